# Optimizing an MI355X kernel written in HIP

```python
import math
import jax
import jax.numpy as jnp
from jax import lax
import numpy as np

D_MODEL = 1024
BATCH = 8
SEQ = 4096
DEPTH = 4

GRID_W = 64
CTX_LEN = 256
N_BRANCH = 4
BRANCH_W = D_MODEL // 4
NA_HEADS = 4
NA_HD = BRANCH_W // NA_HEADS
NA_KH = 8
NA_KW = 16
MLA_HEADS = 4
MLA_Q_LORA = D_MODEL // 4
MLA_KV_LORA = D_MODEL // 8
MLA_NOPE = 64
MLA_ROPE = 32
MLA_V = BRANCH_W // MLA_HEADS
S5_GROUP_CH = 16
S5_GROUPS = BRANCH_W // S5_GROUP_CH
S5_STATE = 64
DIFF_HEADS = 4
DIFF_HD = BRANCH_W // (2 * DIFF_HEADS)
D_FF = 3584
N_EXPERTS = 8
TOP_K = 2
EXPERT_BLOCK = 128
N_DENSE = (DEPTH + 1) // 2
N_MOE = DEPTH // 2
Q_BLOCK = 128
ROPE_BASE = 10000.0
LN_EPS = 1e-5
RMS_EPS = 1e-6
ALPHA = (2 * DEPTH) ** 0.25
BETA = (8 * DEPTH) ** -0.25
NA_SCALE = NA_HD ** -0.5
MLA_SCALE = (MLA_NOPE + MLA_ROPE) ** -0.5
DIFF_SCALE = DIFF_HD ** -0.5
IN_SIZES = (BRANCH_W, BRANCH_W, BRANCH_W, MLA_Q_LORA, MLA_KV_LORA, MLA_ROPE, BRANCH_W, 2 * DIFF_HEADS * DIFF_HD, 2 * DIFF_HEADS * DIFF_HD, 2 * DIFF_HEADS * DIFF_HD)
IN_COLS = sum(IN_SIZES)

kernel_name = 'hybrid_diffusion_trunk'


def _split_cols(z, sizes):
    parts, start = [], 0
    for size in sizes:
        parts.append(z[..., start:start + size])
        start += size
    return parts


def _heads(z, n_heads):
    b, t, _ = z.shape
    return z.reshape(b, t, n_heads, -1).transpose(0, 2, 1, 3)


def _merge_heads(z):
    b, h, t, dh = z.shape
    return z.transpose(0, 2, 1, 3).reshape(b, t, h * dh)


def _layer_norm(z, g, b):
    zf = z.astype(jnp.float32)
    zc = zf - jnp.mean(zf, axis=-1, keepdims=True)
    var = jnp.mean(zc * zc, axis=-1, keepdims=True)
    return (zc * lax.rsqrt(var + LN_EPS) * g.astype(jnp.float32) + b.astype(jnp.float32)).astype(z.dtype)


def _rms_norm(z, g):
    zf = z.astype(jnp.float32)
    return (zf * lax.rsqrt(jnp.mean(zf * zf, axis=-1, keepdims=True) + RMS_EPS) * g.astype(jnp.float32)).astype(z.dtype)


def _softmax(s):
    return jax.nn.softmax(s.astype(jnp.float32), axis=-1)


def _rope_2d(z, prow, pcol):
    half = z.shape[-1] // 2
    nf = half // 2
    inv = ROPE_BASE ** (-jnp.arange(nf, dtype=jnp.float32) / nf)

    def rot(za, p):
        ang = p.astype(jnp.float32)[:, None] * inv[None, :]
        cos, sin = jnp.cos(ang), jnp.sin(ang)
        z1 = za[..., :nf].astype(jnp.float32)
        z2 = za[..., nf:].astype(jnp.float32)
        return jnp.concatenate([z1 * cos - z2 * sin, z1 * sin + z2 * cos], axis=-1)

    return jnp.concatenate([rot(z[..., :half], prow), rot(z[..., half:], pcol)], axis=-1).astype(z.dtype)


def _sweep_query_blocks(fn, *qs):
    b, h, t, _ = qs[0].shape
    nb = t // Q_BLOCK
    blocks = tuple(q.reshape(b, h, nb, Q_BLOCK, q.shape[-1]).transpose(2, 0, 1, 3, 4) for q in qs)
    out = lax.map(lambda blk: fn(*blk), blocks)
    return out.transpose(1, 2, 0, 3, 4).reshape(b, h, t, out.shape[-1])


def _dense_attention(q, k, v, scale):
    p = _softmax(jnp.einsum('bhqd,bhkd->bhqk', q, k) * scale)
    return jnp.einsum('bhqk,bhkd->bhqd', p.astype(v.dtype), v)


def _neighbourhood_attention(q, k, v, kc, vc, rpb):
    b, h, t, dh = q.shape
    rows = t // GRID_W
    kh = min(NA_KH, rows)
    kw = NA_KW
    q = q.reshape(b, h, rows, GRID_W, dh)
    k = k.reshape(b, h, rows, GRID_W, dh)
    v = v.reshape(b, h, rows, GRID_W, dh)
    col = jnp.arange(GRID_W)
    col_idx = jnp.clip(col - kw // 2, 0, GRID_W - kw)[:, None] + jnp.arange(kw)[None, :]
    col_off = col_idx - col[:, None] + (NA_KW - 1)

    def row_block(r):
        r0 = jnp.clip(r - kh // 2, 0, rows - kh)
        qr = lax.dynamic_index_in_dim(q, r, axis=2, keepdims=False)
        kg = lax.dynamic_slice_in_dim(k, r0, kh, axis=2)[:, :, :, col_idx]
        vg = lax.dynamic_slice_in_dim(v, r0, kh, axis=2)[:, :, :, col_idx]
        row_off = r0 + jnp.arange(kh) - r + (NA_KH - 1)
        bias = rpb[:, row_off][:, :, col_off].transpose(0, 2, 1, 3)
        s_loc = (jnp.einsum('bhqd,bhrqcd->bhqrc', qr, kg) * NA_SCALE + bias[None]).reshape(b, h, GRID_W, kh * kw)
        s_ctx = jnp.einsum('bhqd,bhld->bhql', qr, kc) * NA_SCALE
        p = _softmax(jnp.concatenate([s_loc, s_ctx], axis=-1)).astype(v.dtype)
        p_loc = p[..., :kh * kw].reshape(b, h, GRID_W, kh, kw)
        return jnp.einsum('bhqrc,bhrqcd->bhqd', p_loc, vg) + jnp.einsum('bhql,bhld->bhqd', p[..., kh * kw:], vc)

    out = lax.map(row_block, jnp.arange(rows))
    return out.transpose(1, 2, 0, 3, 4).reshape(b, h, t, dh)


def _mla_qkv(q_lat, kv_lat, k_rope, q_norm, kv_norm, w_uq, w_ukv, pos):
    b, t, _ = q_lat.shape
    q = (_rms_norm(q_lat, q_norm) @ w_uq).reshape(b, t, MLA_HEADS, MLA_NOPE + MLA_ROPE).transpose(0, 2, 1, 3)
    kv = (_rms_norm(kv_lat, kv_norm) @ w_ukv).reshape(b, t, MLA_HEADS, MLA_NOPE + MLA_V).transpose(0, 2, 1, 3)
    q_nope, q_rope = q[..., :MLA_NOPE], q[..., MLA_NOPE:]
    k_nope, v = kv[..., :MLA_NOPE], kv[..., MLA_NOPE:]
    if pos is not None:
        q_rope = _rope_2d(q_rope, *pos)
        k_rope = _rope_2d(k_rope, *pos)
    return q_nope, q_rope, k_nope, k_rope, v


def _mla_attend(qn, qr, kn, kr, v):
    s = jnp.einsum('bhqd,bhkd->bhqk', qn, kn) + jnp.einsum('bhqr,bkr->bhqk', qr, kr)
    p = _softmax(s * MLA_SCALE)
    return jnp.einsum('bhqk,bhkd->bhqd', p.astype(v.dtype), v)


def _diag_scan(a_bar, bu, h0, reverse):
    if h0 is not None:
        edge = bu.shape[1] - 1 if reverse else 0
        bu = bu.at[:, edge].add(a_bar * h0)
    a = jnp.broadcast_to(a_bar, bu.shape)

    def combine(e1, e2):
        a1, b1 = e1
        a2, b2 = e2
        return a1 * a2, a2 * b1 + b2

    return lax.associative_scan(combine, (a, bu), axis=1, reverse=reverse)[1]


def _s5_mixer(u, uc, lam_re, lam_im, log_dt, b_re, b_im, c_re, c_im, d_skip, w_glu, ctx_out):
    def groups(z):
        return z.astype(jnp.float32).reshape(z.shape[0], z.shape[1], S5_GROUPS, S5_GROUP_CH).astype(jnp.complex64)

    ug, ucg = groups(u), groups(uc)
    ys, ycs = [], []
    for direction in range(2):
        rev = direction == 1
        lam = lax.complex(lam_re[direction].astype(jnp.float32), lam_im[direction].astype(jnp.float32))
        dt = jnp.exp(log_dt[direction].astype(jnp.float32))[:, None]
        a_bar = jnp.exp(lam * dt)
        b_mat = lax.complex(b_re[direction].astype(jnp.float32), b_im[direction].astype(jnp.float32))
        b_bar = ((a_bar - 1.0) / lam)[..., None] * b_mat
        c_mat = lax.complex(c_re[direction].astype(jnp.float32), c_im[direction].astype(jnp.float32))
        st_c = _diag_scan(a_bar, jnp.einsum('gpc,btgc->btgp', b_bar, ucg), None, rev)
        h0 = st_c[:, 0] if rev else st_c[:, -1]
        st = _diag_scan(a_bar, jnp.einsum('gpc,btgc->btgp', b_bar, ug), h0, rev)
        ys.append(jnp.real(jnp.einsum('gcp,btgp->btgc', c_mat, st)))
        if ctx_out:
            ycs.append(jnp.real(jnp.einsum('gcp,btgp->btgc', c_mat, st_c)))

    def finish(y_dirs, z):
        y = (y_dirs[0] + y_dirs[1]).reshape(z.shape) + d_skip.astype(jnp.float32) * z.astype(jnp.float32)
        val, gate = jnp.split(y.astype(z.dtype) @ w_glu, 2, axis=-1)
        return val * jax.nn.sigmoid(gate)

    return finish(ys, u), (finish(ycs, uc) if ctx_out else None)


def _diff_qkv(zq, zk, zv, pos):
    b, t, _ = zq.shape
    q = zq.reshape(b, t, DIFF_HEADS, 2, DIFF_HD).transpose(0, 2, 3, 1, 4)
    k = zk.reshape(b, t, DIFF_HEADS, 2, DIFF_HD).transpose(0, 2, 3, 1, 4)
    if pos is not None:
        q = _rope_2d(q, *pos)
        k = _rope_2d(k, *pos)
    return q[:, :, 0], q[:, :, 1], k[:, :, 0], k[:, :, 1], _heads(zv, DIFF_HEADS)


def _diff_attend(q1, q2, k1, k2, v, lam):
    p1 = _softmax(jnp.einsum('bhqd,bhkd->bhqk', q1, k1) * DIFF_SCALE)
    p2 = _softmax(jnp.einsum('bhqd,bhkd->bhqk', q2, k2) * DIFF_SCALE)
    return jnp.einsum('bhqk,bhkd->bhqd', (p1 - lam * p2).astype(v.dtype), v)


def _diff_finish(o, subln, lam_init):
    return _merge_heads(_rms_norm(o, subln) * (1.0 - lam_init))


def _gated_merge(h, outs, w_branch, w_gate, b_gate):
    d = h.shape[-1]
    m = None
    for i, o in enumerate(outs):
        gate = jax.nn.sigmoid(h @ w_gate[:, i * d:(i + 1) * d] + b_gate[i * d:(i + 1) * d])
        term = gate * (o @ w_branch[i])
        m = term if m is None else m + term
    return m


def _token_mixing(h, hc, pos, w_in, na_rpb, mla_q_norm, mla_kv_norm, mla_w_uq, mla_w_ukv,
                  s5_lam_re, s5_lam_im, s5_log_dt, s5_b_re, s5_b_im, s5_c_re, s5_c_im, s5_d, s5_w_glu,
                  diff_lam_q1, diff_lam_k1, diff_lam_q2, diff_lam_k2, diff_subln,
                  w_branch, w_gate, b_gate, w_out, lam_init, ctx_out):
    na_q, na_k, na_v, m_q, m_kv, m_kr, s5_u, d_q, d_k, d_v = _split_cols(h @ w_in, IN_SIZES)
    na_qc, na_kc, na_vc, m_qc, m_kvc, m_krc, s5_uc, d_qc, d_kc, d_vc = _split_cols(hc @ w_in, IN_SIZES)
    outs, outs_c = [], []

    kac, vac = _heads(na_kc, NA_HEADS), _heads(na_vc, NA_HEADS)
    o = _neighbourhood_attention(_heads(na_q, NA_HEADS), _heads(na_k, NA_HEADS), _heads(na_v, NA_HEADS), kac, vac, na_rpb)
    outs.append(_merge_heads(o))
    if ctx_out:
        outs_c.append(_merge_heads(_dense_attention(_heads(na_qc, NA_HEADS), kac, vac, NA_SCALE)))

    qn, qr, kn, kr, vb = _mla_qkv(m_q, m_kv, m_kr, mla_q_norm, mla_kv_norm, mla_w_uq, mla_w_ukv, pos)
    qnc, qrc, knc, krc, vbc = _mla_qkv(m_qc, m_kvc, m_krc, mla_q_norm, mla_kv_norm, mla_w_uq, mla_w_ukv, None)
    kn_all = jnp.concatenate([kn, knc], axis=2)
    kr_all = jnp.concatenate([kr, krc], axis=1)
    vb_all = jnp.concatenate([vb, vbc], axis=2)
    o = _sweep_query_blocks(lambda a, r: _mla_attend(a, r, kn_all, kr_all, vb_all), qn, qr)
    outs.append(_merge_heads(o))
    if ctx_out:
        outs_c.append(_merge_heads(_mla_attend(qnc, qrc, knc, krc, vbc)))

    o, oc = _s5_mixer(s5_u, s5_uc, s5_lam_re, s5_lam_im, s5_log_dt, s5_b_re, s5_b_im, s5_c_re, s5_c_im, s5_d, s5_w_glu, ctx_out)
    outs.append(o)
    if ctx_out:
        outs_c.append(oc)

    lam = (jnp.exp(jnp.sum(diff_lam_q1.astype(jnp.float32) * diff_lam_k1.astype(jnp.float32)))
           - jnp.exp(jnp.sum(diff_lam_q2.astype(jnp.float32) * diff_lam_k2.astype(jnp.float32))) + lam_init)
    q1, q2, k1, k2, vd = _diff_qkv(d_q, d_k, d_v, pos)
    q1c, q2c, k1c, k2c, vdc = _diff_qkv(d_qc, d_kc, d_vc, None)
    k1a = jnp.concatenate([k1, k1c], axis=2)
    k2a = jnp.concatenate([k2, k2c], axis=2)
    vda = jnp.concatenate([vd, vdc], axis=2)
    o = _sweep_query_blocks(lambda a, bq: _diff_attend(a, bq, k1a, k2a, vda, lam), q1, q2)
    outs.append(_diff_finish(o, diff_subln, lam_init))
    if ctx_out:
        outs_c.append(_diff_finish(_diff_attend(q1c, q2c, k1c, k2c, vdc, lam), diff_subln, lam_init))

    y = _gated_merge(h, outs, w_branch, w_gate, b_gate) @ w_out
    yc = (_gated_merge(hc, outs_c, w_branch, w_gate, b_gate) @ w_out) if ctx_out else None
    return y, yc


def _swiglu(h, w1, w3, w2):
    return (jax.nn.silu(h @ w1) * (h @ w3)) @ w2


def _moe_swiglu(h, w_router, w1, w3, w2):
    t, d = h.shape
    top_v, top_i = lax.top_k((h @ w_router).astype(jnp.float32), TOP_K)
    gates = jax.nn.softmax(top_v, axis=-1)
    flat_e = top_i.reshape(-1)
    n_assign = t * TOP_K
    order = jnp.argsort(flat_e)
    sorted_e = flat_e[order]
    tok = (order // TOP_K).astype(jnp.int32)
    counts = jnp.bincount(flat_e, length=N_EXPERTS)
    padded = (counts + EXPERT_BLOCK - 1) // EXPERT_BLOCK * EXPERT_BLOCK
    pad_end = jnp.cumsum(padded)
    pad_start = pad_end - padded
    start = jnp.cumsum(counts) - counts
    dest = pad_start[sorted_e] + jnp.arange(n_assign) - start[sorted_e]
    n_blocks = -(-n_assign // EXPERT_BLOCK) + N_EXPERTS
    buf_tok = jnp.full((n_blocks * EXPERT_BLOCK,), t, jnp.int32).at[dest].set(tok)
    block_e = jnp.minimum(jnp.searchsorted(pad_end, jnp.arange(n_blocks) * EXPERT_BLOCK, side='right'), N_EXPERTS - 1)
    hp = jnp.concatenate([h, jnp.zeros((1, d), h.dtype)], axis=0)
    xb = hp[buf_tok].reshape(n_blocks, EXPERT_BLOCK, d)
    yb = lax.map(lambda a: _swiglu(a[0], w1[a[1]], w3[a[1]], w2[a[1]]), (xb, block_e))
    y_assign = yb.reshape(-1, d)[dest] * gates.reshape(-1)[order][:, None].astype(h.dtype)
    return jax.ops.segment_sum(y_assign, tok, num_segments=t)


def _channel_mixer(z, layer, ffn_w1, ffn_w3, ffn_w2, moe_router, moe_w1, moe_w3, moe_w2):
    j = layer // 2
    if layer % 2 == 0:
        return _swiglu(z, ffn_w1[j], ffn_w3[j], ffn_w2[j])
    flat = z.reshape(-1, z.shape[-1])
    return _moe_swiglu(flat, moe_router[j], moe_w1[j], moe_w3[j], moe_w2[j]).reshape(z.shape)


def setup_inputs(seed: int = 0) -> dict:
    key = jax.random.key(seed)
    ks = list(jax.random.split(key, 48))
    f32 = jnp.float32

    def nrm(shape, scale):
        return jax.random.normal(ks.pop(), shape, f32) * scale

    def gain(shape):
        return 1.0 + nrm(shape, 0.02)

    d = D_MODEL
    n_idx = jnp.arange(S5_STATE, dtype=f32)
    return {
        'x': nrm((BATCH, SEQ, d), 1.0),
        'c': nrm((BATCH, d), 1.0),
        'ctx': nrm((BATCH, CTX_LEN, d), 1.0),
        'c_ctx': nrm((d,), 1.0),
        'w_ada': nrm((DEPTH, d, 6 * d), d ** -0.5),
        'b_ada': nrm((DEPTH, 6 * d), 0.02),
        'w_in': nrm((DEPTH, d, IN_COLS), d ** -0.5),
        'na_rpb': nrm((DEPTH, NA_HEADS, 2 * NA_KH - 1, 2 * NA_KW - 1), 0.05),
        'mla_q_norm': gain((DEPTH, MLA_Q_LORA)),
        'mla_kv_norm': gain((DEPTH, MLA_KV_LORA)),
        'mla_w_uq': nrm((DEPTH, MLA_Q_LORA, MLA_HEADS * (MLA_NOPE + MLA_ROPE)), MLA_Q_LORA ** -0.5),
        'mla_w_ukv': nrm((DEPTH, MLA_KV_LORA, MLA_HEADS * (MLA_NOPE + MLA_V)), MLA_KV_LORA ** -0.5),
        's5_lam_re': -0.5 + nrm((DEPTH, 2, S5_GROUPS, S5_STATE), 0.01),
        's5_lam_im': math.pi * n_idx + nrm((DEPTH, 2, S5_GROUPS, S5_STATE), 0.01),
        's5_log_dt': jax.random.uniform(ks.pop(), (DEPTH, 2, S5_GROUPS), f32, math.log(1e-3), math.log(1e-1)),
        's5_b_re': nrm((DEPTH, 2, S5_GROUPS, S5_STATE, S5_GROUP_CH), (2 * S5_GROUP_CH) ** -0.5),
        's5_b_im': nrm((DEPTH, 2, S5_GROUPS, S5_STATE, S5_GROUP_CH), (2 * S5_GROUP_CH) ** -0.5),
        's5_c_re': nrm((DEPTH, 2, S5_GROUPS, S5_GROUP_CH, S5_STATE), S5_STATE ** -0.5),
        's5_c_im': nrm((DEPTH, 2, S5_GROUPS, S5_GROUP_CH, S5_STATE), S5_STATE ** -0.5),
        's5_d': nrm((DEPTH, BRANCH_W), 0.5),
        's5_w_glu': nrm((DEPTH, BRANCH_W, 2 * BRANCH_W), BRANCH_W ** -0.5),
        'diff_lam_q1': nrm((DEPTH, DIFF_HD), 0.1),
        'diff_lam_k1': nrm((DEPTH, DIFF_HD), 0.1),
        'diff_lam_q2': nrm((DEPTH, DIFF_HD), 0.1),
        'diff_lam_k2': nrm((DEPTH, DIFF_HD), 0.1),
        'diff_subln': gain((DEPTH, 2 * DIFF_HD)),
        'w_branch': nrm((DEPTH, N_BRANCH, BRANCH_W, d), BETA * BRANCH_W ** -0.5),
        'w_gate': nrm((DEPTH, d, N_BRANCH * d), d ** -0.5),
        'b_gate': nrm((DEPTH, N_BRANCH * d), 0.02),
        'w_out': nrm((DEPTH, d, d), BETA * d ** -0.5),
        'ln1_g': gain((DEPTH, d)),
        'ln1_b': nrm((DEPTH, d), 0.02),
        'ln2_g': gain((DEPTH, d)),
        'ln2_b': nrm((DEPTH, d), 0.02),
        'ffn_w1': nrm((N_DENSE, d, D_FF), d ** -0.5),
        'ffn_w3': nrm((N_DENSE, d, D_FF), d ** -0.5),
        'ffn_w2': nrm((N_DENSE, D_FF, d), BETA * D_FF ** -0.5),
        'moe_router': nrm((N_MOE, d, N_EXPERTS), d ** -0.5),
        'moe_w1': nrm((N_MOE, N_EXPERTS, d, D_FF), d ** -0.5),
        'moe_w3': nrm((N_MOE, N_EXPERTS, d, D_FF), d ** -0.5),
        'moe_w2': nrm((N_MOE, N_EXPERTS, D_FF, d), BETA * D_FF ** -0.5),
    }


def reference(x, c, ctx, c_ctx, w_ada, b_ada, w_in, na_rpb, mla_q_norm, mla_kv_norm, mla_w_uq, mla_w_ukv,
              s5_lam_re, s5_lam_im, s5_log_dt, s5_b_re, s5_b_im, s5_c_re, s5_c_im, s5_d, s5_w_glu,
              diff_lam_q1, diff_lam_k1, diff_lam_q2, diff_lam_k2, diff_subln,
              w_branch, w_gate, b_gate, w_out, ln1_g, ln1_b, ln2_g, ln2_b,
              ffn_w1, ffn_w3, ffn_w2, moe_router, moe_w1, moe_w3, moe_w2):
    b, s, d = x.shape
    t = jnp.arange(s)
    pos = (t // GRID_W, t % GRID_W)
    cond = jax.nn.silu(c)
    cond_ctx = jax.nn.silu(c_ctx)[None, :]
    xc = ctx
    for layer in range(DEPTH):
        ctx_out = layer < DEPTH - 1
        lam_init = 0.8 - 0.6 * math.exp(-0.3 * layer)
        mod = jnp.split((cond @ w_ada[layer] + b_ada[layer])[:, None, :], 6, axis=-1)
        mod_c = jnp.split((cond_ctx @ w_ada[layer] + b_ada[layer])[:, None, :], 6, axis=-1)
        y, yc = _token_mixing(x * (1.0 + mod[1]) + mod[0], xc * (1.0 + mod_c[1]) + mod_c[0], pos,
                              w_in[layer], na_rpb[layer], mla_q_norm[layer], mla_kv_norm[layer],
                              mla_w_uq[layer], mla_w_ukv[layer],
                              s5_lam_re[layer], s5_lam_im[layer], s5_log_dt[layer], s5_b_re[layer], s5_b_im[layer],
                              s5_c_re[layer], s5_c_im[layer], s5_d[layer], s5_w_glu[layer],
                              diff_lam_q1[layer], diff_lam_k1[layer], diff_lam_q2[layer], diff_lam_k2[layer],
                              diff_subln[layer], w_branch[layer], w_gate[layer], b_gate[layer], w_out[layer],
                              lam_init, ctx_out)
        x = _layer_norm(ALPHA * x + mod[2] * y, ln1_g[layer], ln1_b[layer])
        f = _channel_mixer(x * (1.0 + mod[4]) + mod[3], layer, ffn_w1, ffn_w3, ffn_w2, moe_router, moe_w1, moe_w3, moe_w2)
        x = _layer_norm(ALPHA * x + mod[5] * f, ln2_g[layer], ln2_b[layer])
        if ctx_out:
            xc = _layer_norm(ALPHA * xc + mod_c[2] * yc, ln1_g[layer], ln1_b[layer])
            fc = _channel_mixer(xc * (1.0 + mod_c[4]) + mod_c[3], layer, ffn_w1, ffn_w3, ffn_w2, moe_router, moe_w1, moe_w3, moe_w2)
            xc = _layer_norm(ALPHA * xc + mod_c[5] * fc, ln2_g[layer], ln2_b[layer])
    return x
```

```cpp
#include <hip/hip_runtime.h>
#include <cstdint>
#include <cstdio>
#include <type_traits>
#ifndef XBF
#define XBF 1
#endif
#ifndef G8
#define G8 1
#endif

constexpr int D = 1024, NB = 8, SQ = 4096, CL = 256, DEPTH = 4;
constexpr int TL = NB * SQ, TC = NB * CL, T = TL + TC;
constexpr int INC = 2208, EC = 896, DFF = 3584, NE = 8;
constexpr int O_NAQ = 0, O_NAK = 256, O_NAV = 512, O_MQ = 768, O_MKV = 1024, O_MKR = 1152, O_S5 = 1184, O_DQ = 1440, O_DK = 1696, O_DV = 1952;
constexpr float ALPHA = 1.681792830507429f;
constexpr size_t MiB = 1u << 20;
constexpr size_t WS_COND = 0, WS_MOD = 1 * MiB, WS_CNT = 3 * MiB, WS_LTOK = 4 * MiB, WS_LGATE = 6 * MiB, WS_X = 8 * MiB, WS_O = 144 * MiB, WS_MG = 280 * MiB,
                 WS_TG = 416 * MiB, WS_E = 552 * MiB, WS_Y5 = 671 * MiB, WS_Z = 705 * MiB, WS_H = 999 * MiB, WS_W13 = 1067 * MiB, WS_W2T = 1081 * MiB, WS_END = 1122 * MiB;
constexpr int CH = 8704;
#ifndef MERGE_NAIVE
#define MERGE_NAIVE 0
#endif

__device__ __forceinline__ int modrow(int r) { return r < TL ? (r >> 12) : 8; }
__device__ __forceinline__ float sigm(float v) { return 1.f / (1.f + expf(-v)); }

__global__ void k_lamv(const float* q1, const float* k1, const float* q2, const float* k2, float* LAMV) {
    const int i = threadIdx.x, l = i >> 7, w = (i >> 5) & 3, j = i & 31; const float* src = w == 0 ? q1 : (w == 1 ? k1 : (w == 2 ? q2 : k2)); LAMV[i] = src[l * 32 + j];
}
__global__ void k_cond(const float* c, const float* c_ctx, float* COND) {
    int i = blockIdx.x * 256 + threadIdx.x;
    if (i >= 9 * D) return;
    float v = i < 8 * D ? c[i] : c_ctx[i - 8 * D];
    COND[i] = v * sigm(v);
}
__global__ void k_mod(const float* COND, const float* w_ada, const float* b_ada, float* MOD) {
    int n = blockIdx.x * 256 + threadIdx.x, l = blockIdx.y;
    float acc[9];
#pragma unroll
    for (int r = 0; r < 9; ++r) acc[r] = 0.f;
    const float* w = w_ada + (size_t)l * D * 6144 + n;
    for (int k = 0; k < D; ++k) { float wv = w[(size_t)k * 6144];
#pragma unroll
        for (int r = 0; r < 9; ++r) acc[r] += COND[r * D + k] * wv; }
    float bb = b_ada[l * 6144 + n];
#pragma unroll
    for (int r = 0; r < 9; ++r) MOD[((size_t)l * 9 + r) * 6144 + n] = acc[r] + bb;
}
__global__ void k_copy_in(const float* x, const float* ctx, float* X) {
    size_t i = (size_t)blockIdx.x * 256 + threadIdx.x;
    const size_t nl = (size_t)TL * D / 4, nt = (size_t)T * D / 4;
    if (i >= nt) return;
    ((float4*)X)[i] = i < nl ? ((const float4*)x)[i] : ((const float4*)ctx)[i - nl];
}

struct SG { const float* A; const float* B; float* C; const float* bias; const float* aux; const float* mod; const int* gather; const int* cnt; const float* gatew; const int* scat;
            int lda, ldb, ldc, ldaux, M, N, K, sh_off, sc_off, row0, arow0, first; };
template <int MODE> __global__ __launch_bounds__(256) void k_sgemm(SG p) {
    __shared__ float As[8][132];
    __shared__ float Bs[8][132];
    int Mlim = p.M;
    if (p.cnt) { int c = *p.cnt - p.row0; Mlim = c < Mlim ? c : Mlim; }
    const int bm = blockIdx.y * 128, bn = blockIdx.x * 128;
    if (bm >= Mlim) return;
    const int tid = threadIdx.x, ty = tid >> 4, tx = tid & 15;
    float acc[8][8];
#pragma unroll
    for (int i = 0; i < 8; ++i)
#pragma unroll
        for (int j = 0; j < 8; ++j) acc[i][j] = 0.f;
    const int ar = tid >> 1, ak = (tid & 1) * 4;
    int arow = bm + ar; const bool avalid = arow < Mlim;
    int asrc = 0; if (avalid) asrc = p.gather ? p.gather[p.arow0 + arow] : p.arow0 + arow;
    const float* ap = p.A + (size_t)asrc * p.lda + ak;
    const float* modp = nullptr; if (p.mod) modp = p.mod + (size_t)modrow(asrc) * 6144;
    const int bk = tid >> 5, bnn = (tid & 31) * 4;
    const bool bvalid = (bn + bnn) < p.N;
    const float* bp = p.B + (size_t)bk * p.ldb + bn + bnn;
    for (int k0 = 0; k0 < p.K; k0 += 8) {
        float4 av = make_float4(0.f, 0.f, 0.f, 0.f), bv = make_float4(0.f, 0.f, 0.f, 0.f);
        if (avalid) { av = *(const float4*)(ap + k0);
            if (modp) { const float4 sc = *(const float4*)(modp + p.sc_off + k0 + ak), sh = *(const float4*)(modp + p.sh_off + k0 + ak);
                av.x = av.x * (1.f + sc.x) + sh.x; av.y = av.y * (1.f + sc.y) + sh.y; av.z = av.z * (1.f + sc.z) + sh.z; av.w = av.w * (1.f + sc.w) + sh.w; } }
        if (bvalid) bv = *(const float4*)(bp + (size_t)k0 * p.ldb);
        __syncthreads();
        As[ak + 0][ar] = av.x; As[ak + 1][ar] = av.y; As[ak + 2][ar] = av.z; As[ak + 3][ar] = av.w;
        *(float4*)&Bs[bk][bnn] = bv;
        __syncthreads();
#pragma unroll
        for (int k = 0; k < 8; ++k) {
            float a[8], b[8];
            *(float4*)&a[0] = *(const float4*)&As[k][ty * 8]; *(float4*)&a[4] = *(const float4*)&As[k][ty * 8 + 4];
            *(float4*)&b[0] = *(const float4*)&Bs[k][tx * 8]; *(float4*)&b[4] = *(const float4*)&Bs[k][tx * 8 + 4];
#pragma unroll
            for (int i = 0; i < 8; ++i)
#pragma unroll
                for (int j = 0; j < 8; ++j) acc[i][j] += a[i] * b[j];
        }
    }
#pragma unroll
    for (int i = 0; i < 8; ++i) {
        const int r = bm + ty * 8 + i; if (r >= Mlim) continue;
        int tok = 0; float gw = 0.f;
        if (MODE == 5) { tok = p.scat[p.row0 + r]; gw = p.gatew[p.row0 + r]; }
#pragma unroll
        for (int j = 0; j < 8; ++j) {
            const int c = bn + tx * 8 + j; if (c >= p.N) continue;
            float v = acc[i][j];
            float* cp = p.C + (size_t)r * p.ldc + c;
            if (MODE == 0) { if (p.bias) v += p.bias[c]; *cp = v; }
            if (MODE == 1) { *cp = sigm(v + p.bias[c]); }
            if (MODE == 2) { float o = p.first ? 0.f : *cp; *cp = o + p.aux[(size_t)r * p.ldaux + c] * v; }
            if (MODE == 3) { *cp = v * sigm(v); }
            if (MODE == 4) { *cp = *cp * v; }
            if (MODE == 5) { float* fp = p.C + (size_t)tok * p.ldc + c; *fp = *fp + gw * v; }
        }
    }
}

__global__ __launch_bounds__(256) void k_rms(float* Z, const float* gq, const float* gkv) {
    const int r = blockIdx.x * 4 + (threadIdx.x >> 6), lane = threadIdx.x & 63;
    float* z = Z + (size_t)r * INC;
    float4 q = *(float4*)(z + O_MQ + lane * 4); float2 kv = *(float2*)(z + O_MKV + lane * 2);
    float sq = q.x * q.x + q.y * q.y + q.z * q.z + q.w * q.w, sk = kv.x * kv.x + kv.y * kv.y;
#pragma unroll
    for (int o = 1; o < 64; o <<= 1) { sq += __shfl_xor(sq, o); sk += __shfl_xor(sk, o); }
    const float rq = rsqrtf(sq / 256.f + 1e-6f), rk = rsqrtf(sk / 128.f + 1e-6f);
    const float4 g4 = *(const float4*)(gq + lane * 4); const float2 g2 = *(const float2*)(gkv + lane * 2);
    q.x *= rq * g4.x; q.y *= rq * g4.y; q.z *= rq * g4.z; q.w *= rq * g4.w; kv.x *= rk * g2.x; kv.y *= rk * g2.y;
    *(float4*)(z + O_MQ + lane * 4) = q; *(float2*)(z + O_MKV + lane * 2) = kv;
}
__global__ __launch_bounds__(256) void k_rope(float* Z, float* E) {
    const int idx = blockIdx.x * 256 + threadIdx.x;
    if (idx >= TL * 21) return;
    const int r = idx / 21, v = idx % 21;
    float* z;
    if (v == 0) z = Z + (size_t)r * INC + O_MKR;
    else if (v < 9) z = Z + (size_t)r * INC + O_DQ + (v - 1) * 32;
    else if (v < 17) z = Z + (size_t)r * INC + O_DK + (v - 9) * 32;
    else z = E + (size_t)r * EC + (v - 17) * 96 + 64;
    const int t = r & (SQ - 1), prow = t >> 6, pcol = t & 63;
#pragma unroll
    for (int half = 0; half < 2; ++half) { const float pp = (float)(half ? pcol : prow);
#pragma unroll
        for (int i = 0; i < 8; ++i) { const float inv = exp2f(-(float)i * 0.125f * 13.287712379549449f); float sn, cs; sincosf(pp * inv, &sn, &cs);
            const float z1 = z[half * 16 + i], z2 = z[half * 16 + 8 + i];
            z[half * 16 + i] = z1 * cs - z2 * sn; z[half * 16 + 8 + i] = z1 * sn + z2 * cs; } }
}

#define ONLINE(m, l, acc, s, vp) do { const float mn_ = fmaxf(m, s); const float c_ = __expf(m - mn_), p_ = __expf(s - mn_); l = l * c_ + p_; m = mn_; \
    _Pragma("unroll") for (int d_ = 0; d_ < 64; d_ += 4) { const float4 v4_ = *(const float4*)((vp) + d_); acc[d_] = acc[d_] * c_ + p_ * v4_.x; acc[d_ + 1] = acc[d_ + 1] * c_ + p_ * v4_.y; \
        acc[d_ + 2] = acc[d_ + 2] * c_ + p_ * v4_.z; acc[d_ + 3] = acc[d_ + 3] * c_ + p_ * v4_.w; } } while (0)

__global__ __launch_bounds__(256) void k_mla(const float* __restrict__ E, const float* __restrict__ Z, float* __restrict__ O) {
    const int r = blockIdx.x * 256 + threadIdx.x, h = blockIdx.y;
    const bool isctx = r >= TL; const int b = isctx ? (r - TL) / CL : r / SQ;
    float q[96];
#pragma unroll
    for (int i = 0; i < 96; ++i) q[i] = E[(size_t)r * EC + h * 96 + i] * 0.10206207261596575f;
    float m = -1e30f, l = 0.f, acc[64];
#pragma unroll
    for (int i = 0; i < 64; ++i) acc[i] = 0.f;
    const int nk = isctx ? CL : SQ + CL;
    for (int j = 0; j < nk; ++j) {
        const int kr = isctx ? TL + b * CL + j : (j < SQ ? b * SQ + j : TL + b * CL + (j - SQ));
        const float* kn = E + (size_t)kr * EC + 384 + h * 128; const float* kp = Z + (size_t)kr * INC + O_MKR;
        float s = 0.f;
#pragma unroll
        for (int i = 0; i < 64; i += 4) { const float4 k4 = *(const float4*)(kn + i); s += q[i] * k4.x + q[i + 1] * k4.y + q[i + 2] * k4.z + q[i + 3] * k4.w; }
#pragma unroll
        for (int i = 0; i < 32; i += 4) { const float4 k4 = *(const float4*)(kp + i); s += q[64 + i] * k4.x + q[65 + i] * k4.y + q[66 + i] * k4.z + q[67 + i] * k4.w; }
        ONLINE(m, l, acc, s, kn + 64);
    }
    const float il = 1.f / l;
#pragma unroll
    for (int d = 0; d < 64; ++d) O[(size_t)r * D + 256 + h * 64 + d] = acc[d] * il;
}

__global__ __launch_bounds__(256) void k_diff(const float* __restrict__ Z, float* __restrict__ O, const float* lq1, const float* lk1, const float* lq2, const float* lk2, const float* subln, float lam_init) {
    const int r = blockIdx.x * 256 + threadIdx.x, h = blockIdx.y;
    const bool isctx = r >= TL; const int b = isctx ? (r - TL) / CL : r / SQ;
    float s1 = 0.f, s2 = 0.f;
    for (int i = 0; i < 32; ++i) { s1 += lq1[i] * lk1[i]; s2 += lq2[i] * lk2[i]; }
    const float lam = expf(s1) - expf(s2) + lam_init;
    float q1[32], q2[32];
#pragma unroll
    for (int i = 0; i < 32; ++i) { q1[i] = Z[(size_t)r * INC + O_DQ + h * 64 + i] * 0.17677669529663687f; q2[i] = Z[(size_t)r * INC + O_DQ + h * 64 + 32 + i] * 0.17677669529663687f; }
    float m1 = -1e30f, l1 = 0.f, m2 = -1e30f, l2 = 0.f, a1[64], a2[64];
#pragma unroll
    for (int i = 0; i < 64; ++i) { a1[i] = 0.f; a2[i] = 0.f; }
    const int nk = isctx ? CL : SQ + CL;
    for (int j = 0; j < nk; ++j) {
        const int kr = isctx ? TL + b * CL + j : (j < SQ ? b * SQ + j : TL + b * CL + (j - SQ));
        const float* k1 = Z + (size_t)kr * INC + O_DK + h * 64; const float* vp = Z + (size_t)kr * INC + O_DV + h * 64;
        float sa = 0.f, sb = 0.f;
#pragma unroll
        for (int i = 0; i < 32; i += 4) { const float4 ka = *(const float4*)(k1 + i), kb = *(const float4*)(k1 + 32 + i);
            sa += q1[i] * ka.x + q1[i + 1] * ka.y + q1[i + 2] * ka.z + q1[i + 3] * ka.w; sb += q2[i] * kb.x + q2[i + 1] * kb.y + q2[i + 2] * kb.z + q2[i + 3] * kb.w; }
        ONLINE(m1, l1, a1, sa, vp);
        ONLINE(m2, l2, a2, sb, vp);
    }
    const float i1 = 1.f / l1, i2 = lam / l2; float ss = 0.f;
#pragma unroll
    for (int d = 0; d < 64; ++d) { a1[d] = a1[d] * i1 - a2[d] * i2; ss += a1[d] * a1[d]; }
    const float rr = rsqrtf(ss / 64.f + 1e-6f) * (1.f - lam_init);
#pragma unroll
    for (int d = 0; d < 64; ++d) O[(size_t)r * D + 768 + h * 64 + d] = a1[d] * rr * subln[d];
}

__global__ __launch_bounds__(256) void k_na(const float* __restrict__ Z, float* __restrict__ O, const float* __restrict__ rpb) {
    const int r = blockIdx.x * 256 + threadIdx.x, h = blockIdx.y;
    const bool isctx = r >= TL; const int b = isctx ? (r - TL) / CL : r / SQ;
    float q[64];
#pragma unroll
    for (int i = 0; i < 64; ++i) q[i] = Z[(size_t)r * INC + O_NAQ + h * 64 + i] * 0.125f;
    float m = -1e30f, l = 0.f, acc[64];
#pragma unroll
    for (int i = 0; i < 64; ++i) acc[i] = 0.f;
    if (!isctx) {
        const int t = r & (SQ - 1), gr = t >> 6, gc = t & 63;
        const int r0 = min(max(gr - 4, 0), 56), cs = min(max(gc - 8, 0), 48);
        for (int i = 0; i < 8; ++i) for (int j = 0; j < 16; ++j) {
            const int kt = b * SQ + (r0 + i) * 64 + cs + j;
            const float* kp = Z + (size_t)kt * INC + O_NAK + h * 64; const float* vp = Z + (size_t)kt * INC + O_NAV + h * 64;
            float s = rpb[(h * 15 + (r0 + i - gr + 7)) * 31 + (cs + j - gc + 15)];
#pragma unroll
            for (int d = 0; d < 64; d += 4) { const float4 k4 = *(const float4*)(kp + d); s += q[d] * k4.x + q[d + 1] * k4.y + q[d + 2] * k4.z + q[d + 3] * k4.w; }
            ONLINE(m, l, acc, s, vp);
        }
    }
    for (int j = 0; j < CL; ++j) {
        const int kt = TL + b * CL + j;
        const float* kp = Z + (size_t)kt * INC + O_NAK + h * 64; const float* vp = Z + (size_t)kt * INC + O_NAV + h * 64;
        float s = 0.f;
#pragma unroll
        for (int d = 0; d < 64; d += 4) { const float4 k4 = *(const float4*)(kp + d); s += q[d] * k4.x + q[d + 1] * k4.y + q[d + 2] * k4.z + q[d + 3] * k4.w; }
        ONLINE(m, l, acc, s, vp);
    }
    const float il = 1.f / l;
#pragma unroll
    for (int d = 0; d < 64; ++d) O[(size_t)r * D + h * 64 + d] = acc[d] * il;
}

__global__ __launch_bounds__(64) void k_s5(int dir, const float* __restrict__ Z, float* Y5, const float* lam_re, const float* lam_im, const float* log_dt,
                                           const float* b_re, const float* b_im, const float* c_re, const float* c_im, const float* s5d) {
    const int b = blockIdx.x >> 4, g = blockIdx.x & 15, p = threadIdx.x;
    const int gi = dir * 16 + g;
    const double lre = lam_re[gi * 64 + p], lim = lam_im[gi * 64 + p], dt = exp((double)log_dt[gi]);
    const double er = exp(lre * dt); double ang = lim * dt; ang -= 6.283185307179586476925 * rint(ang / 6.283185307179586476925);
    float sn, cs; sincosf((float)ang, &sn, &cs);
    const double ar = er * cs, ai = er * sn;
    const double nr = ar - 1.0, ni = ai, den = lre * lre + lim * lim;
    const float fr = (float)((nr * lre + ni * lim) / den), fi = (float)((ni * lre - nr * lim) / den);
    float bbr[16], bbi[16], cr[16], ci[16], dsk[16];
#pragma unroll
    for (int c = 0; c < 16; ++c) { const float br = b_re[(gi * 64 + p) * 16 + c], bi = b_im[(gi * 64 + p) * 16 + c];
        bbr[c] = fr * br - fi * bi; bbi[c] = fr * bi + fi * br; cr[c] = c_re[(gi * 16 + c) * 64 + p]; ci[c] = c_im[(gi * 16 + c) * 64 + p]; dsk[c] = s5d[g * 16 + c]; }
    double hr = 0.0, hi = 0.0;
    for (int s = 0; s < SQ + CL; ++s) {
        int row;
        if (dir == 0) row = s < CL ? TL + b * CL + s : b * SQ + (s - CL);
        else row = s < CL ? TL + b * CL + (CL - 1 - s) : b * SQ + (SQ - 1 - (s - CL));
        const float* u = Z + (size_t)row * INC + O_S5 + g * 16;
        float uu[16];
#pragma unroll
        for (int c = 0; c < 16; c += 4) *(float4*)&uu[c] = *(const float4*)(u + c);
        float bur = 0.f, bui = 0.f;
#pragma unroll
        for (int c = 0; c < 16; ++c) { bur += bbr[c] * uu[c]; bui += bbi[c] * uu[c]; }
        const double nh = ar * hr - ai * hi + (double)bur; hi = ar * hi + ai * hr + (double)bui; hr = nh;
        const float hrf = (float)hr, hif = (float)hi;
        float v[16];
#pragma unroll
        for (int c = 0; c < 16; ++c) { v[c] = cr[c] * hrf - ci[c] * hif;
#pragma unroll
            for (int o = 1; o < 64; o <<= 1) v[c] += __shfl_xor(v[c], o); }
        if (p == 0) { float* y = Y5 + (size_t)row * 256 + g * 16;
#pragma unroll
            for (int c = 0; c < 16; ++c) y[c] = (dir == 0 ? dsk[c] * uu[c] : y[c]) + v[c]; }
    }
}
__global__ void k_glu(const float* G5, float* O) {
    const int i = blockIdx.x * 256 + threadIdx.x; const int r = i >> 8, c = i & 255;
    O[(size_t)r * D + 512 + c] = G5[(size_t)r * 512 + c] * sigm(G5[(size_t)r * 512 + 256 + c]);
}
__global__ __launch_bounds__(256) void k_ln(float* X, const float* Y, const float* MODl, int goff, const float* g, const float* bta, float* out) {
    const int r = blockIdx.x * 4 + (threadIdx.x >> 6), lane = threadIdx.x & 63;
    const float* md = MODl + (size_t)modrow(r) * 6144 + goff;
    float v[16]; float s = 0.f;
#pragma unroll
    for (int j = 0; j < 4; ++j) { const int c = j * 256 + lane * 4; const float4 x4 = *(const float4*)(X + (size_t)r * D + c), y4 = *(const float4*)(Y + (size_t)r * D + c), m4 = *(const float4*)(md + c);
        v[j * 4] = ALPHA * x4.x + m4.x * y4.x; v[j * 4 + 1] = ALPHA * x4.y + m4.y * y4.y; v[j * 4 + 2] = ALPHA * x4.z + m4.z * y4.z; v[j * 4 + 3] = ALPHA * x4.w + m4.w * y4.w;
        s += v[j * 4] + v[j * 4 + 1] + v[j * 4 + 2] + v[j * 4 + 3]; }
#pragma unroll
    for (int o = 1; o < 64; o <<= 1) s += __shfl_xor(s, o);
    const float mean = s / D; float q = 0.f;
#pragma unroll
    for (int j = 0; j < 16; ++j) { v[j] -= mean; q += v[j] * v[j]; }
#pragma unroll
    for (int o = 1; o < 64; o <<= 1) q += __shfl_xor(q, o);
    const float rstd = rsqrtf(q / D + 1e-5f);
#pragma unroll
    for (int j = 0; j < 4; ++j) { const int c = j * 256 + lane * 4; const float4 g4 = *(const float4*)(g + c), b4 = *(const float4*)(bta + c);
        float4 o4; o4.x = v[j * 4] * rstd * g4.x + b4.x; o4.y = v[j * 4 + 1] * rstd * g4.y + b4.y; o4.z = v[j * 4 + 2] * rstd * g4.z + b4.z; o4.w = v[j * 4 + 3] * rstd * g4.w + b4.w;
        *(float4*)(X + (size_t)r * D + c) = o4; if (out && r < TL) *(float4*)(out + (size_t)r * D + c) = o4; }
}
__global__ __launch_bounds__(256) void k_route(const float* X, const float* MODl, const float* wr, int* cnt, int* ltok, float* lgate) {
    const int r = blockIdx.x * 4 + (threadIdx.x >> 6), lane = threadIdx.x & 63;
    const float* md = MODl + (size_t)modrow(r) * 6144;
    float lg[8];
#pragma unroll
    for (int e = 0; e < 8; ++e) lg[e] = 0.f;
    for (int j = 0; j < 16; ++j) { const int k = j * 64 + lane; const float hv = X[(size_t)r * D + k] * (1.f + md[4 * D + k]) + md[3 * D + k];
        const float4 w0 = *(const float4*)(wr + k * 8), w1 = *(const float4*)(wr + k * 8 + 4);
        lg[0] += hv * w0.x; lg[1] += hv * w0.y; lg[2] += hv * w0.z; lg[3] += hv * w0.w; lg[4] += hv * w1.x; lg[5] += hv * w1.y; lg[6] += hv * w1.z; lg[7] += hv * w1.w; }
#pragma unroll
    for (int e = 0; e < 8; ++e)
#pragma unroll
        for (int o = 1; o < 64; o <<= 1) lg[e] += __shfl_xor(lg[e], o);
    if (lane == 0) {
        int e1 = 0; float v1 = lg[0];
#pragma unroll
        for (int e = 1; e < 8; ++e) if (lg[e] > v1) { v1 = lg[e]; e1 = e; }
        int e2 = -1; float v2 = -3e38f;
#pragma unroll
        for (int e = 0; e < 8; ++e) if (e != e1 && lg[e] > v2) { v2 = lg[e]; e2 = e; }
        const float p2 = expf(v2 - v1), g1 = 1.f / (1.f + p2), g2 = p2 / (1.f + p2);
        const int s1 = atomicAdd(cnt + e1, 1); ltok[e1 * T + s1] = r; lgate[e1 * T + s1] = g1;
        const int s2 = atomicAdd(cnt + e2, 1); ltok[e2 * T + s2] = r; lgate[e2 * T + s2] = g2;
    }
}


#define LAS __attribute__((address_space(3)))
__device__ __forceinline__ int otid() { int w = __builtin_amdgcn_readfirstlane((int)threadIdx.x); asm volatile("" : "+s"(w));
    int t = (w & ~63) + (int)__builtin_amdgcn_mbcnt_hi(~0u, __builtin_amdgcn_mbcnt_lo(~0u, 0u)); asm volatile("" : "+v"(t)); return t; }
typedef unsigned short bf16_t;
typedef short bf16x8 __attribute__((ext_vector_type(8)));
typedef float f32x4 __attribute__((ext_vector_type(4)));
typedef float f32x2 __attribute__((ext_vector_type(2)));
typedef unsigned u32x4 __attribute__((ext_vector_type(4)));
typedef unsigned u32x2 __attribute__((ext_vector_type(2)));
#ifndef GLATE
#define GLATE 1
#endif
#ifndef LNPF
#define LNPF 1
#endif
#ifndef PFL2
#define PFL2 0
#endif
#ifdef KREP
#define KSC (1.f / KREP)
#else
#define KSC 1.f
#endif
namespace pg8 {
constexpr int BM = 256, BK = 64, HALF = 128, HTB = HALF * BK * 2, STAGE_BYTES = 8 * HTB, NXCD = 8, WGM = 4;
__host__ __device__ __forceinline__ int lds_byte(int r, int c) { const int st = (r >> 4) * 2 + (c >> 5), rr = r & 15, cc = c & 31, ob = rr * 64 + cc * 2; return st * 1024 + (ob ^ (((ob >> 9) & 1) << 5)); }
__host__ __device__ __forceinline__ void stage_rc(int b, int& R, int& C) { const int st = b / 1024, sb = b % 1024, swz = sb ^ (((sb >> 9) & 1) << 5); R = (st >> 1) * 16 + swz / 64; C = (st & 1) * 32 + (swz % 64) / 2; }
__host__ __device__ __forceinline__ int perm32(int rho) { const int n = rho >> 4, i = rho & 15; return 8 * (i >> 2) + 4 * n + (i & 3); }
typedef __bf16 bf16x2_t __attribute__((ext_vector_type(2)));
__device__ __forceinline__ unsigned cvt_pk_bf16(float lo, float hi) { const f32x2 v = {lo, hi}; return __builtin_bit_cast(unsigned, __builtin_convertvector(v, bf16x2_t)); }
typedef int v8i_t __attribute__((ext_vector_type(8)));
typedef int v4i_t __attribute__((ext_vector_type(4)));
__device__ __forceinline__ v8i_t cat8(bf16x8 lo, bf16x8 hi) { return __builtin_shufflevector(__builtin_bit_cast(v4i_t, lo), __builtin_bit_cast(v4i_t, hi), 0, 1, 2, 3, 4, 5, 6, 7); }
__device__ __forceinline__ float clamp8(float v) { return fminf(fmaxf(v, -448.f), 448.f); }
__device__ __forceinline__ unsigned pk4_fp8(float a, float b, float c, float d) { int w = 0; w = __builtin_amdgcn_cvt_pk_fp8_f32(clamp8(a), clamp8(b), w, false); w = __builtin_amdgcn_cvt_pk_fp8_f32(clamp8(c), clamp8(d), w, true); return (unsigned)w; }
constexpr float S8_H = 4.f, S8_W13 = 64.f, S8_ACT = 2.f, S8_W2 = 256.f;
struct Unit { const char* A; const char* B; int pm, pn, x0, x1; };
struct StaticOrder {
    int nM, nN, nwg, G, c; const char* A; const char* B; size_t tA, tB;
    __device__ void init(int nM_, int nN_, int G_, int c_, const void* A_, int lda, const void* B_, int ldb) { nM = nM_; nN = nN_; nwg = nM * nN; G = G_; c = c_; A = (const char*)A_; B = (const char*)B_; tA = (size_t)BM * lda * 2; tB = (size_t)BM * ldb * 2; }
    __device__ bool next(int i, Unit& u) const {
        const long L = (long)i * G + c; if (L >= nwg) return false;
        int wgid = (int)L; { const int q = nwg / NXCD, r = nwg % NXCD, xcd = wgid % NXCD, off = wgid / NXCD; wgid = (xcd < r ? xcd * (q + 1) : r * (q + 1) + (xcd - r) * q) + off; }
        const int nig = WGM * nN, gid = wgid / nig, fm = gid * WGM, gsz = (nM - fm) < WGM ? (nM - fm) : WGM;
        u.pm = fm + ((wgid % nig) % gsz); u.pn = (wgid % nig) / gsz; u.x0 = 0; u.x1 = 0;
        u.A = A + (size_t)u.pm * tA; u.B = B + (size_t)u.pn * tB; return true;
    }
};
template <class Epi, class Sched, bool F8 = false, bool I8 = false>
__device__ __forceinline__ void gemm_phase(LAS unsigned char* lds, const int K, const int lda, const int ldb, const Sched& S, const Epi& E) {
    const int tid = otid(), wid = __builtin_amdgcn_readfirstlane(tid >> 6), lane = tid & 63, wr = wid >> 2, wc = wid & 3, fr = lane & 15, fq = lane >> 4;
    const int nt = K / BK;
    constexpr bool PF = PFL2 && (I8 || F8);
    unsigned voffA[2], voffB[2];
#pragma unroll
    for (int i = 0; i < 2; ++i) { int R, C; stage_rc(tid * 16 + i * 8192, R, C); const int Rb = Epi::PERM ? ((R & ~31) + perm32(R & 31)) : R;
        voffA[i] = (unsigned)(R * lda + C) * 2u; voffB[i] = (unsigned)(Rb * ldb + C) * 2u; }
    const size_t kstep = (size_t)(BK * 2);
    const size_t hA = (size_t)HALF * lda * 2, hB = (size_t)HALF * ldb * 2;
    const unsigned ldsw = (unsigned)wid * 1024u;
    const int aoff = lds_byte(wr * 64 + fr, fq * 8), boff = lds_byte(wc * 32 + fr, fq * 8);
#define PG8_SA(b, h) (((b) * 2 + (h)) * HTB)
#define PG8_SB(b, h) ((4 + (b) * 2 + (h)) * HTB)
#define PG8_STAGE(bufoff, gbase, voff) do { _Pragma("unroll") for (int _i = 0; _i < 2; ++_i) \
        __builtin_amdgcn_global_load_lds((const unsigned*)((const char*)(gbase) + (voff)[_i]), (LAS unsigned*)(lds + (bufoff) + ldsw + _i * 8192), 16, 0, 0); } while (0)
#define PG8_LDA(dst, b, h) do { _Pragma("unroll") for (int m = 0; m < 4; ++m) { if constexpr (F8) dst##8[m] = cat8(*(const LAS bf16x8*)(lds + PG8_SA(b, h) + aoff + m * 2048), *(const LAS bf16x8*)(lds + PG8_SA(b, h) + aoff + m * 2048 + 1024)); \
        else { _Pragma("unroll") for (int k = 0; k < 2; ++k) dst[m][k] = *(const LAS bf16x8*)(lds + PG8_SA(b, h) + aoff + m * 2048 + k * 1024); } } } while (0)
#define PG8_LDB(dst, b, h) do { _Pragma("unroll") for (int n = 0; n < 2; ++n) { if constexpr (F8) dst##8[n] = cat8(*(const LAS bf16x8*)(lds + PG8_SB(b, h) + boff + n * 2048), *(const LAS bf16x8*)(lds + PG8_SB(b, h) + boff + n * 2048 + 1024)); \
        else { _Pragma("unroll") for (int k = 0; k < 2; ++k) dst[n][k] = *(const LAS bf16x8*)(lds + PG8_SB(b, h) + boff + n * 2048 + k * 1024); } } } while (0)
#define PG8_MMA(ai, bj, At, Bt) do { __builtin_amdgcn_s_setprio(1); _Pragma("unroll") for (int m = 0; m < 4; ++m) _Pragma("unroll") for (int n = 0; n < 2; ++n) { \
        if constexpr (F8) asm volatile("v_mfma_f32_16x16x128_f8f6f4 %0, %1, %2, %0" : "+v"(acc[ai][bj][m][n]) : "v"(Bt##8[n]), "v"(At##8[m]));   \
        else if constexpr (I8) { _Pragma("unroll") for (int k = 0; k < 2; ++k) acc[ai][bj][m][n] = __builtin_bit_cast(f32x4, __builtin_amdgcn_mfma_i32_16x16x64_i8(__builtin_bit_cast(v4i_t, Bt[n][k]), __builtin_bit_cast(v4i_t, At[m][k]), __builtin_bit_cast(v4i_t, acc[ai][bj][m][n]), 0, 0, 0)); } \
        else { _Pragma("unroll") for (int k = 0; k < 2; ++k) acc[ai][bj][m][n] = __builtin_amdgcn_mfma_f32_16x16x32_bf16(Bt[n][k], At[m][k], acc[ai][bj][m][n], 0, 0, 0); } } \
        __builtin_amdgcn_s_setprio(0); } while (0)
#define PG8_WAIT_V(n) asm volatile("s_waitcnt vmcnt(" #n ")" ::: "memory")
#define PG8_WAIT_L(n) asm volatile("s_waitcnt lgkmcnt(" #n ")" ::: "memory")
#define PG8_PREFETCH() do { const int prow_ = (wid & 3) * 64 + (int)__builtin_amdgcn_mbcnt_hi(~0u, __builtin_amdgcn_mbcnt_lo(~0u, 0u));     \
        const char* pb_ = (wid & 4) ? nB + (size_t)prow_ * ldb * 2 : nA + (size_t)prow_ * lda * 2; \
        _Pragma("unroll") for (int c_ = 0; c_ < 6; ++c_) { const int cc_ = (2 + c_ < nt) ? 2 + c_ : nt - 1; \
            __builtin_amdgcn_global_load_lds((const unsigned*)(pb_ + (size_t)cc_ * 128), (LAS unsigned*)(lds + 131072 + wid * 256), 4, 0, 0); } } while (0)
#define PG8_WAIT_V8P do { if (pfi) asm volatile("s_waitcnt vmcnt(14)" ::: "memory"); else asm volatile("s_waitcnt vmcnt(8)" ::: "memory"); } while (0)
#define PG8_BAR __builtin_amdgcn_s_barrier()
#define PG8_SCHED __builtin_amdgcn_sched_barrier(0)
    Unit cur, nxt; int ui = 0;
    if (!S.next(0, cur)) return;
    f32x4 acc[2][2][4][2];
#pragma unroll
    for (int a = 0; a < 2; ++a)
#pragma unroll
        for (int b = 0; b < 2; ++b)
#pragma unroll
            for (int m = 0; m < 4; ++m)
#pragma unroll
                for (int n = 0; n < 2; ++n) acc[a][b][m][n] = (f32x4){0.f, 0.f, 0.f, 0.f};
    bf16x8 At[4][2], B0[2][2], B1[2][2]; v8i_t At8[4], B08[2], B18[2]; (void)At; (void)B0; (void)B1; (void)At8; (void)B08; (void)B18;
    const char* cA = cur.A; const char* cB = cur.B;
    PG8_STAGE(PG8_SB(0, 0), cB, voffB); PG8_STAGE(PG8_SB(0, 1), cB + hB, voffB); PG8_STAGE(PG8_SA(0, 0), cA, voffA); PG8_STAGE(PG8_SA(0, 1), cA + hA, voffA);
    if (wr == 1) PG8_BAR;
    PG8_WAIT_V(2); PG8_BAR;
    PG8_STAGE(PG8_SB(1, 0), cB + kstep, voffB); PG8_STAGE(PG8_SA(1, 0), cA + kstep, voffA); PG8_STAGE(PG8_SB(1, 1), cB + hB + kstep, voffB);
    PG8_WAIT_V(6); PG8_BAR;
    for (;;) {
        const bool has_next = S.next(ui + 1, nxt);
        const char* nA = has_next ? nxt.A : cA; const char* nB = has_next ? nxt.B : cB;
#ifdef KREP
#pragma unroll 1
        for (int kr = 0; kr < (I8 ? KREP : 1); ++kr) { const char* eA = (kr == (I8 ? KREP : 1) - 1) ? nA : cA; const char* eB = (kr == (I8 ? KREP : 1) - 1) ? nB : cB;
#else
        { const char* eA = nA; const char* eB = nB;
#endif
#pragma unroll 1
        for (int t = 0; t < nt; t += 2) {
            const bool last = (t == nt - 2);
            const bool pfi = PF && last && has_next;
            const char* a1 = cA + (size_t)(t + 1) * kstep;
            const char* a2 = last ? eA : cA + (size_t)(t + 2) * kstep; const char* b2 = last ? eB : cB + (size_t)(t + 2) * kstep;
            const char* a3 = a2 + kstep; const char* b3 = b2 + kstep;
            PG8_LDB(B0, 0, 0); PG8_LDB(B1, 0, 1); PG8_SCHED; PG8_LDA(At, 0, 0); PG8_STAGE(PG8_SA(1, 1), a1 + hA, voffA);
            PG8_WAIT_V(8); PG8_WAIT_L(0); PG8_BAR; PG8_MMA(0, 0, At, B0); PG8_MMA(0, 1, At, B1); PG8_BAR; PG8_SCHED;
            PG8_LDA(At, 0, 1); if (pfi) PG8_PREFETCH(); PG8_STAGE(PG8_SB(0, 0), b2, voffB); PG8_STAGE(PG8_SB(0, 1), b2 + hB, voffB); PG8_STAGE(PG8_SA(0, 0), a2, voffA);
            PG8_WAIT_V8P; PG8_WAIT_L(0); PG8_BAR; PG8_MMA(1, 0, At, B0); PG8_MMA(1, 1, At, B1); PG8_BAR; PG8_SCHED;
            PG8_LDB(B0, 1, 0); PG8_LDB(B1, 1, 1); PG8_SCHED; PG8_LDA(At, 1, 0); PG8_STAGE(PG8_SA(0, 1), a2 + hA, voffA);
            PG8_WAIT_V8P; PG8_WAIT_L(0); PG8_BAR; PG8_MMA(0, 0, At, B0); PG8_MMA(0, 1, At, B1); PG8_BAR; PG8_SCHED;
            PG8_LDA(At, 1, 1); PG8_STAGE(PG8_SB(1, 0), b3, voffB); PG8_STAGE(PG8_SB(1, 1), b3 + hB, voffB); PG8_STAGE(PG8_SA(1, 0), a3, voffA);
            PG8_WAIT_V(8); PG8_WAIT_L(0); PG8_BAR; PG8_MMA(1, 0, At, B0); PG8_MMA(1, 1, At, B1); PG8_BAR; PG8_SCHED;
        }
        }
        if (wr == 0) PG8_BAR;
        if constexpr (F8) asm volatile("s_nop 15\n\ts_nop 15" ::: "memory");
        { int le_ = (int)__builtin_amdgcn_mbcnt_hi(~0u, __builtin_amdgcn_mbcnt_lo(~0u, 0u)); asm volatile("" : "+v"(le_));
          E(acc, cur, wr, wc, le_ & 15, le_ >> 4); }
#ifdef DUP_EPI
        if constexpr (I8) { asm volatile("" ::: "memory"); E(acc, cur, wr, wc, fr, fq); }
#endif
        if (!has_next) break;
#pragma unroll
        for (int a = 0; a < 2; ++a)
#pragma unroll
            for (int b = 0; b < 2; ++b)
#pragma unroll
                for (int m = 0; m < 4; ++m)
#pragma unroll
                    for (int n = 0; n < 2; ++n) acc[a][b][m][n] = (f32x4){0.f, 0.f, 0.f, 0.f};
        cur = nxt; cA = nA; cB = nB; ++ui;
        if (wr == 1) PG8_BAR;
    }
    PG8_WAIT_V(0);
    PG8_BAR;
#undef PG8_SA
#undef PG8_SB
#undef PG8_STAGE
#undef PG8_LDA
#undef PG8_LDB
#undef PG8_MMA
#undef PG8_WAIT_V
#undef PG8_PREFETCH
#undef PG8_WAIT_V8P
#undef PG8_WAIT_L
#undef PG8_BAR
#undef PG8_SCHED
}
struct EpiStoreS {
    static constexpr bool PERM = true;
    bf16_t* O; int ldc; float scale;
    __device__ __forceinline__ void operator()(const f32x4 (&acc)[2][2][4][2], const Unit& u, int wr, int wc, int fr, int fq) const {
        const int row0 = u.pm * BM + wr * 64 + fr, col0 = u.pn * BM + wc * 32 + 8 * fq;
#pragma unroll
        for (int ai = 0; ai < 2; ++ai)
#pragma unroll
            for (int m = 0; m < 4; ++m) { bf16_t* rowp = O + (size_t)(row0 + ai * HALF + m * 16) * ldc + col0;
#pragma unroll
                for (int bj = 0; bj < 2; ++bj) { const f32x4 v0 = acc[ai][bj][m][0] * scale, v1 = acc[ai][bj][m][1] * scale;
                    u32x4 w; w.x = cvt_pk_bf16(v0[0], v0[1]); w.y = cvt_pk_bf16(v0[2], v0[3]); w.z = cvt_pk_bf16(v1[0], v1[1]); w.w = cvt_pk_bf16(v1[2], v1[3]);
                    *(u32x4*)(rowp + bj * HALF) = w; } }
    }
};
struct EpiStore {
    static constexpr bool PERM = true;
    bf16_t* O; int ldc;
    __device__ __forceinline__ void operator()(const f32x4 (&acc)[2][2][4][2], const Unit& u, int wr, int wc, int fr, int fq) const {
        const int row0 = u.pm * BM + wr * 64 + fr, col0 = u.pn * BM + wc * 32 + 8 * fq;
#pragma unroll
        for (int ai = 0; ai < 2; ++ai)
#pragma unroll
            for (int m = 0; m < 4; ++m) { bf16_t* rowp = O + (size_t)(row0 + ai * HALF + m * 16) * ldc + col0;
#pragma unroll
                for (int bj = 0; bj < 2; ++bj) { const f32x4 v0 = acc[ai][bj][m][0], v1 = acc[ai][bj][m][1];
                    u32x4 w; w.x = cvt_pk_bf16(v0[0], v0[1]); w.y = cvt_pk_bf16(v0[2], v0[3]); w.z = cvt_pk_bf16(v1[0], v1[1]); w.w = cvt_pk_bf16(v1[2], v1[3]);
                    *(u32x4*)(rowp + bj * HALF) = w; } }
    }
};
__device__ __forceinline__ float fsig(float v) { return __builtin_amdgcn_rcpf(1.f + __builtin_amdgcn_exp2f(-1.4426950408889634f * v)); }
template <bool GLU> struct EpiPair {
    static constexpr bool PERM = true;
    bf16_t* O; int ldc; int col_off;
    __device__ __forceinline__ void operator()(const f32x4 (&acc)[2][2][4][2], const Unit& u, int wr, int wc, int fr, int fq) const {
        const int row0 = u.pm * BM + wr * 64 + fr, col0 = col_off + u.pn * 128 + wc * 16 + 4 * fq;
#pragma unroll
        for (int ai = 0; ai < 2; ++ai)
#pragma unroll
            for (int m = 0; m < 4; ++m) { bf16_t* rowp = O + (size_t)(row0 + ai * HALF + m * 16) * ldc + col0;
#pragma unroll
                for (int bj = 0; bj < 2; ++bj) { const f32x4 v0 = acc[ai][bj][m][0], v1 = acc[ai][bj][m][1];
                    float o0, o1, o2, o3;
                    if (GLU) { o0 = v0[0] * fsig(v0[1]); o1 = v0[2] * fsig(v0[3]); o2 = v1[0] * fsig(v1[1]); o3 = v1[2] * fsig(v1[3]); }
                    else { o0 = v0[0] * fsig(v0[0]) * v0[1]; o1 = v0[2] * fsig(v0[2]) * v0[3]; o2 = v1[0] * fsig(v1[0]) * v1[1]; o3 = v1[2] * fsig(v1[2]) * v1[3]; }
                    u32x2 w; w.x = cvt_pk_bf16(o0, o1); w.y = cvt_pk_bf16(o2, o3);
                    *(u32x2*)(rowp + bj * 64) = w; } }
    }
};
struct EpiSwiglu8 {
    static constexpr bool PERM = true;
    unsigned char* O; int ldc; float isc, osc;
    __device__ __forceinline__ void operator()(const f32x4 (&acc)[2][2][4][2], const Unit& u, int wr, int wc, int fr, int fq) const {
        const int row0 = u.pm * BM + wr * 64 + fr, col0 = u.pn * 128 + wc * 16 + 4 * fq;
#pragma unroll
        for (int ai = 0; ai < 2; ++ai)
#pragma unroll
            for (int m = 0; m < 4; ++m) { unsigned char* rowp = O + (size_t)(row0 + ai * HALF + m * 16) * ldc + col0;
#pragma unroll
                for (int bj = 0; bj < 2; ++bj) { const f32x4 v0 = acc[ai][bj][m][0] * isc, v1 = acc[ai][bj][m][1] * isc;
                    const float o0 = v0[0] * fsig(v0[0]) * v0[1] * osc, o1 = v0[2] * fsig(v0[2]) * v0[3] * osc, o2 = v1[0] * fsig(v1[0]) * v1[1] * osc, o3 = v1[2] * fsig(v1[2]) * v1[3] * osc;
                    *(unsigned*)(rowp + bj * 64) = pk4_fp8(o0, o1, o2, o3); } }
    }
};
template <bool OUT8> struct EpiSwigluQ {
    static constexpr bool PERM = true;
    bf16_t* O; int ldc; const float* hs; const float* ws; float osc;
    __device__ __forceinline__ void operator()(const f32x4 (&acc)[2][2][4][2], const Unit& u, int wr, int wc, int fr, int fq) const {
        const int row0 = u.pm * BM + wr * 64 + fr, col0 = u.pn * 128 + wc * 16 + 4 * fq;
        const float* wsp_ = ws + u.x0 * (2 * 3584) + u.pn * BM + wc * 32 + 8 * fq;
        constexpr float NL = -1.4426950408889634f;
        const float ob = OUT8 ? osc : 1.f;
        f32x2 sw[2][2][2];
#pragma unroll
        for (int bj = 0; bj < 2; ++bj)
#pragma unroll
            for (int n = 0; n < 2; ++n) { const float4 w = *(const float4*)(wsp_ + bj * HALF + 4 * n); sw[bj][n][0] = (f32x2){w.x, w.y * ob}; sw[bj][n][1] = (f32x2){w.z, w.w * ob}; }
        float hrv[2][4];
#pragma unroll
        for (int ai = 0; ai < 2; ++ai)
#pragma unroll
            for (int m = 0; m < 4; ++m) hrv[ai][m] = hs[row0 + ai * HALF + m * 16] * KSC;
#pragma unroll
        for (int ai = 0; ai < 2; ++ai)
#pragma unroll
            for (int m = 0; m < 4; ++m) { const int row = row0 + ai * HALF + m * 16; bf16_t* rowp = O + (size_t)row * ldc + col0; const float hr = hrv[ai][m]; const f32x2 hr2 = {hr, hr};
#pragma unroll
                for (int bj = 0; bj < 2; ++bj) { float o[4];
#pragma unroll
                    for (int n = 0; n < 2; ++n) { const v4i_t iv = __builtin_bit_cast(v4i_t, acc[ai][bj][m][n]);
                        const f32x2 p0 = (f32x2){(float)iv[0], (float)iv[1]} * (sw[bj][n][0] * hr2), p1 = (f32x2){(float)iv[2], (float)iv[3]} * (sw[bj][n][1] * hr2);
                        o[2 * n] = (p0.x * p0.y) * __builtin_amdgcn_rcpf(1.f + __builtin_amdgcn_exp2f(NL * p0.x));
                        o[2 * n + 1] = (p1.x * p1.y) * __builtin_amdgcn_rcpf(1.f + __builtin_amdgcn_exp2f(NL * p1.x)); }
                    if constexpr (OUT8) { *(unsigned*)((unsigned char*)O + (size_t)row * ldc + col0 + bj * 64) = pk4_fp8(o[0], o[1], o[2], o[3]); continue; }
                    u32x2 w; w.x = cvt_pk_bf16(o[0], o[1]); w.y = cvt_pk_bf16(o[2], o[3]);
                    *(u32x2*)(rowp + bj * 64) = w; } }
    }
};
struct EpiStoreQ {
    static constexpr bool PERM = true;
    bf16_t* O; int ldc; const float* hs; const float* ws;
    __device__ __forceinline__ void operator()(const f32x4 (&acc)[2][2][4][2], const Unit& u, int wr, int wc, int fr, int fq) const {
        const int row0 = u.pm * BM + wr * 64 + fr, col0 = u.pn * BM + wc * 32 + 8 * fq;
        float hrv[2][4];
#pragma unroll
        for (int ai = 0; ai < 2; ++ai)
#pragma unroll
            for (int m = 0; m < 4; ++m) hrv[ai][m] = hs[row0 + ai * HALF + m * 16] * KSC;
        float4 wq[2][2];
#pragma unroll
        for (int bj = 0; bj < 2; ++bj) { wq[bj][0] = *(const float4*)(ws + col0 + bj * HALF); wq[bj][1] = *(const float4*)(ws + col0 + bj * HALF + 4); }
#pragma unroll
        for (int ai = 0; ai < 2; ++ai)
#pragma unroll
            for (int m = 0; m < 4; ++m) { const int row = row0 + ai * HALF + m * 16; bf16_t* rowp = O + (size_t)row * ldc + col0; const float hr = hrv[ai][m];
#pragma unroll
                for (int bj = 0; bj < 2; ++bj) { const v4i_t i0 = __builtin_bit_cast(v4i_t, acc[ai][bj][m][0]), i1 = __builtin_bit_cast(v4i_t, acc[ai][bj][m][1]);
                    const float4 w0 = wq[bj][0], w1 = wq[bj][1];
                    u32x4 w; w.x = cvt_pk_bf16((float)i0[0] * (hr * w0.x), (float)i0[1] * (hr * w0.y)); w.y = cvt_pk_bf16((float)i0[2] * (hr * w0.z), (float)i0[3] * (hr * w0.w));
                    w.z = cvt_pk_bf16((float)i1[0] * (hr * w1.x), (float)i1[1] * (hr * w1.y)); w.w = cvt_pk_bf16((float)i1[2] * (hr * w1.z), (float)i1[3] * (hr * w1.w));
                    *(u32x4*)(rowp + bj * HALF) = w; } }
    }
};
struct EpiGateQ {
    static constexpr bool PERM = true;
    unsigned char* O; int ldc; const float* bias; const float* hs; const float* ws;
    __device__ __forceinline__ void operator()(const f32x4 (&acc)[2][2][4][2], const Unit& u, int wr, int wc, int fr, int fq) const {
        const int row0 = u.pm * BM + wr * 64 + fr, col0 = u.pn * BM + wc * 32 + 8 * fq;
        constexpr float NL = -1.4426950408889634f, K255 = 1.f / 255.f;
        f32x2 sw[2][2][2], bw[2][2][2];
#pragma unroll
        for (int bj = 0; bj < 2; ++bj)
#pragma unroll
            for (int n = 0; n < 2; ++n) { const float4 w = *(const float4*)(ws + col0 + bj * HALF + 4 * n), b = *(const float4*)(bias + col0 + bj * HALF + 4 * n);
                sw[bj][n][0] = (f32x2){w.x * NL, w.y * NL}; sw[bj][n][1] = (f32x2){w.z * NL, w.w * NL}; bw[bj][n][0] = (f32x2){b.x * NL, b.y * NL}; bw[bj][n][1] = (f32x2){b.z * NL, b.w * NL}; }
        float hrv[2][4];
#pragma unroll
        for (int ai = 0; ai < 2; ++ai)
#pragma unroll
            for (int m = 0; m < 4; ++m) hrv[ai][m] = hs[row0 + ai * HALF + m * 16] * KSC;
#pragma unroll
        for (int ai = 0; ai < 2; ++ai)
#pragma unroll
            for (int m = 0; m < 4; ++m) { const int row = row0 + ai * HALF + m * 16; const float hr = hrv[ai][m]; const f32x2 hr2 = {hr, hr}, k2 = {K255, K255};
#pragma unroll
                for (int bj = 0; bj < 2; ++bj) { unsigned a[2];
#pragma unroll
                    for (int n = 0; n < 2; ++n) { const v4i_t iv = __builtin_bit_cast(v4i_t, acc[ai][bj][m][n]);
                        const f32x2 z0 = (f32x2){(float)iv[0], (float)iv[1]} * (sw[bj][n][0] * hr2) + bw[bj][n][0], z1 = (f32x2){(float)iv[2], (float)iv[3]} * (sw[bj][n][1] * hr2) + bw[bj][n][1];
                        const f32x2 x0 = (f32x2){__builtin_amdgcn_exp2f(z0.x), __builtin_amdgcn_exp2f(z0.y)} * k2 + k2, x1 = (f32x2){__builtin_amdgcn_exp2f(z1.x), __builtin_amdgcn_exp2f(z1.y)} * k2 + k2;
                        unsigned t = 0;
                        t = __builtin_amdgcn_cvt_pk_u8_f32(__builtin_amdgcn_rcpf(x0.x), 0, t); t = __builtin_amdgcn_cvt_pk_u8_f32(__builtin_amdgcn_rcpf(x0.y), 1, t);
                        t = __builtin_amdgcn_cvt_pk_u8_f32(__builtin_amdgcn_rcpf(x1.x), 2, t); t = __builtin_amdgcn_cvt_pk_u8_f32(__builtin_amdgcn_rcpf(x1.y), 3, t); a[n] = t; }
                    *(u32x2*)(O + (size_t)row * ldc + col0 + bj * HALF) = (u32x2){a[0], a[1]}; } }
    }
};
}

constexpr int NWAVES = 8, NTHR = 512;
constexpr int LDS_BYTES = 147456;
__device__ __forceinline__ unsigned f2bf(float f) { unsigned u = __builtin_bit_cast(unsigned, f); return (u + 0x7fffu + ((u >> 16) & 1u)) >> 16; }
__device__ __forceinline__ unsigned pk2(float lo, float hi) { return f2bf(lo) | (f2bf(hi) << 16); }
__device__ __forceinline__ float bf2f(unsigned short b) { return __builtin_bit_cast(float, (unsigned)b << 16); }
#define LDS_WAIT() asm volatile("s_waitcnt lgkmcnt(0)" ::: "memory")
__device__ __forceinline__ void transpose_item(const float* W, int ldw, int nblk, bf16_t* WT, int ldo, int row_off, int row_mul, int k_off, const float* kscale, LAS float* scr, int item, int lane) {
    const int kb = item / nblk, nb = item % nblk, k0 = 64 * kb, n0 = 32 * nb;
#pragma unroll 8
    for (int i = 0; i < 32; ++i) { const int kk = 2 * i + (lane >> 5); float v = W[(size_t)(k0 + kk) * ldw + n0 + (lane & 31)]; if (kscale) v *= kscale[k0 + kk]; scr[kk * 33 + (lane & 31)] = v; }
    LDS_WAIT(); asm volatile("" ::: "memory");
    const int c = lane & 7;
#pragma unroll
    for (int j = 0; j < 4; ++j) { const int n = (lane >> 3) + 8 * j; const LAS float* s = scr + (8 * c) * 33 + n;
        u32x4 o; o.x = pk2(s[0 * 33], s[1 * 33]); o.y = pk2(s[2 * 33], s[3 * 33]); o.z = pk2(s[4 * 33], s[5 * 33]); o.w = pk2(s[6 * 33], s[7 * 33]);
        *(u32x4*)(WT + (size_t)(row_off + (n0 + n) * row_mul) * ldo + k_off + k0 + 8 * c) = o; }
    LDS_WAIT(); asm volatile("" ::: "memory");
}
__device__ __forceinline__ void transpose_item8(const float* W, int ldw, int nblk, unsigned char* WT, int ldo, int row_off, int row_mul, float scale, LAS float* scr, int item, int lane) {
    const int kb = item / nblk, nb = item % nblk, k0 = 64 * kb, n0 = 32 * nb;
#pragma unroll 8
    for (int i = 0; i < 32; ++i) { const int kk = 2 * i + (lane >> 5); scr[kk * 33 + (lane & 31)] = W[(size_t)(k0 + kk) * ldw + n0 + (lane & 31)] * scale; }
    LDS_WAIT(); asm volatile("" ::: "memory");
    const int c = lane & 7;
#pragma unroll
    for (int j = 0; j < 4; ++j) { const int n = (lane >> 3) + 8 * j; const LAS float* sp = scr + (8 * c) * 33 + n;
        u32x2 o; o.x = pg8::pk4_fp8(sp[0 * 33], sp[1 * 33], sp[2 * 33], sp[3 * 33]); o.y = pg8::pk4_fp8(sp[4 * 33], sp[5 * 33], sp[6 * 33], sp[7 * 33]);
        *(u32x2*)(WT + (size_t)(row_off + (n0 + n) * row_mul) * ldo + k0 + 8 * c) = o; }
    LDS_WAIT(); asm volatile("" ::: "memory");
}
__device__ __forceinline__ unsigned pk4_i8(float a, float b, float c, float d) {
    const int ia = (int)__builtin_rintf(a), ib = (int)__builtin_rintf(b), ic = (int)__builtin_rintf(c), id = (int)__builtin_rintf(d);
    return (unsigned)(ia & 255) | ((unsigned)(ib & 255) << 8) | ((unsigned)(ic & 255) << 16) | ((unsigned)id << 24); }
__device__ __forceinline__ float shx_(float v, int o, int lane) { return __int_as_float(__builtin_amdgcn_ds_bpermute((lane ^ o) << 2, __float_as_int(v))); }
__device__ __forceinline__ void transpose_item_q(const float* W, int K, int ldw, int n0, signed char* WT, int ldo, int row_off, int row_mul, float* wscale, LAS float* scr, int lane) {
    const float* wp = W + (size_t)(lane >> 5) * ldw + n0 + (lane & 31);
    float am = 0.f;
#pragma unroll 16
    for (int i = 0; i < K / 2; ++i) am = fmaxf(am, fabsf(wp[(size_t)(2 * i) * ldw]));
    am = fmaxf(am, shx_(am, 32, lane));
    const float qs = 127.f / fmaxf(am, 1e-30f);
    if (lane < 32) wscale[row_off + (n0 + lane) * row_mul] = am * (1.f / 127.f);
#pragma unroll 1
    for (int kb = 0; kb < K / 64; ++kb) { const int k0 = 64 * kb;
#pragma unroll 8
        for (int i = 0; i < 32; ++i) { const int kk = 2 * i + (lane >> 5); scr[kk * 33 + (lane & 31)] = wp[(size_t)(k0 + 2 * i) * ldw] * qs; }
        LDS_WAIT(); asm volatile("" ::: "memory");
        const int c = lane & 7;
#pragma unroll
        for (int j = 0; j < 4; ++j) { const int n = (lane >> 3) + 8 * j; const LAS float* sp = scr + (8 * c) * 33 + n;
            u32x2 o; o.x = pk4_i8(sp[0 * 33], sp[1 * 33], sp[2 * 33], sp[3 * 33]); o.y = pk4_i8(sp[4 * 33], sp[5 * 33], sp[6 * 33], sp[7 * 33]);
            *(u32x2*)(WT + (size_t)(row_off + (n0 + n) * row_mul) * ldo + k0 + 8 * c) = o; }
        LDS_WAIT(); asm volatile("" ::: "memory"); }
}
__device__ __forceinline__ void colgroup_q_block(const float* W, int ldw, int n0, signed char* WT, int ldo, int row_off, int row_mul, float* wscale, LAS unsigned char* lds) {
    const int tid_ = otid(); const int wave = __builtin_amdgcn_readfirstlane(tid_ >> 6), lane = tid_ & 63;
    LAS float* scr = (LAS float*)(lds + wave * 16384); LAS float* red = (LAS float*)(lds + 12288);
    const float* wp = W + (size_t)(128 * wave + (lane >> 5)) * ldw + n0 + (lane & 31);
    float v[64]; float am = 0.f;
#pragma unroll
    for (int i = 0; i < 64; ++i) v[i] = wp[(size_t)(2 * i) * ldw];
#pragma unroll
    for (int i = 0; i < 64; ++i) am = fmaxf(am, fabsf(v[i]));
    am = fmaxf(am, shx_(am, 32, lane));
    if (lane < 32) red[wave * 4096 + lane] = am;
    __syncthreads();
#pragma unroll
    for (int w = 0; w < 8; ++w) am = fmaxf(am, red[w * 4096 + (lane & 31)]);
    const float qs = 127.f / fmaxf(am, 1e-30f);
    if (wave == 0 && lane < 32) wscale[row_off + (n0 + lane) * row_mul] = am * (1.f / 127.f);
#pragma unroll
    for (int kt = 0; kt < 2; ++kt) { const int k0 = 128 * wave + 64 * kt;
#pragma unroll
        for (int i = 0; i < 32; ++i) scr[(2 * i + (lane >> 5)) * 33 + (lane & 31)] = v[32 * kt + i] * qs;
        LDS_WAIT(); asm volatile("" ::: "memory");
        const int c = lane & 7;
#pragma unroll
        for (int j = 0; j < 4; ++j) { const int n = (lane >> 3) + 8 * j; const LAS float* sp = scr + (8 * c) * 33 + n;
            u32x2 o; o.x = pk4_i8(sp[0 * 33], sp[1 * 33], sp[2 * 33], sp[3 * 33]); o.y = pk4_i8(sp[4 * 33], sp[5 * 33], sp[6 * 33], sp[7 * 33]);
            *(u32x2*)(WT + (size_t)(row_off + (n0 + n) * row_mul) * ldo + k0 + 8 * c) = o; }
        LDS_WAIT(); asm volatile("" ::: "memory"); }
    __syncthreads();
}
__device__ __forceinline__ void conv_matrix8(const float* W, int K, int N, int ldw, unsigned char* WT, int ldo, int row_off, int row_mul, float scale, LAS unsigned char* lds, int& cursor) {
    const int tid_ = otid(); const int wave = __builtin_amdgcn_readfirstlane(tid_ >> 6), lane = tid_ & 63;
    LAS float* scr = (LAS float*)(lds + wave * 16384);
    const int gw = blockIdx.x * NWAVES + wave, NGW = gridDim.x * NWAVES;
    const int nblk = N / 32, nitems = (K / 64) * nblk;
    for (int it = (gw + NGW - (cursor % NGW)) % NGW; it < nitems; it += NGW) transpose_item8(W, ldw, nblk, WT, ldo, row_off, row_mul, scale, scr, it, lane);
    cursor += nitems;
}
__device__ __forceinline__ void conv_matrix(const float* W, int K, int N, int ldw, bf16_t* WT, int ldo, int row_off, int row_mul, int k_off, const float* kscale, LAS unsigned char* lds, int& cursor) {
    const int tid_ = otid(); const int wave = __builtin_amdgcn_readfirstlane(tid_ >> 6), lane = tid_ & 63;
    LAS float* scr = (LAS float*)(lds + wave * 16384);
    const int gw = blockIdx.x * NWAVES + wave, NGW = gridDim.x * NWAVES;
    const int nblk = N / 32, nitems = (K / 64) * nblk;
    for (int it = (gw + NGW - (cursor % NGW)) % NGW; it < nitems; it += NGW) transpose_item(W, ldw, nblk, WT, ldo, row_off, row_mul, k_off, kscale, scr, it, lane);
    cursor += nitems;
}

struct ConvFfn { const float* w1; const float* w3; const float* w2; bf16_t* W13; bf16_t* W2t; };
__global__ __launch_bounds__(NTHR, 2) void k_conv_ffn(ConvFfn a) {
    extern __shared__ __attribute__((aligned(16))) unsigned char lds_raw[];
    LAS unsigned char* lds = (LAS unsigned char*)lds_raw;
    int cursor = 0;
    conv_matrix(a.w1, D, DFF, DFF, a.W13, D, 0, 2, 0, nullptr, lds, cursor);
    conv_matrix(a.w3, D, DFF, DFF, a.W13, D, 1, 2, 0, nullptr, lds, cursor);
    conv_matrix(a.w2, DFF, D, D, a.W2t, DFF, 0, 1, 0, nullptr, lds, cursor);
}
struct GemmArgs { const bf16_t* A; const bf16_t* B; bf16_t* O; int nM, nN, K, lda, ldb, ldc, col_off, pad; };
template <class Epi> __global__ __launch_bounds__(NTHR, 2) void k_gemm(GemmArgs a) {
    extern __shared__ __attribute__((aligned(16))) unsigned char lds_raw[];
    LAS unsigned char* lds = (LAS unsigned char*)lds_raw;
    pg8::StaticOrder S; S.init(a.nM, a.nN, (int)gridDim.x, (int)blockIdx.x, a.A, a.lda, a.B, a.ldb);
    Epi E; E.O = a.O; E.ldc = a.ldc; if constexpr (!std::is_same<Epi, pg8::EpiStore>::value) E.col_off = a.col_off;
    pg8::gemm_phase<Epi, pg8::StaticOrder>(lds, a.K, a.lda, a.ldb, S, E);
}
template <bool YBF> __global__ __launch_bounds__(256) void k_lnh(float* X, const void* Yv, const float* MODl, int goff, const float* g, const float* bta, float* out, bf16_t* H, const float* MODh, int hsh, int hsc) {
    const int r = blockIdx.x * 4 + (threadIdx.x >> 6), lane = threadIdx.x & 63;
    const float* md = MODl + (size_t)modrow(r) * 6144 + goff;
    float v[16]; float s = 0.f;
#pragma unroll
    for (int j = 0; j < 4; ++j) { const int c = j * 256 + lane * 4; const float4 x4 = *(const float4*)(X + (size_t)r * D + c), m4 = *(const float4*)(md + c);
        float y0, y1, y2, y3;
        if (YBF) { const u32x2 yw = *(const u32x2*)((const bf16_t*)Yv + (size_t)r * D + c);
            y0 = __builtin_bit_cast(float, yw.x << 16); y1 = __builtin_bit_cast(float, yw.x & 0xffff0000u); y2 = __builtin_bit_cast(float, yw.y << 16); y3 = __builtin_bit_cast(float, yw.y & 0xffff0000u); }
        else { const float4 y4 = *(const float4*)((const float*)Yv + (size_t)r * D + c); y0 = y4.x; y1 = y4.y; y2 = y4.z; y3 = y4.w; }
        v[j * 4] = ALPHA * x4.x + m4.x * y0; v[j * 4 + 1] = ALPHA * x4.y + m4.y * y1; v[j * 4 + 2] = ALPHA * x4.z + m4.z * y2; v[j * 4 + 3] = ALPHA * x4.w + m4.w * y3;
        s += v[j * 4] + v[j * 4 + 1] + v[j * 4 + 2] + v[j * 4 + 3]; }
#pragma unroll
    for (int o = 1; o < 64; o <<= 1) s += __shfl_xor(s, o);
    const float mean = s / D; float q = 0.f;
#pragma unroll
    for (int j = 0; j < 16; ++j) { v[j] -= mean; q += v[j] * v[j]; }
#pragma unroll
    for (int o = 1; o < 64; o <<= 1) q += __shfl_xor(q, o);
    const float rstd = rsqrtf(q / D + 1e-5f);
    const float* mh = MODh ? MODh + (size_t)modrow(r) * 6144 : nullptr;
#pragma unroll
    for (int j = 0; j < 4; ++j) { const int c = j * 256 + lane * 4; const float4 g4 = *(const float4*)(g + c), b4 = *(const float4*)(bta + c);
        float4 o4; o4.x = v[j * 4] * rstd * g4.x + b4.x; o4.y = v[j * 4 + 1] * rstd * g4.y + b4.y; o4.z = v[j * 4 + 2] * rstd * g4.z + b4.z; o4.w = v[j * 4 + 3] * rstd * g4.w + b4.w;
        *(float4*)(X + (size_t)r * D + c) = o4; if (out && r < TL) *(float4*)(out + (size_t)r * D + c) = o4;
        if (H) { const float4 sc = *(const float4*)(mh + hsc + c), sh = *(const float4*)(mh + hsh + c);
            u32x2 w; w.x = pk2(o4.x * (1.f + sc.x) + sh.x, o4.y * (1.f + sc.y) + sh.y); w.y = pk2(o4.z * (1.f + sc.z) + sh.z, o4.w * (1.f + sc.w) + sh.w);
            *(u32x2*)(H + (size_t)r * D + c) = w; } }
}


constexpr int MAXTILES = 288;
__global__ __launch_bounds__(256) void k_route2(const float* X, const float* MODl, const float* wr, int* plan, int* ltok, int* tslot, float* tgate) {
    const int r = blockIdx.x * 4 + (threadIdx.x >> 6), lane = threadIdx.x & 63;
    const float* md = MODl + (size_t)modrow(r) * 6144;
    float lg[8];
#pragma unroll
    for (int e = 0; e < 8; ++e) lg[e] = 0.f;
    for (int j = 0; j < 16; ++j) { const int k = j * 64 + lane; const float hv = X[(size_t)r * D + k] * (1.f + md[4 * D + k]) + md[3 * D + k];
        const float4 w0 = *(const float4*)(wr + k * 8), w1 = *(const float4*)(wr + k * 8 + 4);
        lg[0] += hv * w0.x; lg[1] += hv * w0.y; lg[2] += hv * w0.z; lg[3] += hv * w0.w; lg[4] += hv * w1.x; lg[5] += hv * w1.y; lg[6] += hv * w1.z; lg[7] += hv * w1.w; }
#pragma unroll
    for (int e = 0; e < 8; ++e)
#pragma unroll
        for (int o = 1; o < 64; o <<= 1) lg[e] += __shfl_xor(lg[e], o);
    if (lane == 0) {
        int e1 = 0; float v1 = lg[0];
#pragma unroll
        for (int e = 1; e < 8; ++e) if (lg[e] > v1) { v1 = lg[e]; e1 = e; }
        int e2 = -1; float v2 = -3e38f;
#pragma unroll
        for (int e = 0; e < 8; ++e) if (e != e1 && lg[e] > v2) { v2 = lg[e]; e2 = e; }
        const float p2 = expf(v2 - v1), g1 = 1.f / (1.f + p2), g2 = p2 / (1.f + p2);
        const int s1 = atomicAdd(plan + e1, 1); ltok[e1 * T + s1] = r; tslot[r * 2] = e1 * T + s1; tgate[r * 2] = g1;
        const int s2 = atomicAdd(plan + e2, 1); ltok[e2 * T + s2] = r; tslot[r * 2 + 1] = e2 * T + s2; tgate[r * 2 + 1] = g2;
    }
}
__global__ void k_moe_plan(int* plan) {
    if (threadIdx.x == 0) { int start = 0;
        for (int e = 0; e < 8; ++e) { const int nt = (plan[e] + 255) >> 8; plan[8 + e] = start * 256; for (int t = 0; t < nt; ++t) plan[32 + start + t] = e; start += nt; }
        plan[16] = start; }
}
__global__ __launch_bounds__(256) void k_gather(const bf16_t* H, bf16_t* Hg, const int* plan, const int* ltok) {
    const int pr = blockIdx.x * 4 + (threadIdx.x >> 6), lane = threadIdx.x & 63;
    if (pr >= plan[16] * 256) return;
    const int e = plan[32 + (pr >> 8)], slot = pr - plan[8 + e];
    u32x4 v0 = (u32x4){0u, 0u, 0u, 0u}, v1 = v0;
    if (slot < plan[e]) { const int tok = ltok[e * T + slot]; const u32x4* src = (const u32x4*)(H + (size_t)tok * D); v0 = src[lane]; v1 = src[64 + lane]; }
    u32x4* dst = (u32x4*)(Hg + (size_t)pr * D); dst[lane] = v0; dst[64 + lane] = v1;
}
namespace pg8 {
struct MoeOrder {
    int nM, nN, nwg, G, c; const int* tileE; const char* A; const char* B; size_t tA, tB, tBe;
    __device__ void init(const int* plan, int nN_, int G_, int c_, const void* A_, int lda, const void* B_, int ldb, size_t expert_elems) {
        nM = plan[16]; nN = nN_; nwg = nM * nN; G = G_; c = c_; tileE = plan + 32; A = (const char*)A_; B = (const char*)B_; tA = (size_t)BM * lda * 2; tB = (size_t)BM * ldb * 2; tBe = expert_elems * 2; }
    __device__ bool next(int i, Unit& u) const {
        const long L = (long)i * G + c; if (L >= nwg) return false;
        int wgid = (int)L; { const int q = nwg / NXCD, r = nwg % NXCD, xcd = wgid % NXCD, off = wgid / NXCD; wgid = (xcd < r ? xcd * (q + 1) : r * (q + 1) + (xcd - r) * q) + off; }
        const int nig = WGM * nN, gid = wgid / nig, fm = gid * WGM, gsz = (nM - fm) < WGM ? (nM - fm) : WGM;
        u.pm = fm + ((wgid % nig) % gsz); u.pn = (wgid % nig) / gsz; u.x0 = tileE[u.pm]; u.x1 = 0;
        u.A = A + (size_t)u.pm * tA; u.B = B + (size_t)u.x0 * tBe + (size_t)u.pn * tB; return true;
    }
};
}
struct MoeGemmArgs { const bf16_t* A; const bf16_t* B; bf16_t* O; const int* plan; int nN, K, lda, ldb, ldc, pad; size_t expert_elems; };
template <class Epi> __global__ __launch_bounds__(NTHR, 2) void k_gemm_moe(MoeGemmArgs a) {
    extern __shared__ __attribute__((aligned(16))) unsigned char lds_raw[];
    LAS unsigned char* lds = (LAS unsigned char*)lds_raw;
    pg8::MoeOrder S; S.init(a.plan, a.nN, (int)gridDim.x, (int)blockIdx.x, a.A, a.lda, a.B, a.ldb, a.expert_elems);
    Epi E; E.O = a.O; E.ldc = a.ldc; if constexpr (!std::is_same<Epi, pg8::EpiStore>::value) E.col_off = 0;
    pg8::gemm_phase<Epi, pg8::MoeOrder>(lds, a.K, a.lda, a.ldb, S, E);
}
struct ConvMoe { const float* w1; const float* w3; const float* w2; bf16_t* W13; bf16_t* W2t; };
__global__ __launch_bounds__(NTHR, 2) void k_conv_moe(ConvMoe a) {
    extern __shared__ __attribute__((aligned(16))) unsigned char lds_raw[];
    LAS unsigned char* lds = (LAS unsigned char*)lds_raw;
    int cursor = 0;
    for (int e = 0; e < NE; ++e) {
        conv_matrix(a.w1 + (size_t)e * D * DFF, D, DFF, DFF, a.W13 + (size_t)e * 2 * DFF * D, D, 0, 2, 0, nullptr, lds, cursor);
        conv_matrix(a.w3 + (size_t)e * D * DFF, D, DFF, DFF, a.W13 + (size_t)e * 2 * DFF * D, D, 1, 2, 0, nullptr, lds, cursor);
        conv_matrix(a.w2 + (size_t)e * DFF * D, DFF, D, D, a.W2t + (size_t)e * D * DFF, DFF, 0, 1, 0, nullptr, lds, cursor);
    }
}
__global__ __launch_bounds__(256) void k_ln_moe(float* X, const bf16_t* Y2, const int* plan, const int* tslot, const float* tgate, const float* MODl, int goff, const float* g, const float* bta, float* out, bf16_t* H, const float* MODh) {
    const int r = blockIdx.x * 4 + (threadIdx.x >> 6), lane = threadIdx.x & 63;
    const float* md = MODl + (size_t)modrow(r) * 6144 + goff;
    const int t0 = tslot[r * 2], t1 = tslot[r * 2 + 1]; const float g0 = tgate[r * 2], g1 = tgate[r * 2 + 1];
    const int e0 = t0 / T, e1 = t1 / T; const size_t p0 = (size_t)(plan[8 + e0] + (t0 - e0 * T)), p1 = (size_t)(plan[8 + e1] + (t1 - e1 * T));
    float v[16]; float s = 0.f;
#pragma unroll
    for (int j = 0; j < 4; ++j) { const int c = j * 256 + lane * 4; const float4 x4 = *(const float4*)(X + (size_t)r * D + c), m4 = *(const float4*)(md + c);
        const u32x2 ya = *(const u32x2*)(Y2 + p0 * D + c), yb = *(const u32x2*)(Y2 + p1 * D + c);
        const float y0 = g0 * __builtin_bit_cast(float, ya.x << 16) + g1 * __builtin_bit_cast(float, yb.x << 16), y1 = g0 * __builtin_bit_cast(float, ya.x & 0xffff0000u) + g1 * __builtin_bit_cast(float, yb.x & 0xffff0000u);
        const float y2 = g0 * __builtin_bit_cast(float, ya.y << 16) + g1 * __builtin_bit_cast(float, yb.y << 16), y3 = g0 * __builtin_bit_cast(float, ya.y & 0xffff0000u) + g1 * __builtin_bit_cast(float, yb.y & 0xffff0000u);
        v[j * 4] = ALPHA * x4.x + m4.x * y0; v[j * 4 + 1] = ALPHA * x4.y + m4.y * y1; v[j * 4 + 2] = ALPHA * x4.z + m4.z * y2; v[j * 4 + 3] = ALPHA * x4.w + m4.w * y3;
        s += v[j * 4] + v[j * 4 + 1] + v[j * 4 + 2] + v[j * 4 + 3]; }
#pragma unroll
    for (int o = 1; o < 64; o <<= 1) s += __shfl_xor(s, o);
    const float mean = s / D; float q = 0.f;
#pragma unroll
    for (int j = 0; j < 16; ++j) { v[j] -= mean; q += v[j] * v[j]; }
#pragma unroll
    for (int o = 1; o < 64; o <<= 1) q += __shfl_xor(q, o);
    const float rstd = rsqrtf(q / D + 1e-5f);
#pragma unroll
    for (int j = 0; j < 4; ++j) { const int c = j * 256 + lane * 4; const float4 g4 = *(const float4*)(g + c), b4 = *(const float4*)(bta + c);
        float4 o4; o4.x = v[j * 4] * rstd * g4.x + b4.x; o4.y = v[j * 4 + 1] * rstd * g4.y + b4.y; o4.z = v[j * 4 + 2] * rstd * g4.z + b4.z; o4.w = v[j * 4 + 3] * rstd * g4.w + b4.w;
        *(float4*)(X + (size_t)r * D + c) = o4; if (out && r < TL) *(float4*)(out + (size_t)r * D + c) = o4;
        if (H) { const float* mh = MODh + (size_t)modrow(r) * 6144; const float4 sc = *(const float4*)(mh + D + c), sh = *(const float4*)(mh + c);
            u32x2 w; w.x = pk2(o4.x * (1.f + sc.x) + sh.x, o4.y * (1.f + sc.y) + sh.y); w.y = pk2(o4.z * (1.f + sc.z) + sh.z, o4.w * (1.f + sc.w) + sh.w);
            *(u32x2*)(H + (size_t)r * D + c) = w; } }
}


constexpr int ZC = 2304;
constexpr int NWG = ZC + 4 * D;
namespace pg8 {
struct EpiGate {
    static constexpr bool PERM = true;
    bf16_t* O; int ldc; const float* bias; float isc = 1.f; bool u8 = false;
    __device__ __forceinline__ void operator()(const f32x4 (&acc)[2][2][4][2], const Unit& u, int wr, int wc, int fr, int fq) const {
        const int row0 = u.pm * BM + wr * 64 + fr, col0 = u.pn * BM + wc * 32 + 8 * fq;
        f32x4 bv[2][2];
#pragma unroll
        for (int bj = 0; bj < 2; ++bj)
#pragma unroll
            for (int n = 0; n < 2; ++n) bv[bj][n] = *(const f32x4*)(bias + col0 + bj * HALF + 4 * n);
#pragma unroll
        for (int ai = 0; ai < 2; ++ai)
#pragma unroll
            for (int m = 0; m < 4; ++m) { bf16_t* rowp = O + (size_t)(row0 + ai * HALF + m * 16) * ldc + col0;
#pragma unroll
                for (int bj = 0; bj < 2; ++bj) { const f32x4 v0 = acc[ai][bj][m][0] * isc + bv[bj][0], v1 = acc[ai][bj][m][1] * isc + bv[bj][1];
                    if (u8) { unsigned a0 = 0, a1 = 0;
                        a0 = __builtin_amdgcn_cvt_pk_u8_f32(fsig(v0[0]) * 255.f, 0, a0); a0 = __builtin_amdgcn_cvt_pk_u8_f32(fsig(v0[1]) * 255.f, 1, a0); a0 = __builtin_amdgcn_cvt_pk_u8_f32(fsig(v0[2]) * 255.f, 2, a0); a0 = __builtin_amdgcn_cvt_pk_u8_f32(fsig(v0[3]) * 255.f, 3, a0);
                        a1 = __builtin_amdgcn_cvt_pk_u8_f32(fsig(v1[0]) * 255.f, 0, a1); a1 = __builtin_amdgcn_cvt_pk_u8_f32(fsig(v1[1]) * 255.f, 1, a1); a1 = __builtin_amdgcn_cvt_pk_u8_f32(fsig(v1[2]) * 255.f, 2, a1); a1 = __builtin_amdgcn_cvt_pk_u8_f32(fsig(v1[3]) * 255.f, 3, a1);
                        *(u32x2*)((unsigned char*)O + (size_t)(row0 + ai * HALF + m * 16) * ldc + col0 + bj * HALF) = (u32x2){a0, a1}; continue; }
                    u32x4 w; w.x = cvt_pk_bf16(fsig(v0[0]), fsig(v0[1])); w.y = cvt_pk_bf16(fsig(v0[2]), fsig(v0[3])); w.z = cvt_pk_bf16(fsig(v1[0]), fsig(v1[1])); w.w = cvt_pk_bf16(fsig(v1[2]), fsig(v1[3]));
                    *(u32x4*)(rowp + bj * HALF) = w; } }
    }
};
struct MergeOrder {
    StaticOrder so; const char* A; const char* B; size_t tA;
    __device__ void init(int nM, int G_, int c_, const void* A_, const void* B_) { so.init(nM, 4, G_, c_, A_, D, B_, 256); A = (const char*)A_; B = (const char*)B_; tA = (size_t)BM * D * 2; }
    __device__ bool next(int j, Unit& u) const {
        if (!so.next(j >> 2, u)) return false;
        const int i = j & 3; u.x0 = i;
        u.A = A + (size_t)u.pm * tA + (size_t)i * 256 * 2;
        u.B = B + ((size_t)i * D + (size_t)u.pn * BM) * 256 * 2;
        return true;
    }
};
__device__ __forceinline__ float bflo(unsigned w) { return __builtin_bit_cast(float, w << 16); }
__device__ __forceinline__ float bfhi(unsigned w) { return __builtin_bit_cast(float, w & 0xffff0000u); }
struct EpiMerge {
    static constexpr bool PERM = true;
    bf16_t* M; const bf16_t* G;
    __device__ __forceinline__ void operator()(const f32x4 (&acc)[2][2][4][2], const Unit& u, int wr, int wc, int fr, int fq) const {
        const int i = u.x0;
        const unsigned char* G8p = (const unsigned char*)G + ((size_t)u.pm * BM + (wr * 64 + fr)) * (4 * D) + (size_t)i * D + (size_t)u.pn * BM + wc * 32 + 8 * fq;
        const bf16_t* Gt = G + ((size_t)u.pm * BM * (4 * D) + (size_t)i * D + (size_t)u.pn * BM) + (size_t)((wr * 64 + fr) * (4 * D) + wc * 32 + 8 * fq);
        bf16_t* Mt = M + ((size_t)u.pm * BM * D + (size_t)u.pn * BM) + (size_t)((wr * 64 + fr) * D + wc * 32 + 8 * fq);
        u32x4 g[2][4][2], p[4][2], w[4][2];
#pragma unroll
        for (int ai = 0; ai < 2; ++ai)
#pragma unroll
            for (int m = 0; m < 4; ++m)
#pragma unroll
                for (int bj = 0; bj < 2; ++bj) { if (G8) { const u32x2 gq = *(const u32x2*)(G8p + (size_t)(ai * HALF + m * 16) * (4 * D) + bj * HALF); g[ai][m][bj] = (u32x4){gq.x, gq.y, 0u, 0u}; }
                    else g[ai][m][bj] = *(const u32x4*)(Gt + (size_t)(ai * HALF + m * 16) * (4 * D) + bj * HALF); }
#pragma unroll
        for (int m = 0; m < 4; ++m)
#pragma unroll
            for (int bj = 0; bj < 2; ++bj) { p[m][bj] = (u32x4){0u, 0u, 0u, 0u}; if (i) p[m][bj] = *(const u32x4*)(Mt + (size_t)(m * 16) * D + bj * HALF); }
#pragma unroll
        for (int ai = 0; ai < 2; ++ai) {
#pragma unroll
            for (int m = 0; m < 4; ++m)
#pragma unroll
                for (int bj = 0; bj < 2; ++bj) { const f32x4 v0 = acc[ai][bj][m][0], v1 = acc[ai][bj][m][1]; const u32x4 gg = g[ai][m][bj], pp = p[m][bj]; u32x4 o;
                    if (G8) { constexpr float k = 1.f / 255.f;
                        o.x = cvt_pk_bf16(bflo(pp.x) + (float)(gg.x & 255u) * k * v0[0], bfhi(pp.x) + (float)((gg.x >> 8) & 255u) * k * v0[1]); o.y = cvt_pk_bf16(bflo(pp.y) + (float)((gg.x >> 16) & 255u) * k * v0[2], bfhi(pp.y) + (float)(gg.x >> 24) * k * v0[3]);
                        o.z = cvt_pk_bf16(bflo(pp.z) + (float)(gg.y & 255u) * k * v1[0], bfhi(pp.z) + (float)((gg.y >> 8) & 255u) * k * v1[1]); o.w = cvt_pk_bf16(bflo(pp.w) + (float)((gg.y >> 16) & 255u) * k * v1[2], bfhi(pp.w) + (float)(gg.y >> 24) * k * v1[3]); }
                    else { o.x = cvt_pk_bf16(bflo(pp.x) + bflo(gg.x) * v0[0], bfhi(pp.x) + bfhi(gg.x) * v0[1]); o.y = cvt_pk_bf16(bflo(pp.y) + bflo(gg.y) * v0[2], bfhi(pp.y) + bfhi(gg.y) * v0[3]);
                        o.z = cvt_pk_bf16(bflo(pp.z) + bflo(gg.z) * v1[0], bfhi(pp.z) + bfhi(gg.z) * v1[1]); o.w = cvt_pk_bf16(bflo(pp.w) + bflo(gg.w) * v1[2], bfhi(pp.w) + bfhi(gg.w) * v1[3]); }
                    w[m][bj] = o; }
            if (ai == 0) {
#pragma unroll
                for (int m = 0; m < 4; ++m)
#pragma unroll
                    for (int bj = 0; bj < 2; ++bj) { p[m][bj] = (u32x4){0u, 0u, 0u, 0u}; if (i) p[m][bj] = *(const u32x4*)(Mt + (size_t)(HALF + m * 16) * D + bj * HALF); } }
#pragma unroll
            for (int m = 0; m < 4; ++m)
#pragma unroll
                for (int bj = 0; bj < 2; ++bj) *(u32x4*)(Mt + (size_t)(ai * HALF + m * 16) * D + bj * HALF) = w[m][bj];
        }
    }
};
}
struct ConvMix { const float* w_in; const float* w_gate; const float* w_branch; const float* w_out; bf16_t* WinG; bf16_t* Wbr; bf16_t* Wout; };
__global__ __launch_bounds__(NTHR, 2) void k_conv_mix(ConvMix a) {
    extern __shared__ __attribute__((aligned(16))) unsigned char lds_raw[];
    LAS unsigned char* lds = (LAS unsigned char*)lds_raw;
    int cursor = 0;
    conv_matrix(a.w_in, D, INC, INC, a.WinG, D, 0, 1, 0, nullptr, lds, cursor);
    conv_matrix(a.w_gate, D, 4 * D, 4 * D, a.WinG, D, ZC, 1, 0, nullptr, lds, cursor);
    for (int i = 0; i < 4; ++i) conv_matrix(a.w_branch + (size_t)i * 256 * D, 256, D, D, a.Wbr, 256, i * D, 1, 0, nullptr, lds, cursor);
    conv_matrix(a.w_out, D, D, D, a.Wout, D, 0, 1, 0, nullptr, lds, cursor);
    for (int i = blockIdx.x * NTHR + threadIdx.x; i < (ZC - INC) * D / 8; i += gridDim.x * NTHR) ((u32x4*)(a.WinG + (size_t)INC * D))[i] = (u32x4){0u, 0u, 0u, 0u};
}
struct Gemm2Args { const bf16_t* A; const bf16_t* B; bf16_t* O; const float* bias; const bf16_t* G; int nM, nN, K, lda, ldb, ldc; };
__global__ __launch_bounds__(NTHR, 2) void k_gemm_gate(Gemm2Args a) {
    extern __shared__ __attribute__((aligned(16))) unsigned char lds_raw[];
    LAS unsigned char* lds = (LAS unsigned char*)lds_raw;
    pg8::StaticOrder S; S.init(a.nM, a.nN, (int)gridDim.x, (int)blockIdx.x, a.A, a.lda, a.B, a.ldb);
    pg8::EpiGate E; E.O = a.O; E.ldc = a.ldc; E.bias = a.bias;
    pg8::gemm_phase<pg8::EpiGate, pg8::StaticOrder>(lds, a.K, a.lda, a.ldb, S, E);
}
__global__ __launch_bounds__(NTHR, 2) void k_gemm_merge(Gemm2Args a) {
    extern __shared__ __attribute__((aligned(16))) unsigned char lds_raw[];
    LAS unsigned char* lds = (LAS unsigned char*)lds_raw;
    pg8::MergeOrder S; S.init(a.nM, (int)gridDim.x, (int)blockIdx.x, a.A, a.B);
    pg8::EpiMerge E; E.M = a.O; E.G = a.G;
    pg8::gemm_phase<pg8::EpiMerge, pg8::MergeOrder>(lds, 256, D, 256, S, E);
}
__global__ void k_modh(const float* X, const float* MODl, int sh, int sc, bf16_t* H) {
    const size_t i = ((size_t)blockIdx.x * 256 + threadIdx.x) * 4; const int r = (int)(i >> 10), c = (int)(i & 1023);
    const float* md = MODl + (size_t)modrow(r) * 6144; const float4 x = *(const float4*)(X + i), s4 = *(const float4*)(md + sc + c), h4 = *(const float4*)(md + sh + c);
    u32x2 w; w.x = pk2(x.x * (1.f + s4.x) + h4.x, x.y * (1.f + s4.y) + h4.y); w.y = pk2(x.z * (1.f + s4.z) + h4.z, x.w * (1.f + s4.w) + h4.w);
    *(u32x2*)(H + i) = w;
}
__global__ void k_z_expand(const bf16_t* Zb, float* Z) {
    const size_t i = (size_t)blockIdx.x * 256 + threadIdx.x; if (i >= (size_t)T * INC) return; const size_t r = i / INC, c = i % INC;
    Z[i] = bf2f(Zb[r * ZC + c]);
}
__global__ void k_o_compress(const float* O, bf16_t* Ob) {
    const size_t i = ((size_t)blockIdx.x * 256 + threadIdx.x) * 4; const float4 v = *(const float4*)(O + i);
    u32x2 w; w.x = pk2(v.x, v.y); w.y = pk2(v.z, v.w); *(u32x2*)(Ob + i) = w;
}


constexpr int KB = SQ + CL;
constexpr float C_MLA = 0.10206207261596575f * 1.4426950408889634f, C_DIFF = 0.17677669529663687f * 1.4426950408889634f, C_NA = 0.125f * 1.4426950408889634f;
typedef float f32x16 __attribute__((ext_vector_type(16)));
using pg8::bflo; using pg8::bfhi;
__device__ __forceinline__ float shx(float v, int o, int lane) { return __int_as_float(__builtin_amdgcn_ds_bpermute((lane ^ o) << 2, __float_as_int(v))); }
__device__ __forceinline__ float wave_sum(float v, int lane) {
#pragma unroll
    for (int o = 1; o < 64; o <<= 1) v += shx(v, o, lane);
    return v;
}
__device__ __forceinline__ void zero_rect(bf16_t* W, int ldo, int r0, int r1, int k0, int k1) {
    const int kw = (k1 - k0) / 8, n = (r1 - r0) * kw;
    for (int i = blockIdx.x * NTHR + otid(); i < n; i += gridDim.x * NTHR) { const int r = r0 + i / kw, k = k0 + (i % kw) * 8; *(u32x4*)(W + (size_t)r * ldo + k) = (u32x4){0u, 0u, 0u, 0u}; }
}
struct ConvExp { const float* w_uq; const float* w_ukv; const float* gq; const float* gkv; const float* w_glu; bf16_t* Wexp; bf16_t* Wglu; };
__global__ __launch_bounds__(NTHR, 2) void k_conv_exp(ConvExp a) {
    extern __shared__ __attribute__((aligned(16))) unsigned char lds_raw[];
    LAS unsigned char* lds = (LAS unsigned char*)lds_raw;
    int cursor = 0;
    conv_matrix(a.w_uq, 256, 384, 384, a.Wexp, 384, 0, 1, 0, a.gq, lds, cursor);
    conv_matrix(a.w_ukv, 128, 512, 512, a.Wexp, 384, 384, 1, 256, a.gkv, lds, cursor);
    zero_rect(a.Wexp, 384, 0, 384, 256, 384); zero_rect(a.Wexp, 384, 384, 896, 0, 256); zero_rect(a.Wexp, 384, 896, 1024, 0, 384);
    conv_matrix(a.w_glu, 256, 256, 512, a.Wglu, 256, 0, 2, 0, nullptr, lds, cursor);
    conv_matrix(a.w_glu + 256, 256, 256, 512, a.Wglu, 256, 1, 2, 0, nullptr, lds, cursor);
}
struct PrepArgs { const bf16_t* ZB; const bf16_t* EB; bf16_t* QM; bf16_t* KM; bf16_t* QD; bf16_t* KD; bf16_t* VTN; bf16_t* VTM; bf16_t* VTD; };
__device__ __forceinline__ void prep_row(const PrepArgs& a, int r, int lane) {
    const bf16_t* z = a.ZB + (size_t)r * ZC; const bf16_t* e = a.EB + (size_t)r * D;
    float sq, sk;
    { const u32x2 w = *(const u32x2*)(z + O_MQ + 4 * lane); const float a0 = bflo(w.x), a1 = bfhi(w.x), a2 = bflo(w.y), a3 = bfhi(w.y); sq = a0 * a0 + a1 * a1 + a2 * a2 + a3 * a3;
      const unsigned v = *(const unsigned*)(z + O_MKV + 2 * lane); const float b0 = bflo(v), b1 = bfhi(v); sk = b0 * b0 + b1 * b1; }
    sq = wave_sum(sq, lane); sk = wave_sum(sk, lane);
    const float rq = rsqrtf(sq * (1.f / 256.f) + 1e-6f), rk = rsqrtf(sk * (1.f / 128.f) + 1e-6f);
    const bool lat = r < TL; const int t = r & (SQ - 1), j = lane & 31;
    float sn = 0.f, cs = 1.f;
    if (lat) { const float pos = (float)((j & 16) ? (t & 63) : (t >> 6)); const float inv = exp2f(-(float)(j & 7) * 0.125f * 13.287712379549449f); sincosf(pos * inv, &sn, &cs); }
#define ROPE(v) ({ const float v_ = (v); const float p_ = shx(v_, 8, lane); (j & 8) ? (p_ * sn + v_ * cs) : (v_ * cs - p_ * sn); })
#pragma unroll
    for (int h = 0; h < 4; ++h) {
        a.QM[((size_t)h * T + r) * 96 + lane] = (bf16_t)f2bf(bf2f(e[h * 96 + lane]) * rq * C_MLA);
        a.KM[((size_t)h * T + r) * 96 + lane] = (bf16_t)f2bf(bf2f(e[384 + h * 128 + lane]) * rk);
    }
#pragma unroll
    for (int p = 0; p < 2; ++p) { const int hh = 2 * p + (lane >> 5); const float v = ROPE(bf2f(e[hh * 96 + 64 + j]) * rq); a.QM[((size_t)hh * T + r) * 96 + 64 + j] = (bf16_t)f2bf(v * C_MLA); }
    { const float v = ROPE(bf2f(z[O_MKR + j])); const bf16_t o = (bf16_t)f2bf(v); const int h0 = (lane >> 5) * 2;
      a.KM[((size_t)h0 * T + r) * 96 + 64 + j] = o; a.KM[((size_t)(h0 + 1) * T + r) * 96 + 64 + j] = o; }
#pragma unroll
    for (int p = 0; p < 4; ++p) { const int vec = 2 * p + (lane >> 5);
        const float vq = ROPE(bf2f(z[O_DQ + vec * 32 + j])); a.QD[((size_t)vec * T + r) * 32 + j] = (bf16_t)f2bf(vq * C_DIFF);
        const float vk = ROPE(bf2f(z[O_DK + vec * 32 + j])); a.KD[((size_t)vec * T + r) * 32 + j] = (bf16_t)f2bf(vk); }
#undef ROPE
}
__device__ __forceinline__ void prep_vt_tile(const PrepArgs& a, int ti, LAS unsigned char* lds) {
    const int tid = otid(), wave = tid >> 6, lane = tid & 63;
    const int r0 = ti * 64; const bool lat = r0 < TL;
    const int b = lat ? (r0 >> 12) : ((r0 - TL) >> 8), slot0 = lat ? (r0 & (SQ - 1)) : (SQ + ((r0 - TL) & (CL - 1)));
    LAS bf16_t* tile = (LAS bf16_t*)lds;
    for (int src = 0; src < 3; ++src) {
        bf16_t* dst = src == 0 ? a.VTN : (src == 1 ? a.VTM : a.VTD);
        for (int i = 0; i < 8; ++i) { const int tok = wave * 8 + i, r = r0 + tok;
            float v0, v1, v2, v3;
            if (src == 1) { const bf16_t* z = a.ZB + (size_t)r * ZC; const unsigned kv = *(const unsigned*)(z + O_MKV + 2 * lane); const float b0 = bflo(kv), b1 = bfhi(kv);
                const float rk = rsqrtf(wave_sum(b0 * b0 + b1 * b1, lane) * (1.f / 128.f) + 1e-6f);
                const int c = 4 * lane, h = c >> 6, d = c & 63; const u32x2 w = *(const u32x2*)(a.EB + (size_t)r * D + 384 + h * 128 + 64 + d);
                v0 = bflo(w.x) * rk; v1 = bfhi(w.x) * rk; v2 = bflo(w.y) * rk; v3 = bfhi(w.y) * rk; }
            else { const u32x2 w = *(const u32x2*)(a.ZB + (size_t)r * ZC + (src == 0 ? O_NAV : O_DV) + 4 * lane); v0 = bflo(w.x); v1 = bfhi(w.x); v2 = bflo(w.y); v3 = bfhi(w.y); }
            tile[(4 * lane + 0) * 72 + tok] = (bf16_t)f2bf(v0); tile[(4 * lane + 1) * 72 + tok] = (bf16_t)f2bf(v1); tile[(4 * lane + 2) * 72 + tok] = (bf16_t)f2bf(v2); tile[(4 * lane + 3) * 72 + tok] = (bf16_t)f2bf(v3); }
        __syncthreads();
        for (int i = tid; i < 1024; i += NTHR) { const int row = i >> 2, g = i & 3; const LAS u32x2* p = (const LAS u32x2*)(tile + row * 72 + g * 16);
            const u32x2 q0 = p[0], q1 = p[1], q2 = p[2], q3 = p[3];
            bf16_t* o = dst + ((size_t)(b * 4 + (row >> 6)) * 64 + (row & 63)) * KB + slot0 + g * 16;
            *(u32x4*)o = (u32x4){q0.x, q0.y, q2.x, q2.y}; *(u32x4*)(o + 8) = (u32x4){q1.x, q1.y, q3.x, q3.y}; }
        __syncthreads();
    }
}
template <int NT> __device__ __forceinline__ void prep_rows_fast(const PrepArgs& a, const float* rope_tab, int r0, int rstride, int nrows, int lane) {
    const int hq = lane >> 4, d0 = 4 * (lane & 15), vi = lane >> 3, j0 = 4 * (lane & 7);
    const bool second = (lane & 2) != 0, colhalf = (lane & 4) != 0;
    u32x2 zq[NT], eq[NT], ek[NT], rp[NT][3]; unsigned zkv[NT]; f32x4 cs[NT], sn[NT]; int rr[NT]; bool ok[NT];
#pragma unroll
    for (int t = 0; t < NT; ++t) { rr[t] = r0 + t * rstride; ok[t] = rr[t] < nrows; const int r = ok[t] ? rr[t] : 0;
        const bf16_t* z = a.ZB + (size_t)r * ZC; const bf16_t* e = a.EB + (size_t)r * D;
        zq[t] = *(const u32x2*)(z + O_MQ + 4 * lane); zkv[t] = *(const unsigned*)(z + O_MKV + 2 * lane);
        eq[t] = *(const u32x2*)(e + hq * 96 + d0); ek[t] = *(const u32x2*)(e + 384 + hq * 128 + d0);
        rp[t][0] = vi < 4 ? *(const u32x2*)(e + vi * 96 + 64 + j0) : *(const u32x2*)(z + O_DQ + (vi - 4) * 32 + j0);
        rp[t][1] = vi < 4 ? *(const u32x2*)(z + O_DQ + (vi + 4) * 32 + j0) : *(const u32x2*)(z + O_DK + (vi - 4) * 32 + j0);
        rp[t][2] = vi < 4 ? *(const u32x2*)(z + O_DK + (vi + 4) * 32 + j0) : *(const u32x2*)(z + O_MKR + j0);
        const bool lat = r < TL; const int tk = r & (SQ - 1), pos = colhalf ? (tk & 63) : (tk >> 6);
        cs[t] = (f32x4){1.f, 1.f, 1.f, 1.f}; sn[t] = (f32x4){0.f, 0.f, 0.f, 0.f};
        if (lat) { cs[t] = *(const f32x4*)(rope_tab + pos * 16 + 4 * (lane & 1)); sn[t] = *(const f32x4*)(rope_tab + pos * 16 + 8 + 4 * (lane & 1)); } }
#pragma unroll
    for (int t = 0; t < NT; ++t) { const int r = rr[t];
        float sq, sk;
        { const float a0 = bflo(zq[t].x), a1 = bfhi(zq[t].x), a2 = bflo(zq[t].y), a3 = bfhi(zq[t].y); sq = a0 * a0 + a1 * a1 + a2 * a2 + a3 * a3; const float b0 = bflo(zkv[t]), b1 = bfhi(zkv[t]); sk = b0 * b0 + b1 * b1; }
#pragma unroll
        for (int o = 1; o < 64; o <<= 1) { sq += shx(sq, o, lane); sk += shx(sk, o, lane); }
        const float rq = rsqrtf(sq * (1.f / 256.f) + 1e-6f), rk = rsqrtf(sk * (1.f / 128.f) + 1e-6f);
        if (ok[t]) {
            { const float f = rq * C_MLA; u32x2 w; w.x = pk2(bflo(eq[t].x) * f, bfhi(eq[t].x) * f); w.y = pk2(bflo(eq[t].y) * f, bfhi(eq[t].y) * f); *(u32x2*)(a.QM + ((size_t)hq * T + r) * 96 + d0) = w; }
            { u32x2 w; w.x = pk2(bflo(ek[t].x) * rk, bfhi(ek[t].x) * rk); w.y = pk2(bflo(ek[t].y) * rk, bfhi(ek[t].y) * rk); *(u32x2*)(a.KM + ((size_t)hq * T + r) * 96 + d0) = w; } }
#pragma unroll
        for (int p = 0; p < 3; ++p) {
            f32x4 v = (f32x4){bflo(rp[t][p].x), bfhi(rp[t][p].x), bflo(rp[t][p].y), bfhi(rp[t][p].y)};
            f32x4 pr; pr[0] = shx(v[0], 2, lane); pr[1] = shx(v[1], 2, lane); pr[2] = shx(v[2], 2, lane); pr[3] = shx(v[3], 2, lane);
            f32x4 o = second ? pr * sn[t] + v * cs[t] : v * cs[t] - pr * sn[t];
            float f = 1.f; bf16_t* dst;
            if (p == 0) { if (vi < 4) { f = rq * C_MLA; dst = a.QM + ((size_t)vi * T + r) * 96 + 64 + j0; } else { f = C_DIFF; dst = a.QD + ((size_t)(vi - 4) * T + r) * 32 + j0; } }
            else if (p == 1) { if (vi < 4) { f = C_DIFF; dst = a.QD + ((size_t)(vi + 4) * T + r) * 32 + j0; } else dst = a.KD + ((size_t)(vi - 4) * T + r) * 32 + j0; }
            else { if (vi < 4) dst = a.KD + ((size_t)(vi + 4) * T + r) * 32 + j0; else dst = a.KM + ((size_t)(vi - 4) * T + r) * 96 + 64 + j0; }
            if (ok[t]) { u32x2 w; w.x = pk2(o[0] * f, o[1] * f); w.y = pk2(o[2] * f, o[3] * f); *(u32x2*)dst = w; } }
    }
}
__device__ __forceinline__ void prep_vt_tile_fast(const PrepArgs& a, int ti, LAS unsigned char* lds) {
    const int tid = otid(), wave = tid >> 6, lane = tid & 63;
    const int r0 = ti * 64; const bool lat = r0 < TL;
    const int b = lat ? (r0 >> 12) : ((r0 - TL) >> 8), slot0 = lat ? (r0 & (SQ - 1)) : (SQ + ((r0 - TL) & (CL - 1)));
    LAS bf16_t* tile = (LAS bf16_t*)lds;
    u32x2 vv[3][8]; unsigned kv[8];
    { const int c = 4 * lane, h = c >> 6, d = c & 63;
#pragma unroll
      for (int i = 0; i < 8; ++i) { const int r = r0 + wave * 8 + i; const bf16_t* z = a.ZB + (size_t)r * ZC;
          vv[0][i] = *(const u32x2*)(z + O_NAV + 4 * lane); vv[2][i] = *(const u32x2*)(z + O_DV + 4 * lane); vv[1][i] = *(const u32x2*)(a.EB + (size_t)r * D + 384 + h * 128 + 64 + d); kv[i] = *(const unsigned*)(z + O_MKV + 2 * lane); } }
#pragma unroll
    for (int src = 0; src < 3; ++src) {
        bf16_t* dst = src == 0 ? a.VTN : (src == 1 ? a.VTM : a.VTD);
#pragma unroll
        for (int i = 0; i < 8; ++i) { const int tok = wave * 8 + i; u32x2 w = vv[src][i];
            if (src == 1) { const float b0 = bflo(kv[i]), b1 = bfhi(kv[i]); const float rk = rsqrtf(wave_sum(b0 * b0 + b1 * b1, lane) * (1.f / 128.f) + 1e-6f);
                w.x = pk2(bflo(w.x) * rk, bfhi(w.x) * rk); w.y = pk2(bflo(w.y) * rk, bfhi(w.y) * rk); }
            tile[(4 * lane + 0) * 72 + tok] = (bf16_t)(w.x & 0xffffu); tile[(4 * lane + 1) * 72 + tok] = (bf16_t)(w.x >> 16); tile[(4 * lane + 2) * 72 + tok] = (bf16_t)(w.y & 0xffffu); tile[(4 * lane + 3) * 72 + tok] = (bf16_t)(w.y >> 16); }
        __syncthreads();
        for (int i = tid; i < 1024; i += NTHR) { const int row = i >> 2, g = i & 3; const LAS u32x2* p = (const LAS u32x2*)(tile + row * 72 + g * 16);
            const u32x2 q0 = p[0], q1 = p[1], q2 = p[2], q3 = p[3];
            bf16_t* o = dst + ((size_t)(b * 4 + (row >> 6)) * 64 + (row & 63)) * KB + slot0 + g * 16;
            *(u32x4*)o = (u32x4){q0.x, q0.y, q2.x, q2.y}; *(u32x4*)(o + 8) = (u32x4){q1.x, q1.y, q3.x, q3.y}; }
        __syncthreads();
    }
}
__global__ __launch_bounds__(NTHR, 2) void k_prep(PrepArgs a) {
    extern __shared__ __attribute__((aligned(16))) unsigned char lds_raw[];
    LAS unsigned char* lds = (LAS unsigned char*)lds_raw;
    const int wave = threadIdx.x >> 6, lane = threadIdx.x & 63;
    for (int r = blockIdx.x * NWAVES + wave; r < T; r += gridDim.x * NWAVES) prep_row(a, r, lane);
    for (int ti = blockIdx.x; ti < T / 64; ti += gridDim.x) prep_vt_tile(a, ti, lds);
}

#define MFMA32(a, b, c) __builtin_amdgcn_mfma_f32_32x32x16_bf16((a), (b), (c), 0, 0, 0)
__device__ __forceinline__ float xhalf_max(float v) { auto rr = __builtin_amdgcn_permlane32_swap(__float_as_uint(v), __float_as_uint(v), false, false); return fmaxf(__uint_as_float(rr[0]), __uint_as_float(rr[1])); }
__device__ __forceinline__ float xhalf_sum(float v) { auto rr = __builtin_amdgcn_permlane32_swap(__float_as_uint(v), __float_as_uint(v), false, false); return __uint_as_float(rr[0]) + __uint_as_float(rr[1]); }
__device__ __forceinline__ void softmax_step(f32x16& s0, f32x16& s1, float& m, float& l, f32x16& o0, f32x16& o1, bf16x8 (&pf)[4]) {
    float ta = __builtin_fmaxf(__builtin_fmaxf(s0[0], s1[0]), s0[1]), tb = __builtin_fmaxf(__builtin_fmaxf(s1[1], s0[2]), s1[2]);
#pragma unroll
    for (int r = 3; r < 15; r += 2) { ta = __builtin_fmaxf(__builtin_fmaxf(ta, s0[r]), s1[r]); tb = __builtin_fmaxf(__builtin_fmaxf(tb, s0[r + 1]), s1[r + 1]); }
    float tm = __builtin_fmaxf(__builtin_fmaxf(ta, tb), __builtin_fmaxf(s0[15], s1[15]));
    tm = xhalf_max(tm);
    const float mn = fmaxf(m, tm);
    if (__any(mn > m)) { const float sc = __builtin_amdgcn_exp2f(m - mn); l *= sc;
#pragma unroll
        for (int r = 0; r < 16; ++r) { o0[r] *= sc; o1[r] *= sc; } }
    m = mn;
    const f32x2 nm = (f32x2){-mn, -mn};
    f32x2 ls2 = (f32x2){0.f, 0.f};
#pragma unroll
    for (int r = 0; r < 16; ++r) { const f32x2 d = (f32x2){s0[r], s1[r]} + nm; const f32x2 e = (f32x2){__builtin_amdgcn_exp2f(d.x), __builtin_amdgcn_exp2f(d.y)}; s0[r] = e.x; s1[r] = e.y; ls2 += e; }
    l += ls2.x + ls2.y;
#pragma unroll
    for (int s = 0; s < 2; ++s) {
        u32x4 w; w.x = pg8::cvt_pk_bf16(s0[8 * s], s0[8 * s + 1]); w.y = pg8::cvt_pk_bf16(s0[8 * s + 2], s0[8 * s + 3]); w.z = pg8::cvt_pk_bf16(s0[8 * s + 4], s0[8 * s + 5]); w.w = pg8::cvt_pk_bf16(s0[8 * s + 6], s0[8 * s + 7]);
        pf[s] = __builtin_bit_cast(bf16x8, w);
        u32x4 x; x.x = pg8::cvt_pk_bf16(s1[8 * s], s1[8 * s + 1]); x.y = pg8::cvt_pk_bf16(s1[8 * s + 2], s1[8 * s + 3]); x.z = pg8::cvt_pk_bf16(s1[8 * s + 4], s1[8 * s + 5]); x.w = pg8::cvt_pk_bf16(s1[8 * s + 6], s1[8 * s + 7]);
        pf[2 + s] = __builtin_bit_cast(bf16x8, x);
    }
}
struct AttnArgs { const bf16_t* Q; const bf16_t* K; const bf16_t* VT; bf16_t* O; const float* lamv; const float* subln; float lam_init; int pad; };
template <int NS> __device__ __forceinline__ void attn_unit(const AttnArgs& a, int b, int h, int qb, LAS unsigned char* lds, float lam) {
    constexpr int DQ = NS == 1 ? 96 : 64, KS = DQ * 2 + 16, VS = 144, KBYTES = 64 * KS, BUF = KBYTES + 64 * VS;
    constexpr int KCH = DQ / 8, NKC = 64 * KCH, NCH = NKC + 512, CPT = (NCH + NTHR - 1) / NTHR;
    const int tid = otid(), wave = __builtin_amdgcn_readfirstlane(tid >> 6), lane = tid & 63, r32 = lane & 31, hi = lane >> 5;
    const bool ctxq = qb == 16;
    const int qrow = (ctxq ? TL + b * CL : b * SQ + qb * 256) + wave * 32 + r32;
    const int jt0 = ctxq ? 64 : 0, ntile = ctxq ? 4 : 68;
    bf16x8 qf[NS == 1 ? 6 : 4];
    if (NS == 1) {
#pragma unroll
        for (int ks = 0; ks < 6; ++ks) qf[ks] = *(const bf16x8*)(a.Q + ((size_t)h * T + qrow) * 96 + 16 * ks + 8 * hi);
    } else {
#pragma unroll
        for (int c = 0; c < 2; ++c)
#pragma unroll
            for (int ks = 0; ks < 2; ++ks) qf[c * 2 + ks] = *(const bf16x8*)(a.Q + ((size_t)(h * 2 + c) * T + qrow) * 32 + 16 * ks + 8 * hi);
    }
    u32x4 stg[CPT];
    auto gload = [&](int jt) {
        const int krow0 = (jt < 64) ? b * SQ + jt * 64 : TL + b * CL + (jt - 64) * 64;
#pragma unroll
        for (int i = 0; i < CPT; ++i) { const int c = tid + i * NTHR;
            if (c < NKC) { const int key = c / KCH, kc = c % KCH;
                const bf16_t* src = NS == 1 ? a.K + ((size_t)h * T + krow0 + key) * 96 + kc * 8 : a.K + ((size_t)(h * 2 + (kc >> 2)) * T + krow0 + key) * 32 + (kc & 3) * 8;
                stg[i] = *(const u32x4*)src; }
            else if (c < NCH) { const int v = c - NKC, d = v >> 3, vc = v & 7; stg[i] = *(const u32x4*)(a.VT + ((size_t)(b * 4 + h) * 64 + d) * KB + jt * 64 + vc * 8); } }
    };
    auto lstore = [&](int buf) {
#pragma unroll
        for (int i = 0; i < CPT; ++i) { const int c = tid + i * NTHR;
            if (c < NKC) { const int key = c / KCH, kc = c % KCH; *(LAS u32x4*)(lds + buf * BUF + key * KS + kc * 16) = stg[i]; }
            else if (c < NCH) { const int v = c - NKC, d = v >> 3, vc = v & 7; *(LAS u32x4*)(lds + buf * BUF + KBYTES + d * VS + vc * 16) = stg[i]; } }
    };
    float m[NS], l[NS]; f32x16 o[NS][2];
#pragma unroll
    for (int n = 0; n < NS; ++n) { m[n] = -1e30f; l[n] = 0.f;
#pragma unroll
        for (int r = 0; r < 16; ++r) { o[n][0][r] = 0.f; o[n][1][r] = 0.f; } }
    const bool lag = wave >= 4;
    bf16x8 pf[NS][4];
    bf16x8 vfr[NS == 1 ? 2 : 1][NS == 1 ? 4 : 1];
    auto pv = [&](int buf) { const LAS unsigned char* vb = lds + buf * BUF + KBYTES + r32 * VS + hi * 16;
#pragma unroll
        for (int db = 0; db < 2; ++db)
#pragma unroll
            for (int t = 0; t < 4; ++t) { bf16x8 vf; if (NS == 1) vf = vfr[NS == 1 ? db : 0][NS == 1 ? t : 0]; else vf = *(const LAS bf16x8*)(vb + db * 32 * VS + t * 32);
#pragma unroll
                for (int n = 0; n < NS; ++n) o[n][db] = MFMA32(vf, pf[n][t], o[n][db]); } };
    gload(jt0); lstore(0); __syncthreads();
    int cur = 0, prv = 2;
    constexpr int NKF = NS == 1 ? 6 : 4;
    for (int it = 0; it < ntile; ++it) {
        const int nxt = cur == 2 ? 0 : cur + 1;
        if (it + 1 < ntile) gload(jt0 + it + 1);
        if (lag && it > 0) pv(prv);
        bf16x8 kfr[2][NKF];
        { const LAS unsigned char* kb = lds + cur * BUF + r32 * KS + hi * 16;
#pragma unroll
          for (int ks = 0; ks < NKF; ++ks) { kfr[0][ks] = *(const LAS bf16x8*)(kb + ks * 32); kfr[1][ks] = *(const LAS bf16x8*)(kb + 32 * KS + ks * 32); } }
        asm volatile("" ::: "memory");
        f32x16 s0, s1;
#pragma unroll
        for (int r = 0; r < 16; ++r) { s0[r] = 0.f; s1[r] = 0.f; }
        constexpr int NK = NS == 1 ? 6 : 2;
#pragma unroll
        for (int ks = 0; ks < NK; ++ks) { s0 = MFMA32(kfr[0][ks], qf[ks], s0); s1 = MFMA32(kfr[1][ks], qf[ks], s1); }
        if (NS == 1) { const LAS unsigned char* vb = lds + cur * BUF + KBYTES + r32 * VS + hi * 16;
#pragma unroll
          for (int db = 0; db < 2; ++db)
#pragma unroll
              for (int t = 0; t < 4; ++t) vfr[NS == 1 ? db : 0][NS == 1 ? t : 0] = *(const LAS bf16x8*)(vb + db * 32 * VS + t * 32);
          asm volatile("" ::: "memory"); }
        softmax_step(s0, s1, m[0], l[0], o[0][0], o[0][1], pf[0]);
        if (NS == 2) {
#pragma unroll
            for (int r = 0; r < 16; ++r) { s0[r] = 0.f; s1[r] = 0.f; }
#pragma unroll
            for (int ks = 0; ks < 2; ++ks) { s0 = MFMA32(kfr[0][2 + ks], qf[2 + ks], s0); s1 = MFMA32(kfr[1][2 + ks], qf[2 + ks], s1); }
            softmax_step(s0, s1, m[NS - 1], l[NS - 1], o[NS - 1][0], o[NS - 1][1], pf[NS - 1]);
        }
        if (!lag) pv(cur);
        if (it + 1 < ntile) lstore(nxt);
        __syncthreads();
        prv = cur; cur = nxt;
    }
    if (lag) pv(prv);
    float inv[NS];
#pragma unroll
    for (int n = 0; n < NS; ++n) inv[n] = 1.f / xhalf_sum(l[n]);
    bf16_t* orow = a.O + (size_t)qrow * D + (NS == 1 ? 256 : 768) + h * 64;
    if (NS == 1) {
#pragma unroll
        for (int db = 0; db < 2; ++db)
#pragma unroll
            for (int g = 0; g < 4; ++g) { u32x2 w; w.x = pg8::cvt_pk_bf16(o[0][db][4 * g] * inv[0], o[0][db][4 * g + 1] * inv[0]); w.y = pg8::cvt_pk_bf16(o[0][db][4 * g + 2] * inv[0], o[0][db][4 * g + 3] * inv[0]);
                *(u32x2*)(orow + 32 * db + 8 * g + 4 * hi) = w; }
    } else {
        const float i1 = inv[0], i2 = lam * inv[NS - 1]; float ss = 0.f;
#pragma unroll
        for (int db = 0; db < 2; ++db)
#pragma unroll
            for (int r = 0; r < 16; ++r) { const float v = o[0][db][r] * i1 - o[NS - 1][db][r] * i2; o[0][db][r] = v; ss += v * v; }
        ss = xhalf_sum(ss);
        const float rr = rsqrtf(ss * (1.f / 64.f) + 1e-6f) * (1.f - a.lam_init);
#pragma unroll
        for (int db = 0; db < 2; ++db)
#pragma unroll
            for (int g = 0; g < 4; ++g) { const int d0 = 32 * db + 8 * g + 4 * hi; const f32x4 sl = *(const f32x4*)(a.subln + d0);
                u32x2 w; w.x = pg8::cvt_pk_bf16(o[0][db][4 * g] * rr * sl[0], o[0][db][4 * g + 1] * rr * sl[1]); w.y = pg8::cvt_pk_bf16(o[0][db][4 * g + 2] * rr * sl[2], o[0][db][4 * g + 3] * rr * sl[3]);
                *(u32x2*)(orow + d0) = w; }
    }
    __syncthreads();
}
template <int NS> __global__ __launch_bounds__(NTHR, 2) void k_attn(AttnArgs a) {
    extern __shared__ __attribute__((aligned(16))) unsigned char lds_raw[];
    LAS unsigned char* lds = (LAS unsigned char*)lds_raw;
    float lam = 0.f;
    if (NS == 2) { float s1 = 0.f, s2 = 0.f; for (int i = 0; i < 32; ++i) { s1 += a.lamv[i] * a.lamv[32 + i]; s2 += a.lamv[64 + i] * a.lamv[96 + i]; } lam = expf(s1) - expf(s2) + a.lam_init; }
    for (int u = blockIdx.x; u < NB * 4 * 17; u += gridDim.x) { const int qb = u % 17, bh = u / 17; attn_unit<NS>(a, bh >> 2, bh & 3, qb, lds, lam); }
}


#define MFMA16(a, b, c) __builtin_amdgcn_mfma_f32_16x16x32_bf16((a), (b), (c), 0, 0, 0)
constexpr int NCHK = KB / 64;
struct S5Prep { const float* lam_re; const float* lam_im; const float* log_dt; const float* b_re; const float* b_im; const float* c_re; const float* c_im; float4* S5A; bf16_t* S5B; bf16_t* S5C; };
__global__ void k_s5prep(S5Prep a) {
    const int i = blockIdx.x * 256 + threadIdx.x; const int gi = i >> 6, p = i & 63;
    const double lre = a.lam_re[i], lim = a.lam_im[i], dt = exp((double)a.log_dt[gi]);
    const double x = lre * dt; double y = lim * dt; y -= 6.283185307179586476925 * rint(y / 6.283185307179586476925);
    float sy, cy; sincosf((float)y, &sy, &cy); const float sh = sinf((float)(0.5 * y));
    const double em1 = x * (1.0 + x * 0.5 * (1.0 + x * (1.0 / 3.0) * (1.0 + x * 0.25 * (1.0 + x * 0.2 * (1.0 + x * (1.0 / 6.0))))));
    const double nr = em1 * (double)cy - 2.0 * (double)sh * (double)sh, ni = (1.0 + em1) * (double)sy;
    const double ar = 1.0 + nr, ai = ni;
    double pr = ar, pi = ai;
#pragma unroll
    for (int k = 0; k < 6; ++k) { const double t = pr * pr - pi * pi; pi = 2.0 * pr * pi; pr = t; }
    a.S5A[i] = make_float4((float)ar, (float)ai, (float)pr, (float)pi);
    const double den = lre * lre + lim * lim; const float fr = (float)((nr * lre + ni * lim) / den), fi = (float)((ni * lre - nr * lim) / den);
    for (int c = 0; c < 16; ++c) { const float br = a.b_re[i * 16 + c], bi = a.b_im[i * 16 + c];
        a.S5B[((size_t)gi * 128 + p) * 16 + c] = (bf16_t)f2bf(fr * br - fi * bi); a.S5B[((size_t)gi * 128 + 64 + p) * 16 + c] = (bf16_t)f2bf(fr * bi + fi * br);
        a.S5C[((size_t)gi * 16 + c) * 128 + p] = (bf16_t)f2bf(a.c_re[(gi * 16 + c) * 64 + p]); a.S5C[((size_t)gi * 16 + c) * 128 + 64 + p] = (bf16_t)f2bf(-a.c_im[(gi * 16 + c) * 64 + p]); }
}
struct S5Args { const bf16_t* ZB; const float4* S5A; const bf16_t* S5B; const bf16_t* S5C; const float* dskip; float2* S; bf16_t* Y5; unsigned long long* dbg; };
__device__ __forceinline__ int s5_chunk_row0(int b, int tc) { return tc < 4 ? TL + b * CL + tc * 64 : b * SQ + (tc - 4) * 64; }
__device__ __forceinline__ int s5_tc_of(int dir, int j) { return dir == 0 ? j : (j < 4 ? 3 - j : 71 - j); }
template <bool WRITE_H> __device__ __forceinline__ void s5_subblock(const bf16_t* ZB, int row0, int g, int dir, const bf16x8 (&bfr)[8], float ar, float ai, float& hr, float& hi, LAS float* tile, int lane) {
    const int n16 = lane & 15, kq = lane >> 4;
    bf16x8 af = (bf16x8){0, 0, 0, 0, 0, 0, 0, 0};
    if (kq < 2) af = *(const bf16x8*)(ZB + (size_t)(row0 + n16) * ZC + O_S5 + g * 16 + 8 * kq);
    f32x4 accs[8];
#pragma unroll
    for (int nb = 0; nb < 8; ++nb) { accs[nb] = (f32x4){0.f, 0.f, 0.f, 0.f}; accs[nb] = MFMA16(af, bfr[nb], accs[nb]); }
    __builtin_amdgcn_sched_barrier(0); asm volatile("s_nop 15\n\ts_nop 15" :: "v"(af) : "memory"); __builtin_amdgcn_sched_barrier(0);
#pragma unroll
    for (int nb = 0; nb < 8; ++nb)
#pragma unroll
        for (int i = 0; i < 4; ++i) tile[(4 * kq + i) * 132 + 16 * nb + n16] = accs[nb][i];
#pragma unroll
    for (int ii = 0; ii < 16; ++ii) { const int i = dir == 0 ? ii : 15 - ii;
        const float br = tile[i * 132 + lane], bi = tile[i * 132 + 64 + lane];
        const float nr = ar * hr - ai * hi + br, ni = ar * hi + ai * hr + bi; hr = nr; hi = ni;
        if (WRITE_H) { tile[i * 132 + lane] = hr; tile[i * 132 + 64 + lane] = hi; } }
}
__device__ __forceinline__ void s5_load_b(const S5Args& a, int gi, int lane, bf16x8 (&bfr)[8]) {
    const int n16 = lane & 15, kq = lane >> 4;
#pragma unroll
    for (int nb = 0; nb < 8; ++nb) { bfr[nb] = (bf16x8){0, 0, 0, 0, 0, 0, 0, 0}; if (kq < 2) bfr[nb] = *(const bf16x8*)(a.S5B + ((size_t)gi * 128 + 16 * nb + n16) * 16 + 8 * kq); }
}
__device__ __forceinline__ void s5_pass1_item(const S5Args& a, int b, int dir, int j, int g, LAS float* tile, int lane) {
    const int gi = dir * 16 + g; const float4 ap = a.S5A[gi * 64 + lane];
    bf16x8 bfr[8]; s5_load_b(a, gi, lane, bfr);
    const int row0 = s5_chunk_row0(b, s5_tc_of(dir, j));
    float hr = 0.f, hi = 0.f;
    if (a.dbg) { unsigned long long cs = 0; const int n16 = lane & 15, kq = lane >> 4;
        for (int tsb = 0; tsb < 4; ++tsb) if (kq < 2) { const size_t off = (size_t)(row0 + 16 * tsb + n16) * ZC + O_S5 + g * 16 + 8 * kq; const u32x4 w = *(const u32x4*)(a.ZB + off);
            cs += ((unsigned long long)w.x + 3ull * w.y + 5ull * w.z + 7ull * w.w) * (unsigned long long)((off & 4095) + 1); }
        cs += (unsigned long long)__float_as_uint(ap.x) * 11ull + (unsigned long long)__float_as_uint(ap.y) * 13ull;
        for (int nb = 0; nb < 8; ++nb) { const u32x4 w = __builtin_bit_cast(u32x4, bfr[nb]); cs += ((unsigned long long)w.x + 3ull * w.y + 5ull * w.z + 7ull * w.w) * (unsigned long long)(nb + 1); }
        for (int o = 1; o < 64; o <<= 1) cs += __shfl_xor(cs, o);
        if (lane == 0) atomicAdd(a.dbg, cs); }
#pragma unroll 1
    for (int sbi = 0; sbi < 4; ++sbi) { const int tsb = dir == 0 ? sbi : 3 - sbi; s5_subblock<false>(a.ZB, row0 + 16 * tsb, g, dir, bfr, ap.x, ap.y, hr, hi, tile, lane); }
    a.S[((size_t)((b * 2 + dir) * NCHK + j) * 16 + g) * 64 + lane] = make_float2(hr, hi);
    if (a.dbg) { const size_t idx = ((size_t)((b * 2 + dir) * NCHK + j) * 16 + g) * 64 + lane; unsigned long long cs = ((unsigned long long)__float_as_uint(hr) + 3ull * __float_as_uint(hi)) * (unsigned long long)((idx & 1023) + 1);
        for (int o = 1; o < 64; o <<= 1) cs += __shfl_xor(cs, o);
        if (lane == 0) atomicAdd(a.dbg, cs); }
}
__device__ __forceinline__ void s5_pass2_item(const S5Args& a, int b, int tc, int g, LAS float* tile, int lane) {
    const int n16 = lane & 15, kq = lane >> 4;
    const int row0 = s5_chunk_row0(b, tc);
    f32x4 yacc[4];
#pragma unroll
    for (int t = 0; t < 4; ++t) yacc[t] = (f32x4){0.f, 0.f, 0.f, 0.f};
#pragma unroll 1
    for (int dir = 0; dir < 2; ++dir) {
        const int gi = dir * 16 + g; const float4 ap = a.S5A[gi * 64 + lane];
        const int j = dir == 0 ? tc : (tc < 4 ? 3 - tc : 71 - tc);
        float hr = 0.f, hi = 0.f;
        const float2* sp = a.S + ((size_t)((b * 2 + dir) * NCHK) * 16 + g) * 64 + lane;
#pragma unroll 4
        for (int jj = 0; jj < j; ++jj) { const float2 sv = sp[(size_t)jj * 16 * 64]; const float nr = ap.z * hr - ap.w * hi + sv.x, ni = ap.z * hi + ap.w * hr + sv.y; hr = nr; hi = ni; }
        bf16x8 bfr[8]; s5_load_b(a, gi, lane, bfr);
        bf16x8 cf[4];
#pragma unroll
        for (int ks = 0; ks < 4; ++ks) cf[ks] = *(const bf16x8*)(a.S5C + ((size_t)gi * 16 + n16) * 128 + 32 * ks + 8 * kq);
#pragma unroll
        for (int sbi = 0; sbi < 4; ++sbi) { const int tsb = dir == 0 ? sbi : 3 - sbi;
            s5_subblock<true>(a.ZB, row0 + 16 * tsb, g, dir, bfr, ap.x, ap.y, hr, hi, tile, lane);
#pragma unroll
            for (int ks = 0; ks < 4; ++ks) { const LAS float* hp = tile + n16 * 132 + 32 * ks + 8 * kq; const f32x4 h0 = *(const LAS f32x4*)hp, h1 = *(const LAS f32x4*)(hp + 4);
                u32x4 w; w.x = pg8::cvt_pk_bf16(h0[0], h0[1]); w.y = pg8::cvt_pk_bf16(h0[2], h0[3]); w.z = pg8::cvt_pk_bf16(h1[0], h1[1]); w.w = pg8::cvt_pk_bf16(h1[2], h1[3]);
                if (tsb == 0) yacc[0] = MFMA16(__builtin_bit_cast(bf16x8, w), cf[ks], yacc[0]); else if (tsb == 1) yacc[1] = MFMA16(__builtin_bit_cast(bf16x8, w), cf[ks], yacc[1]);
                else if (tsb == 2) yacc[2] = MFMA16(__builtin_bit_cast(bf16x8, w), cf[ks], yacc[2]); else yacc[3] = MFMA16(__builtin_bit_cast(bf16x8, w), cf[ks], yacc[3]); } }
    }
    const float dsk = a.dskip[g * 16 + n16];
#pragma unroll
    for (int t = 0; t < 4; ++t)
#pragma unroll
        for (int i = 0; i < 4; ++i) { const size_t row = (size_t)(row0 + 16 * t + 4 * kq + i); const float u = bf2f(a.ZB[row * ZC + O_S5 + g * 16 + n16]);
            a.Y5[row * 256 + g * 16 + n16] = (bf16_t)f2bf(yacc[t][i] + dsk * u); }
}
__global__ __launch_bounds__(NTHR, 2) void k_s5_pass1(S5Args a) {
    extern __shared__ __attribute__((aligned(16))) unsigned char lds_raw[];
    const int wave = threadIdx.x >> 6, lane = threadIdx.x & 63; LAS float* tile = (LAS float*)((LAS unsigned char*)lds_raw + wave * 8448);
    for (int it = blockIdx.x; it < NB * 2 * NCHK * 2; it += gridDim.x) { const int gh = it & 1, j = (it >> 1) % NCHK, bd = (it >> 1) / NCHK; s5_pass1_item(a, bd >> 1, bd & 1, j, gh * 8 + wave, tile, lane); }
}
__global__ __launch_bounds__(NTHR, 2) void k_s5_pass2(S5Args a) {
    extern __shared__ __attribute__((aligned(16))) unsigned char lds_raw[];
    const int wave = threadIdx.x >> 6, lane = threadIdx.x & 63; LAS float* tile = (LAS float*)((LAS unsigned char*)lds_raw + wave * 8448);
    for (int it = blockIdx.x; it < NB * NCHK * 2; it += gridDim.x) { const int gh = it & 1, tc = (it >> 1) % NCHK, b = (it >> 1) / NCHK; s5_pass2_item(a, b, tc, gh * 8 + wave, tile, lane); }
}


struct NaArgs { const bf16_t* ZB; const bf16_t* VTN; bf16_t* O; const float* rpb; };
__device__ __forceinline__ void na_wave(const NaArgs& a, int item, const LAS float* bias, int wave, int lane) {
    const int r32 = lane & 31, hi = lane >> 5;
    const bool ctxq = item >= 512; const int bh = ctxq ? item - 512 : item >> 4, b = bh >> 2, h = bh & 3;
    int gr = 0, c0 = 0, qrow;
    if (ctxq) qrow = TL + b * CL + wave * 32 + r32; else { gr = (item & 15) * 4 + (wave >> 1); c0 = (wave & 1) * 32; qrow = b * SQ + gr * 64 + c0 + r32; }
    bf16x8 qf[4];
#pragma unroll
    for (int ks = 0; ks < 4; ++ks) qf[ks] = *(const bf16x8*)(a.ZB + (size_t)qrow * ZC + O_NAQ + h * 64 + 16 * ks + 8 * hi);
    float m = -1e30f, l = 0.f; f32x16 o0, o1;
#pragma unroll
    for (int r = 0; r < 16; ++r) { o0[r] = 0.f; o1[r] = 0.f; }
    const bf16_t* vt = a.VTN + ((size_t)(b * 4 + h) * 64 + r32) * KB + 8 * hi;
    const int c = c0 + r32, cs = min(max(c - 8, 0), 48), r0 = min(max(gr - 4, 0), 56);
    const int ntile = ctxq ? 4 : 12;
    bf16x8 kf[8], vf[8];
    auto ktok = [&](int t) { const bool local = !ctxq && t < 8; return local ? b * SQ + (r0 + t) * 64 : TL + b * CL + (ctxq ? t : t - 8) * 64; };
    { const bf16_t* kp = a.ZB + (size_t)(ktok(0) + r32) * ZC + O_NAK + h * 64 + 8 * hi;
#pragma unroll
      for (int ks = 0; ks < 4; ++ks) { kf[ks] = *(const bf16x8*)(kp + 16 * ks); kf[4 + ks] = *(const bf16x8*)(kp + (size_t)32 * ZC + 16 * ks); } }
#pragma unroll 1
    for (int t = 0; t < ntile; ++t) {
        const bool local = !ctxq && t < 8;
        const int slot0 = local ? (r0 + t) * 64 : SQ + (ctxq ? t : t - 8) * 64;
#pragma unroll
        for (int q = 0; q < 4; ++q) { vf[q] = *(const bf16x8*)(vt + slot0 + 16 * q); vf[4 + q] = *(const bf16x8*)(vt + (size_t)32 * KB + slot0 + 16 * q); }
        f32x16 s0, s1;
#pragma unroll
        for (int r = 0; r < 16; ++r) { s0[r] = 0.f; s1[r] = 0.f; }
#pragma unroll
        for (int ks = 0; ks < 4; ++ks) { s0 = MFMA32(kf[ks], qf[ks], s0); s1 = MFMA32(kf[4 + ks], qf[ks], s1); }
        if (t + 1 < ntile) { const bf16_t* kp = a.ZB + (size_t)(ktok(t + 1) + r32) * ZC + O_NAK + h * 64 + 8 * hi;
#pragma unroll
            for (int ks = 0; ks < 4; ++ks) { kf[ks] = *(const bf16x8*)(kp + 16 * ks); kf[4 + ks] = *(const bf16x8*)(kp + (size_t)32 * ZC + 16 * ks); } }
        if (local) { const LAS float* brow = bias + (h * 15 + (r0 + t - gr + 7)) * 32;
#pragma unroll
            for (int r = 0; r < 16; ++r) { const int kk = (r & 3) + 8 * (r >> 2) + 4 * hi;
                { const int kc = kk, off = kc - cs; s0[r] = (off >= 0 && off < 16) ? s0[r] * C_NA + brow[kc - c + 15] : -1e30f; }
                { const int kc = 32 + kk, off = kc - cs; s1[r] = (off >= 0 && off < 16) ? s1[r] * C_NA + brow[kc - c + 15] : -1e30f; } }
        } else {
#pragma unroll
            for (int r = 0; r < 16; ++r) { s0[r] *= C_NA; s1[r] *= C_NA; } }
        bf16x8 pf[4];
        softmax_step(s0, s1, m, l, o0, o1, pf);
#pragma unroll
        for (int q = 0; q < 4; ++q) { o0 = MFMA32(vf[q], pf[q], o0); o1 = MFMA32(vf[4 + q], pf[q], o1); }
    }
    const float inv = 1.f / xhalf_sum(l);
    bf16_t* orow = a.O + (size_t)qrow * D + h * 64;
#pragma unroll
    for (int g = 0; g < 4; ++g) {
        u32x2 w; w.x = pg8::cvt_pk_bf16(o0[4 * g] * inv, o0[4 * g + 1] * inv); w.y = pg8::cvt_pk_bf16(o0[4 * g + 2] * inv, o0[4 * g + 3] * inv); *(u32x2*)(orow + 8 * g + 4 * hi) = w;
        u32x2 x; x.x = pg8::cvt_pk_bf16(o1[4 * g] * inv, o1[4 * g + 1] * inv); x.y = pg8::cvt_pk_bf16(o1[4 * g + 2] * inv, o1[4 * g + 3] * inv); *(u32x2*)(orow + 32 + 8 * g + 4 * hi) = x; }
}
__device__ __forceinline__ void na_load_bias(const float* rpb, LAS float* bias) {
    for (int i = otid(); i < 4 * 15 * 32; i += NTHR) { const int j = i & 31, hr = i >> 5; bias[i] = j < 31 ? rpb[hr * 31 + j] * 1.4426950408889634f : 0.f; }
    __syncthreads();
}
__global__ __launch_bounds__(NTHR, 2) void k_na2(NaArgs a) {
    extern __shared__ __attribute__((aligned(16))) unsigned char lds_raw[];
    LAS float* bias = (LAS float*)lds_raw;
    na_load_bias(a.rpb, bias);
    const int wave = threadIdx.x >> 6, lane = threadIdx.x & 63;
    for (int item = blockIdx.x; item < 544; item += gridDim.x) na_wave(a, item, bias, wave, lane);
}


#ifdef F8PROBE
__global__ __launch_bounds__(NTHR, 2) void k_gemm8_probe(GemmArgs a) {
    extern __shared__ __attribute__((aligned(16))) unsigned char lds_raw[];
    LAS unsigned char* lds = (LAS unsigned char*)lds_raw;
    pg8::StaticOrder S; S.init(a.nM, a.nN, (int)gridDim.x, (int)blockIdx.x, a.A, a.lda, a.B, a.ldb);
    pg8::EpiStoreS E; E.O = a.O; E.ldc = a.ldc; E.scale = 0.5f;
    pg8::gemm_phase<pg8::EpiStoreS, pg8::StaticOrder, true>(lds, a.K, a.lda, a.ldb, S, E);
}
#endif
__global__ void k_chk(const unsigned* p, size_t nwords, unsigned long long* slot) {
    unsigned long long s = 0;
    for (size_t i = (size_t)blockIdx.x * 256 + threadIdx.x; i < nwords; i += (size_t)gridDim.x * 256) s += (unsigned long long)p[i] * (unsigned long long)((i & 1023) + 1);
#pragma unroll
    for (int o = 1; o < 64; o <<= 1) s += __shfl_xor(s, o);
    if ((threadIdx.x & 63) == 0) atomicAdd(slot, s);
}
__global__ void k_chk_final(const unsigned long long* tab, int n, float* out, size_t nout) {
    int first = -1;
    for (int i = 0; i < n; ++i) if (tab[i] != tab[64 + i]) { first = i; break; }
    if (first < 0) return;
    const float c = sqrtf((float)(first + 1));
    for (size_t i = (size_t)blockIdx.x * 256 + threadIdx.x; i < nout; i += (size_t)gridDim.x * 256) out[i] = c;
}

#define XB_TMO      128
#define XB_XCNT(j)  (256  + 64 * (j))
#define XB_XSUB(j)  (1280 + 64 * (j))
#define XB_XGEN(j)  (2304 + 64 * (j))
#define XB_TOP      3328
#define XB_TOPGEN   3392
#define XCD_BAR_WORDS 3456
#define XB_SPIN_CAP (1u << 18)

__device__ __forceinline__ unsigned xb_ld(unsigned* p)              { return __hip_atomic_load(p, __ATOMIC_RELAXED, __HIP_MEMORY_SCOPE_AGENT); }
__device__ __forceinline__ unsigned xb_add(unsigned* p, unsigned v) { return __hip_atomic_fetch_add(p, v, __ATOMIC_RELAXED, __HIP_MEMORY_SCOPE_AGENT); }
__device__ __forceinline__ unsigned xb_xcc_id() { return (unsigned)__builtin_amdgcn_s_getreg((3 << 11) | 20) & 0xFu; }
#define XB_SPIN(cond, bar) do { unsigned _sp = 0; while (cond) { __builtin_amdgcn_s_sleep(1); \
    if ((++_sp & 255u) == 0u) { if (xb_ld(&(bar)[XB_TMO])) break; if (_sp > XB_SPIN_CAP) { atomicAdd(&(bar)[XB_TMO], 1u); break; } } } } while (0)

struct XcdBarrier {
    unsigned* bar; unsigned x;
    volatile LAS unsigned* st;
};

__device__ __forceinline__ XcdBarrier xcd_barrier_post(unsigned* bar, volatile LAS unsigned* st) {
    XcdBarrier b; b.bar = bar; b.x = xb_xcc_id(); b.st = st;
    if (threadIdx.x == 0) (void)xb_add(&bar[XB_XCNT(b.x)], 1u);
    return b;
}
__device__ __forceinline__ void xcd_barrier_complete(unsigned* bar, unsigned x, unsigned& nloc, unsigned& nx) {
    const unsigned G = gridDim.x * gridDim.y * gridDim.z;
    unsigned sum, cnt, mine, sp = 0u;
    for (;;) {
        sum = 0u; cnt = 0u; mine = 0u;
#pragma unroll
        for (unsigned j = 0; j < 16; ++j) { const unsigned c = xb_ld(&bar[XB_XCNT(j)]); sum += c; cnt += (c > 0u) ? 1u : 0u; mine = (j == x) ? c : mine; }
        if (sum == G) break;
        __builtin_amdgcn_s_sleep(1);
        if ((++sp & 255u) == 0u) { if (xb_ld(&bar[XB_TMO])) break; if (sp > XB_SPIN_CAP) { atomicAdd(&bar[XB_TMO], 1u); break; } }
    }
    nloc = mine > 0u ? mine : 1u; nx = cnt > 0u ? cnt : 1u;
}

__device__ __forceinline__ void xcd_barrier(const XcdBarrier& b) {
    asm volatile("s_waitcnt vmcnt(0)" ::: "memory");
    __syncthreads();
    if (threadIdx.x == 0) {
        unsigned* bar = b.bar;
        __builtin_amdgcn_s_waitcnt(0);
        unsigned nloc = b.st[0], nx = b.st[1];
        if (nloc == 0u) { xcd_barrier_complete(bar, b.x, nloc, nx); b.st[0] = nloc; b.st[1] = nx; }
        const unsigned old = xb_add(&bar[XB_XSUB(b.x)], 1u);
        const unsigned gen = old / nloc;
        if (old + 1u == (gen + 1u) * nloc) {
            __builtin_amdgcn_fence(__ATOMIC_RELEASE, "agent");
            asm volatile("s_waitcnt vmcnt(0)" ::: "memory");
            const unsigned og = xb_add(&bar[XB_TOP], 1u);
            const unsigned tg = og / nx;
            if (og + 1u == (tg + 1u) * nx) xb_add(&bar[XB_TOPGEN], 1u);
            else XB_SPIN(xb_ld(&bar[XB_TOPGEN]) == tg, bar);
            __builtin_amdgcn_fence(__ATOMIC_ACQUIRE, "agent");
            xb_add(&bar[XB_XGEN(b.x)], 1u);
            asm volatile("s_waitcnt vmcnt(0)" ::: "memory");
        } else {
            XB_SPIN(xb_ld(&bar[XB_XGEN(b.x)]) == gen, bar);
            __builtin_amdgcn_fence(__ATOMIC_ACQUIRE, "agent");
            asm volatile("s_waitcnt vmcnt(0)" ::: "memory");
        }
    }
    __syncthreads();
}


namespace W {
constexpr size_t CTL = 0, CTL_ZERO = 64 * 1024;
constexpr size_t PLAN = 16384, QCTR = 32768;
constexpr size_t LAMV = 128 * 1024, ROPE = 132 * 1024, WS13 = 192 * 1024  , HSM = 256 * 1024  , WSIN = 448 * 1024  , MOD = 1 * MiB, TSLOT = 2 * MiB, TGATE = 2 * MiB + 512 * 1024, LTOK = 3 * MiB, S5TAB = 5 * MiB, MODP = 8 * MiB, HGS = MODP  , WS13M = MODP + 1 * MiB  ;
constexpr size_t X = 16 * MiB, H = 152 * MiB, WB = 221 * MiB, BIG = 408 * MiB, R2 = 901 * MiB, END = 1097 * MiB;
constexpr size_t WING = WB, WBR = WB + 13 * MiB, WOUT = WB + 15 * MiB, WEXP = WB + 17 * MiB, WGLU = WB + 18 * MiB, WF13 = WB + 19 * MiB, WF2 = WF13 + 112 * MiB;
constexpr size_t Z = BIG, G = BIG + 153 * MiB, E = BIG + 425 * MiB, ACT = BIG;
constexpr size_t QM = R2, KM = R2 + (size_t)4 * T * 96 * 2, QD = R2 + 51 * MiB, KD = R2 + 68 * MiB, VTN = R2 + 85 * MiB, VTM = R2 + 102 * MiB, VTD = R2 + 119 * MiB, S5S = R2 + 136 * MiB, Y5B = R2 + 145 * MiB;
constexpr size_t HG = R2, FB = R2, H8M = R2 + 162 * MiB;
constexpr size_t WG8 = WING + (size_t)ZC * D * 2;
constexpr size_t OB = H, MB = E, YB = Z;
static_assert(WF2 + 56 * MiB <= BIG && G + 272 * MiB <= E && E + 68 * MiB <= R2 && Y5B + 17 * MiB <= END && ACT + 490 * MiB <= R2 && HG + 140 * MiB <= END, "d_ws map");
}
#ifndef DUP_L4
#define DUP_L4 1
#endif
#ifndef DUP_L1
#define DUP_L1 1
#endif
#ifndef DUP_L6
#define DUP_L6 1
#endif
#ifndef DUP_L3
#define DUP_L3 1
#endif
#ifndef DUP_L2
#define DUP_L2 1
#endif
#ifndef DUP_SUB
#define DUP_SUB -1
#endif
#ifndef GATE8
#define GATE8 1
#endif
#ifndef MOEQ
#define MOEQ 1
#endif
#ifndef FFN2_8
#define FFN2_8 1
#endif
#ifndef GQ
#define GQ 1
#endif
#ifndef FFNQ
#define FFNQ 1
#endif
#ifndef FFN8
#define FFN8 1
#endif
#ifndef DUP_FFN
#define DUP_FFN 1
#endif
constexpr int LDS_UP = 131072;
struct FwdArgs { const float* in[41]; unsigned char* ws; float* out; int lo, hi; };
namespace pg8 {
struct EpiZG {
    static constexpr bool PERM = true;
    bf16_t* Zo; bf16_t* Go; const float* bias;
    __device__ __forceinline__ void operator()(const f32x4 (&acc)[2][2][4][2], const Unit& u, int wr, int wc, int fr, int fq) const {
        if (u.pn < ZC / BM) { EpiStore e; e.O = Zo; e.ldc = ZC; e(acc, u, wr, wc, fr, fq); }
        else { Unit v = u; v.pn = u.pn - ZC / BM; EpiGate e; e.O = Go; e.ldc = 4 * D; e.bias = bias; e(acc, v, wr, wc, fr, fq); }
    }
};
struct MoeOrderL {
    int nM, nN, nwg, G, c; const LAS int* tileE; const char* A; const char* B; size_t tA, tB, tBe;
    __device__ void init(const LAS int* plan, int nN_, int G_, int c_, const void* A_, int lda, const void* B_, int ldb, size_t expert_elems) {
        nM = plan[16]; nN = nN_; nwg = nM * nN; G = G_; c = c_; tileE = plan + 32; A = (const char*)A_; B = (const char*)B_; tA = (size_t)BM * lda * 2; tB = (size_t)BM * ldb * 2; tBe = expert_elems * 2; }
    __device__ bool next(int i, Unit& u) const {
        const long L = (long)i * G + c; if (L >= nwg) return false;
        int wgid = (int)L; { const int q = nwg / NXCD, r = nwg % NXCD, xcd = wgid % NXCD, off = wgid / NXCD; wgid = (xcd < r ? xcd * (q + 1) : r * (q + 1) + (xcd - r) * q) + off; }
        const int nig = WGM * nN, gid = wgid / nig, fm = gid * WGM, gsz = (nM - fm) < WGM ? (nM - fm) : WGM;
        u.pm = fm + ((wgid % nig) % gsz); u.pn = (wgid % nig) / gsz; u.x0 = tileE[u.pm]; u.x1 = 0;
        u.A = A + (size_t)u.pm * tA; u.B = B + (size_t)u.x0 * tBe + (size_t)u.pn * tB; return true;
    }
};
}
struct LnArgs { const float* xin; const float* cin; float* X; const bf16_t* Y; const float* mod_gate; const float* g; const float* bta; float* out; bf16_t* H; unsigned char* H8; const float* mod_h; int hsh, hsc;
                const float* wr; int* plan; int* ltok; int* tslot; float* tgate; int nrows; signed char* HQ; float* hscale; };
template <bool MOE, bool ROUTE> __device__ __forceinline__ void ln_rows(const LnArgs& a, const LAS int* planL) {
    const int tid_ = otid(); const int wave = tid_ >> 6, lane = tid_ & 63;
    for (int r = blockIdx.x * NWAVES + wave; r < a.nrows; r += gridDim.x * NWAVES) {
        const int mr = modrow(r);
        const float* xr = a.xin ? (r < TL ? a.xin + (size_t)r * D : a.cin + (size_t)(r - TL) * D) : a.X + (size_t)r * D;
        const float* md = a.mod_gate + (size_t)mr * 6144;
        size_t p0 = 0, p1 = 0; float g0 = 0.f, g1 = 0.f;
        if (MOE) { const int t0 = a.tslot[r * 2], t1 = a.tslot[r * 2 + 1]; g0 = a.tgate[r * 2]; g1 = a.tgate[r * 2 + 1]; const int e0 = t0 / T, e1 = t1 / T;
            p0 = (size_t)(planL[8 + e0] + (t0 - e0 * T)); p1 = (size_t)(planL[8 + e1] + (t1 - e1 * T)); }
        float v[16]; float s = 0.f;
#pragma unroll
        for (int j = 0; j < 4; ++j) { const int c = j * 256 + lane * 4; const float4 m4 = *(const float4*)(md + c); float4 x4;
            if (XBF && !a.xin) { const u32x2 xw = *(const u32x2*)((const bf16_t*)a.X + (size_t)r * D + c); x4 = make_float4(bflo(xw.x), bfhi(xw.x), bflo(xw.y), bfhi(xw.y)); } else x4 = *(const float4*)(xr + c);
            float y0, y1, y2, y3;
            if (MOE) { const u32x2 ya = *(const u32x2*)(a.Y + p0 * D + c), yb = *(const u32x2*)(a.Y + p1 * D + c);
                y0 = g0 * bflo(ya.x) + g1 * bflo(yb.x); y1 = g0 * bfhi(ya.x) + g1 * bfhi(yb.x); y2 = g0 * bflo(ya.y) + g1 * bflo(yb.y); y3 = g0 * bfhi(ya.y) + g1 * bfhi(yb.y); }
            else { const u32x2 yw = *(const u32x2*)(a.Y + (size_t)r * D + c); y0 = bflo(yw.x); y1 = bfhi(yw.x); y2 = bflo(yw.y); y3 = bfhi(yw.y); }
            v[j * 4] = ALPHA * x4.x + m4.x * y0; v[j * 4 + 1] = ALPHA * x4.y + m4.y * y1; v[j * 4 + 2] = ALPHA * x4.z + m4.z * y2; v[j * 4 + 3] = ALPHA * x4.w + m4.w * y3;
            s += v[j * 4] + v[j * 4 + 1] + v[j * 4 + 2] + v[j * 4 + 3]; }
#if LNPF
        if constexpr (!ROUTE) { const int rn = r + gridDim.x * NWAVES;
          if (rn < a.nrows) { const char* px; int nx;
              if (a.xin) { px = (const char*)(rn < TL ? a.xin + (size_t)rn * D : a.cin + (size_t)(rn - TL) * D); nx = 32; }
              else if (XBF) { px = (const char*)((const bf16_t*)a.X + (size_t)rn * D); nx = 16; } else { px = (const char*)(a.X + (size_t)rn * D); nx = 32; }
              const char* pt = lane < nx ? px + lane * 128 : ((!MOE && lane < nx + 16) ? (const char*)(a.Y + (size_t)rn * D) + (lane - nx) * 128 : nullptr);
              if (pt) __builtin_amdgcn_global_load_lds((const unsigned*)pt, (LAS unsigned*)((LAS unsigned char*)planL - 8192 + __builtin_amdgcn_readfirstlane(wave) * 256), 4, 0, 0); } }
#endif
        s = wave_sum(s, lane);
        const float mean = s * (1.f / D); float q = 0.f;
#pragma unroll
        for (int j = 0; j < 16; ++j) { v[j] -= mean; q += v[j] * v[j]; }
        q = wave_sum(q, lane);
        const float rstd = rsqrtf(q * (1.f / D) + 1e-5f);
        float lg[8]; float hq[16]; float am = 0.f; (void)hq;
#pragma unroll
        for (int e = 0; e < 8; ++e) lg[e] = 0.f;
#pragma unroll
        for (int j = 0; j < 4; ++j) { const int c = j * 256 + lane * 4; const float4 g4 = *(const float4*)(a.g + c), b4 = *(const float4*)(a.bta + c);
            float o[4]; o[0] = v[j * 4] * rstd * g4.x + b4.x; o[1] = v[j * 4 + 1] * rstd * g4.y + b4.y; o[2] = v[j * 4 + 2] * rstd * g4.z + b4.z; o[3] = v[j * 4 + 3] * rstd * g4.w + b4.w;
            if (XBF) { if (!a.out) { u32x2 xw; xw.x = pk2(o[0], o[1]); xw.y = pk2(o[2], o[3]); *(u32x2*)((bf16_t*)a.X + (size_t)r * D + c) = xw; } }
            else *(float4*)(a.X + (size_t)r * D + c) = make_float4(o[0], o[1], o[2], o[3]);
            if (a.out && r < TL) *(float4*)(a.out + (size_t)r * D + c) = make_float4(o[0], o[1], o[2], o[3]);
            if (a.H || a.H8 || a.HQ) { const float* mh = a.mod_h + (size_t)mr * 6144; const float4 sc = *(const float4*)(mh + a.hsc + c), sh = *(const float4*)(mh + a.hsh + c);
                float hv[4]; hv[0] = o[0] * (1.f + sc.x) + sh.x; hv[1] = o[1] * (1.f + sc.y) + sh.y; hv[2] = o[2] * (1.f + sc.z) + sh.z; hv[3] = o[3] * (1.f + sc.w) + sh.w;
                if (a.HQ) {
#pragma unroll
                    for (int i = 0; i < 4; ++i) { hq[j * 4 + i] = hv[i]; am = fmaxf(am, fabsf(hv[i])); } }
                if (a.H8) *(unsigned*)(a.H8 + (size_t)r * D + c) = pg8::pk4_fp8(hv[0] * pg8::S8_H, hv[1] * pg8::S8_H, hv[2] * pg8::S8_H, hv[3] * pg8::S8_H);
                if (a.H) { u32x2 w; w.x = pk2(hv[0], hv[1]); w.y = pk2(hv[2], hv[3]); *(u32x2*)(a.H + (size_t)r * D + c) = w; }
                if (ROUTE) {
#pragma unroll
                    for (int i = 0; i < 4; ++i) { const float4 w0 = *(const float4*)(a.wr + (c + i) * 8), w1 = *(const float4*)(a.wr + (c + i) * 8 + 4);
                        lg[0] += hv[i] * w0.x; lg[1] += hv[i] * w0.y; lg[2] += hv[i] * w0.z; lg[3] += hv[i] * w0.w; lg[4] += hv[i] * w1.x; lg[5] += hv[i] * w1.y; lg[6] += hv[i] * w1.z; lg[7] += hv[i] * w1.w; } } } }
        { if (a.HQ) {
#pragma unroll
            for (int o = 32; o >= 1; o >>= 1) am = fmaxf(am, shx(am, o, lane));
            const float qs = 127.f / fmaxf(am, 1e-30f);
            if (lane == 0) a.hscale[r] = am * (1.f / 127.f);
#pragma unroll
            for (int j = 0; j < 4; ++j) *(unsigned*)(a.HQ + (size_t)r * D + j * 256 + lane * 4) = pk4_i8(hq[j * 4] * qs, hq[j * 4 + 1] * qs, hq[j * 4 + 2] * qs, hq[j * 4 + 3] * qs); } }
        if (ROUTE) {
#pragma unroll
            for (int e = 0; e < 8; ++e) lg[e] = wave_sum(lg[e], lane);
            if (lane == 0) {
                int e1 = 0; float v1 = lg[0];
#pragma unroll
                for (int e = 1; e < 8; ++e) if (lg[e] > v1) { v1 = lg[e]; e1 = e; }
                int e2 = -1; float v2 = -3e38f;
#pragma unroll
                for (int e = 0; e < 8; ++e) if (e != e1 && lg[e] > v2) { v2 = lg[e]; e2 = e; }
                const float p2 = expf(v2 - v1), ga = 1.f / (1.f + p2), gb = p2 / (1.f + p2);
                const int s1 = atomicAdd(a.plan + e1, 1); a.ltok[e1 * T + s1] = r; a.tslot[r * 2] = e1 * T + s1; a.tgate[r * 2] = ga;
                const int s2 = atomicAdd(a.plan + e2, 1); a.ltok[e2 * T + s2] = r; a.tslot[r * 2 + 1] = e2 * T + s2; a.tgate[r * 2 + 1] = gb;
            } }
    }
}
__device__ __forceinline__ void moe_plan_lds(const int* plan, LAS int* planL) {
    if (threadIdx.x == 0) { int start = 0;
        for (int e = 0; e < 8; ++e) { const int cnt = plan[e]; const int nt = (cnt + 255) >> 8; planL[e] = cnt; planL[8 + e] = start * 256; for (int t = 0; t < nt; ++t) planL[32 + start + t] = e; start += nt; }
        planL[16] = start; }
    __syncthreads();
}

#define CAS __attribute__((address_space(4)))
__device__ __forceinline__ const float* karg_in(int i) { asm volatile("" : "+s"(i)); return (const float*)((const CAS void* const CAS*)__builtin_amdgcn_kernarg_segment_ptr())[i]; }
constexpr int FFN_ITEMS = 3 * 1792, FFN_CHUNK = 32;
template <bool MOE> __device__ __forceinline__ void ffn_conv_chunk(int chunk, int jj, unsigned char* wsp, LAS unsigned char* lds, int wave, int lane) {
    { const int t_ = otid(); wave = __builtin_amdgcn_readfirstlane(t_ >> 6); lane = t_ & 63; }
    chunk = __builtin_amdgcn_readfirstlane(chunk); asm volatile("" : "+s"(wsp), "+s"(jj), "+s"(chunk));
    LAS float* scr = (LAS float*)(lds + wave * 16384);
    constexpr bool F8W = MOE && FFN8;
    if constexpr (FFNQ && (!MOE || MOEQ)) {
        constexpr int NEX = MOE ? NE : 1, NBIG = NEX * 224;
        if (chunk < NBIG) { const int e = chunk / 224, g = chunk % 224, mat = g / 112, cb = g % 112;
            const size_t eo = MOE ? ((size_t)jj * NE + e) * D * DFF : (size_t)jj * D * DFF;
            colgroup_q_block(karg_in((MOE ? 38 : 34) + mat) + eo, DFF, 32 * cb, (signed char*)(wsp + W::WF13) + (size_t)e * 2 * DFF * D, D, mat, 2, (float*)(wsp + (MOE ? W::WS13M : W::WS13)) + e * 2 * DFF, lds); return; }
        chunk -= NBIG;
#pragma unroll 1
        for (int i = 0; i < FFN_CHUNK / NWAVES; ++i) { const int g = chunk * FFN_CHUNK + i * NWAVES + wave; if (g >= NEX * 1792) break;
            const int e = g / 1792, it = g % 1792; const size_t eo = MOE ? ((size_t)jj * NE + e) * D * DFF : (size_t)jj * D * DFF;
            if (MOE ? FFN8 : FFN2_8) transpose_item8(karg_in(MOE ? 40 : 36) + eo, D, D / 32, (unsigned char*)(wsp + W::WF2) + (size_t)e * D * DFF, DFF, 0, 1, pg8::S8_W2, scr, it, lane);
            else transpose_item(karg_in(MOE ? 40 : 36) + eo, D, D / 32, (bf16_t*)(wsp + W::WF2) + (size_t)e * D * DFF, DFF, 0, 1, 0, nullptr, scr, it, lane); }
        return; }
#pragma unroll 1
    for (int i = 0; i < FFN_CHUNK / NWAVES; ++i) {
        const int g = chunk * FFN_CHUNK + i * NWAVES + wave; if (g >= (MOE ? NE : 1) * FFN_ITEMS) break;
        const int e = g / FFN_ITEMS, r = g % FFN_ITEMS, mat = r / 1792, it = r % 1792;
        const size_t eo = MOE ? ((size_t)jj * NE + e) * D * DFF : (size_t)jj * D * DFF;
        const float* src = karg_in((MOE ? 38 : 34) + mat) + eo;
        if (F8W) { unsigned char* W13_8 = (unsigned char*)(wsp + W::WF13) + (size_t)e * 2 * DFF * D; unsigned char* W2_8 = (unsigned char*)(wsp + W::WF2) + (size_t)e * D * DFF;
            if (mat < 2) transpose_item8(src, DFF, DFF / 32, W13_8, D, mat, 2, pg8::S8_W13, scr, it, lane); else transpose_item8(src, D, D / 32, W2_8, DFF, 0, 1, pg8::S8_W2, scr, it, lane); }
        else { bf16_t* W13 = (bf16_t*)(wsp + W::WF13) + (size_t)e * 2 * DFF * D; bf16_t* W2 = (bf16_t*)(wsp + W::WF2) + (size_t)e * D * DFF;
            if (mat < 2) transpose_item(src, DFF, DFF / 32, W13, D, mat, 2, 0, nullptr, scr, it, lane); else transpose_item(src, D, D / 32, W2, DFF, 0, 1, 0, nullptr, scr, it, lane); }
    }
}
struct FwdCtx { unsigned char* ws; float* out; int lo, hi; };
#define PHASE_BEGIN if (pc >= lo && pc < hi) { unsigned char* wsp = ws; asm volatile("" : "+s"(wsp)); int lp = l; asm volatile("" : "+s"(lp)); \
        int bid = blockIdx.x; asm volatile("" : "+s"(bid)); int GRD = gridDim.x; asm volatile("" : "+s"(GRD)); \
        const int tid = otid(); const int wave = tid >> 6, lane = tid & 63, gw = bid * NWAVES + wave; (void)lane; (void)gw; (void)lp; \
        float* MOD = (float*)(wsp + W::MOD); float* X = (float*)(wsp + W::X); bf16_t* Hb = (bf16_t*)(wsp + W::H); (void)MOD; (void)X; (void)Hb;
#define PHASE_END   if (pc + 1 < hi) xcd_barrier(bar); } ++pc;
#define L_PTRS const float* MODl = MOD + (size_t)lp * 9 * 6144; const int jj = lp >> 1; const float lam_init = 0.8f - 0.6f * __expf(-0.3f * (float)lp); (void)MODl; (void)jj; (void)lam_init; \
        bf16_t* WING = (bf16_t*)(wsp + W::WING); bf16_t* WBR = (bf16_t*)(wsp + W::WBR); bf16_t* WOUT = (bf16_t*)(wsp + W::WOUT); bf16_t* WEXP = (bf16_t*)(wsp + W::WEXP); bf16_t* WGLU = (bf16_t*)(wsp + W::WGLU); \
        bf16_t* WF13 = (bf16_t*)(wsp + W::WF13); bf16_t* WF2 = (bf16_t*)(wsp + W::WF2); \
        bf16_t* ZB = (bf16_t*)(wsp + W::Z); bf16_t* GB = (bf16_t*)(wsp + W::G); bf16_t* EB = (bf16_t*)(wsp + W::E); bf16_t* OB = (bf16_t*)(wsp + W::OB); bf16_t* MB = (bf16_t*)(wsp + W::MB); bf16_t* YB = (bf16_t*)(wsp + W::YB); \
        int* PLANG = (int*)(wsp + W::CTL + W::PLAN + (size_t)jj * 4096); int* LTOK = (int*)(wsp + W::LTOK); int* TSLOT = (int*)(wsp + W::TSLOT); float* TGATE = (float*)(wsp + W::TGATE); \
        unsigned* QC = (unsigned*)(wsp + W::CTL + W::QCTR + (size_t)lp * 1024); \
        (void)WING; (void)WBR; (void)WOUT; (void)WEXP; (void)WGLU; (void)WF13; (void)WF2; (void)ZB; (void)GB; (void)EB; (void)OB; (void)MB; (void)YB; (void)PLANG; (void)LTOK; (void)TSLOT; (void)TGATE; (void)QC;
#define MK_SA S5Args sa; { unsigned char* s5t = wsp + W::S5TAB + (size_t)lp * 288 * 1024; sa.ZB = ZB; sa.S5A = (const float4*)s5t; sa.S5B = (const bf16_t*)(s5t + 32 * 1024); sa.S5C = (const bf16_t*)(s5t + 160 * 1024); \
        sa.dskip = karg_in(19) + lp * 256; sa.S = (float2*)(wsp + W::S5S); sa.Y5 = (bf16_t*)(wsp + W::Y5B); sa.dbg = nullptr; }
#define MK_PA PrepArgs pa{ZB, EB, (bf16_t*)(wsp + W::QM), (bf16_t*)(wsp + W::KM), (bf16_t*)(wsp + W::QD), (bf16_t*)(wsp + W::KD), (bf16_t*)(wsp + W::VTN), (bf16_t*)(wsp + W::VTM), (bf16_t*)(wsp + W::VTD)};
#define MK_L2 LnArgs l2{}; l2.X = X; l2.mod_gate = MODl + 5 * D; l2.g = karg_in(32) + lp * D; l2.bta = karg_in(33) + lp * D; l2.out = lp == DEPTH - 1 ? OUTP : nullptr; \
        l2.H = (GQ || lp == DEPTH - 1) ? nullptr : Hb; l2.H8 = (!GQ && GATE8 && lp != DEPTH - 1) ? (unsigned char*)(wsp + W::H8M) : nullptr; l2.HQ = (GQ && lp != DEPTH - 1) ? (signed char*)(wsp + (GLATE ? W::H8M : W::H)) : nullptr; l2.hscale = (float*)(wsp + W::HSM); l2.mod_h = MODl + 9 * 6144; l2.hsh = 0; l2.hsc = D; l2.tslot = TSLOT; l2.tgate = TGATE; l2.nrows = TR;


template <int LAYER> __device__ __forceinline__ void layer_body(const FwdCtx& cx, LAS unsigned char* lds, const XcdBarrier& bar, int& pc) {
    unsigned char* ws = cx.ws; float* OUTP = cx.out; const int lo = cx.lo, hi = cx.hi; const int l = LAYER; constexpr bool moe = (LAYER & 1) != 0;
    constexpr bool LASTL = LAYER == DEPTH - 1; constexpr int NRT = LASTL ? TL / 256 : T / 256, TR = NRT * 256;
    const int NGW = gridDim.x * NWAVES; (void)NGW;
    LAS float* biasL = (LAS float*)(lds + LDS_UP); LAS int* planL = (LAS int*)(lds + LDS_UP + 8192); LAS int* qslot = (LAS int*)(lds + LDS_UP + 12032); (void)biasL; (void)planL; (void)qslot;
        PHASE_BEGIN L_PTRS
            { int cursor = 0;
#if GQ
              for (int it = bid; it < INC / 32 + 4 * D / 32; it += GRD) {
                  if (it < INC / 32) colgroup_q_block(karg_in(6) + (size_t)lp * D * INC, INC, 32 * it, (signed char*)WING, D, 0, 1, (float*)(wsp + W::WSIN), lds);
                  else colgroup_q_block(karg_in(27) + (size_t)lp * D * 4 * D, 4 * D, 32 * (it - INC / 32), (signed char*)(wsp + W::WG8), D, 0, 1, (float*)(wsp + W::WSIN) + ZC, lds); }
              if (bid == GRD - 1 && tid < ZC - INC) ((float*)(wsp + W::WSIN))[INC + tid] = 0.f;
#else
              conv_matrix(karg_in(6) + (size_t)lp * D * INC, D, INC, INC, WING, D, 0, 1, 0, nullptr, lds, cursor);
              if (GATE8) conv_matrix8(karg_in(27) + (size_t)lp * D * 4 * D, D, 4 * D, 4 * D, (unsigned char*)(wsp + W::WG8), D, 0, 1, pg8::S8_W13, lds, cursor);
              else conv_matrix(karg_in(27) + (size_t)lp * D * 4 * D, D, 4 * D, 4 * D, WING, D, ZC, 1, 0, nullptr, lds, cursor);
#endif
              for (int i = 0; i < 4; ++i) conv_matrix(karg_in(26) + ((size_t)lp * 4 + i) * 256 * D, 256, D, D, WBR, 256, i * D, 1, 0, nullptr, lds, cursor);
              conv_matrix(karg_in(29) + (size_t)lp * D * D, D, D, D, WOUT, D, 0, 1, 0, nullptr, lds, cursor);
              if (!GQ) zero_rect(WING, D, INC, ZC, 0, D);
              conv_matrix(karg_in(10) + (size_t)lp * 256 * 384, 256, 384, 384, WEXP, 384, 0, 1, 0, karg_in(8) + lp * 256, lds, cursor);
              conv_matrix(karg_in(11) + (size_t)lp * 128 * 512, 128, 512, 512, WEXP, 384, 384, 1, 256, karg_in(9) + lp * 128, lds, cursor);
              zero_rect(WEXP, 384, 0, 384, 256, 384); zero_rect(WEXP, 384, 384, 896, 0, 256); zero_rect(WEXP, 384, 896, 1024, 0, 384);
              conv_matrix(karg_in(20) + (size_t)lp * 256 * 512, 256, 256, 512, WGLU, 256, 0, 2, 0, nullptr, lds, cursor);
              conv_matrix(karg_in(20) + (size_t)lp * 256 * 512 + 256, 256, 256, 512, WGLU, 256, 1, 2, 0, nullptr, lds, cursor);
              __syncthreads(); }
        PHASE_END
        for (int rep = 0; rep < DUP_L1; ++rep) {
        PHASE_BEGIN L_PTRS
#if GQ
            { pg8::StaticOrder S; S.init(T / 256, ZC / 256, GRD, bid, (bf16_t*)(wsp + (GLATE ? W::H8M : W::H)), D / 2, WING, D / 2);
              pg8::EpiStoreQ E; E.O = ZB; E.ldc = ZC; E.hs = (const float*)(wsp + W::HSM); E.ws = (const float*)(wsp + W::WSIN);
              pg8::gemm_phase<pg8::EpiStoreQ, pg8::StaticOrder, false, true>(lds, D / 2, D / 2, D / 2, S, E);
#ifdef DUP_Z
              asm volatile("" ::: "memory"); pg8::gemm_phase<pg8::EpiStoreQ, pg8::StaticOrder, false, true>(lds, D / 2, D / 2, D / 2, S, E);
#endif
            }
#if !GLATE
            { pg8::StaticOrder S; S.init(NRT, 4 * D / 256, GRD, bid, Hb, D / 2, (bf16_t*)(wsp + W::WG8), D / 2);
              pg8::EpiGateQ E; E.O = (unsigned char*)GB; E.ldc = 4 * D; E.bias = karg_in(28) + (size_t)lp * 4 * D; E.hs = (const float*)(wsp + W::HSM); E.ws = (const float*)(wsp + W::WSIN) + ZC;
              pg8::gemm_phase<pg8::EpiGateQ, pg8::StaticOrder, false, true>(lds, D / 2, D / 2, D / 2, S, E); }
#endif
#elif GATE8
            { pg8::StaticOrder S; S.init(T / 256, ZC / 256, GRD, bid, Hb, D, WING, D);
              pg8::EpiStore E; E.O = ZB; E.ldc = ZC;
              pg8::gemm_phase<pg8::EpiStore, pg8::StaticOrder>(lds, D, D, D, S, E); }
            { pg8::StaticOrder S; S.init(NRT, 4 * D / 256, GRD, bid, (bf16_t*)(wsp + W::H8M), D / 2, (bf16_t*)(wsp + W::WG8), D / 2);
              pg8::EpiGate E; E.O = GB; E.ldc = 4 * D; E.bias = karg_in(28) + (size_t)lp * 4 * D; E.isc = 1.f / (pg8::S8_H * pg8::S8_W13); E.u8 = G8;
              pg8::gemm_phase<pg8::EpiGate, pg8::StaticOrder, true>(lds, D / 2, D / 2, D / 2, S, E); }
#else
            { pg8::StaticOrder S; S.init(T / 256, NWG / 256, GRD, bid, Hb, D, WING, D);
              pg8::EpiZG E; E.Zo = ZB; E.Go = GB; E.bias = karg_in(28) + (size_t)lp * 4 * D;
              pg8::gemm_phase<pg8::EpiZG, pg8::StaticOrder>(lds, D, D, D, S, E); }
#endif
        PHASE_END
        }
        for (int rep = 0; rep < DUP_L2; ++rep) {
        PHASE_BEGIN L_PTRS MK_SA
            { pg8::StaticOrder S; S.init(T / 256, 4, GRD, bid, ZB + O_MQ, ZC, WEXP, 384);
              pg8::EpiStore E; E.O = EB; E.ldc = D;
              pg8::gemm_phase<pg8::EpiStore, pg8::StaticOrder>(lds, 384, ZC, 384, S, E);
              LAS float* tile = (LAS float*)(lds + wave * 8448);
              for (int it = bid; it < NB * 2 * NCHK * 2; it += GRD) { const int gh = it & 1, j = (it >> 1) % NCHK, bd = (it >> 1) / NCHK; s5_pass1_item(sa, bd >> 1, bd & 1, j, gh * 8 + wave, tile, lane); }
              __syncthreads(); }
        PHASE_END
        }
        for (int rep = 0; rep < DUP_L3; ++rep) {
        PHASE_BEGIN L_PTRS MK_PA
            { const float* rope_tab = (const float*)(wsp + W::ROPE);
              for (int r = gw; r < T; r += 6 * NGW) prep_rows_fast<6>(pa, rope_tab, r, NGW, T, lane); }
            for (int ti = bid; ti < T / 64; ti += GRD) prep_vt_tile_fast(pa, ti, lds);
        PHASE_END
        }
        for (int rep = 0; rep < DUP_L4; ++rep) {
        PHASE_BEGIN L_PTRS
            { float lam; { const float* lv = (const float*)(wsp + W::LAMV) + lp * 128; float s1 = 0.f, s2 = 0.f; for (int i = 0; i < 32; ++i) { s1 += lv[i] * lv[32 + i]; s2 += lv[64 + i] * lv[96 + i]; } lam = __expf(s1) - __expf(s2) + lam_init; }
              na_load_bias(karg_in(7) + (size_t)lp * 4 * 15 * 31, biasL);
#define QPOP2(k, r2) ({ __syncthreads(); if (otid() == 0) *qslot = (int)atomicAdd(QC + 64 * (k) + 32 * rep + 16 * (r2), 1u); __syncthreads(); *qslot; })
#define SUBSCOPE unsigned char* w2 = wsp; asm volatile("" : "+s"(w2)); const int t2_ = otid(); const int wv = __builtin_amdgcn_readfirstlane(t2_ >> 6), ln = t2_ & 63; (void)wv; (void)ln;
              const int nconv = (FFNQ && (!moe || MOEQ)) ? (moe ? NE : 1) * (224 + 1792 / FFN_CHUNK) : ((moe ? NE : 1) * FFN_ITEMS + FFN_CHUNK - 1) / FFN_CHUNK; bool conv_done = false;
#define CONV_SOME(nmax) do { for (int c_ = 0; c_ < (nmax) && !conv_done; ++c_) { __syncthreads(); if (otid() == 0) *qslot = (int)atomicAdd(QC + 8 + 32 * rep, 1u); __syncthreads(); const int q_ = *qslot; \
                  if (q_ >= nconv) conv_done = true; else ffn_conv_chunk<moe>(q_, jj, wsp, lds, wave, lane); } } while (0)
              { SUBSCOPE AttnArgs aa{(bf16_t*)(w2 + W::QD), (bf16_t*)(w2 + W::KD), (bf16_t*)(w2 + W::VTD), (bf16_t*)(w2 + W::OB), nullptr, karg_in(25) + lp * 64, lam_init, 0};
                for (int r2 = 0; r2 < (DUP_SUB == 0 ? 2 : 1); ++r2) for (;;) { const int u = QPOP2(0, r2); if (u >= NB * 4 * (LASTL ? 16 : 17)) break; const int qb = u / 32, bh = u % 32; attn_unit<2>(aa, bh >> 2, bh & 3, qb, lds, lam); CONV_SOME(2); } }
              { SUBSCOPE AttnArgs aa{(bf16_t*)(w2 + W::QM), (bf16_t*)(w2 + W::KM), (bf16_t*)(w2 + W::VTM), (bf16_t*)(w2 + W::OB), nullptr, nullptr, lam_init, 0};
                for (int r2 = 0; r2 < (DUP_SUB == 1 ? 2 : 1); ++r2) for (;;) { const int u = QPOP2(1, r2); if (u >= NB * 4 * (LASTL ? 16 : 17)) break; const int qb = u / 32, bh = u % 32; attn_unit<1>(aa, bh >> 2, bh & 3, qb, lds, 0.f); CONV_SOME(2); } }
              { SUBSCOPE S5Args sa; { unsigned char* s5t = w2 + W::S5TAB + (size_t)lp * 288 * 1024; sa.ZB = (bf16_t*)(w2 + W::Z); sa.S5A = (const float4*)s5t; sa.S5B = (const bf16_t*)(s5t + 32 * 1024); sa.S5C = (const bf16_t*)(s5t + 160 * 1024);
                  sa.dskip = karg_in(19) + lp * 256; sa.S = (float2*)(w2 + W::S5S); sa.Y5 = (bf16_t*)(w2 + W::Y5B); sa.dbg = nullptr; }
                LAS float* tile = (LAS float*)(lds + wv * 8448);
                for (int r2 = 0; r2 < (DUP_SUB == 2 ? 2 : 1); ++r2) for (;;) { const int it = QPOP2(2, r2); if (it >= NB * (LASTL ? NCHK - 4 : NCHK) * 2) break; const int gh = it & 1, tc = LASTL ? 4 + (it >> 1) % (NCHK - 4) : (it >> 1) % NCHK, b = LASTL ? (it >> 1) / (NCHK - 4) : (it >> 1) / NCHK; s5_pass2_item(sa, b, tc, gh * 8 + wv, tile, ln); } }
              { SUBSCOPE NaArgs na{(bf16_t*)(w2 + W::Z), (bf16_t*)(w2 + W::VTN), (bf16_t*)(w2 + W::OB), nullptr};
                for (int r2 = 0; r2 < (DUP_SUB == 3 ? 2 : 1); ++r2) for (;;) { const int it = QPOP2(3, r2); if (it >= (LASTL ? 512 : 544)) break; na_wave(na, it, biasL, wv, ln); } }
#undef SUBSCOPE
              CONV_SOME(1 << 30);
#undef CONV_SOME
              __syncthreads(); }
        PHASE_END
        }
        PHASE_BEGIN L_PTRS
            { pg8::StaticOrder S; S.init(NRT, 2, GRD, bid, (bf16_t*)(wsp + W::Y5B), 256, WGLU, 256);
              pg8::EpiPair<true> E; E.O = OB; E.ldc = D; E.col_off = 512;
              pg8::gemm_phase<pg8::EpiPair<true>, pg8::StaticOrder>(lds, 256, 256, 256, S, E); }
#if GLATE && GQ
            { pg8::StaticOrder S; S.init(NRT, 4 * D / 256, GRD, (bid + GRD / 2) % GRD, (bf16_t*)(wsp + W::H8M), D / 2, (bf16_t*)(wsp + W::WG8), D / 2);
              pg8::EpiGateQ E; E.O = (unsigned char*)GB; E.ldc = 4 * D; E.bias = karg_in(28) + (size_t)lp * 4 * D; E.hs = (const float*)(wsp + W::HSM); E.ws = (const float*)(wsp + W::WSIN) + ZC;
              pg8::gemm_phase<pg8::EpiGateQ, pg8::StaticOrder, false, true>(lds, D / 2, D / 2, D / 2, S, E); }
#endif
        PHASE_END
        for (int rep = 0; rep < DUP_L6; ++rep) {
        PHASE_BEGIN L_PTRS
            { pg8::MergeOrder S; S.init(NRT, GRD, bid, OB, WBR);
              pg8::EpiMerge E; E.M = MB; E.G = GB;
              pg8::gemm_phase<pg8::EpiMerge, pg8::MergeOrder>(lds, 256, D, 256, S, E); }
        PHASE_END
        }
        PHASE_BEGIN L_PTRS
            { pg8::StaticOrder S; S.init(NRT, 4, GRD, bid, MB, D, WOUT, D);
              pg8::EpiStore E; E.O = YB; E.ldc = D;
              pg8::gemm_phase<pg8::EpiStore, pg8::StaticOrder>(lds, D, D, D, S, E); }
        PHASE_END
        PHASE_BEGIN L_PTRS
            { LnArgs la{}; la.xin = lp == 0 ? karg_in(0) : nullptr; la.cin = karg_in(2); la.X = X; la.Y = YB; la.mod_gate = MODl + 2 * D; la.g = karg_in(30) + lp * D; la.bta = karg_in(31) + lp * D; la.out = nullptr;
              la.H = ((FFN8 && moe) || (FFNQ && !moe)) ? nullptr : Hb; la.H8 = (FFN8 && moe && !MOEQ) ? (unsigned char*)Hb : nullptr; la.HQ = (FFNQ && (!moe || MOEQ)) ? (signed char*)Hb : nullptr; la.hscale = (float*)(wsp + (moe ? W::HSM : W::TSLOT)); la.mod_h = MODl; la.hsh = 3 * D; la.hsc = 4 * D; la.wr = karg_in(37) + (size_t)jj * D * 8; la.plan = PLANG; la.ltok = LTOK; la.tslot = TSLOT; la.tgate = TGATE; la.nrows = TR;
              if (moe) ln_rows<false, true>(la, planL); else ln_rows<false, false>(la, planL); }
        PHASE_END
        if (!moe) {
            for (int rep = 0; rep < DUP_FFN; ++rep) {
            PHASE_BEGIN L_PTRS
#if 0
                { pg8::StaticOrder S; S.init(T / 256, 2 * DFF / 256, GRD, bid, Hb, D / 2, WF13, D / 2);
                  pg8::EpiSwiglu8 E; E.O = (unsigned char*)(wsp + W::ACT); E.ldc = DFF; E.isc = 1.f / (pg8::S8_H * pg8::S8_W13); E.osc = pg8::S8_ACT;
                  pg8::gemm_phase<pg8::EpiSwiglu8, pg8::StaticOrder, true>(lds, D / 2, D / 2, D / 2, S, E); }
#elif FFNQ
                { pg8::StaticOrder S; S.init(T / 256, 2 * DFF / 256, GRD, bid, Hb, D / 2, WF13, D / 2);
                  pg8::EpiSwigluQ<FFN2_8 != 0> E; E.O = (bf16_t*)(wsp + W::ACT); E.ldc = DFF; E.hs = (const float*)(wsp + W::TSLOT); E.ws = (const float*)(wsp + W::WS13); E.osc = pg8::S8_ACT;
                  pg8::gemm_phase<pg8::EpiSwigluQ<FFN2_8 != 0>, pg8::StaticOrder, false, true>(lds, D / 2, D / 2, D / 2, S, E); }
#else
                { pg8::StaticOrder S; S.init(T / 256, 2 * DFF / 256, GRD, bid, Hb, D, WF13, D);
                  pg8::EpiPair<false> E; E.O = (bf16_t*)(wsp + W::ACT); E.ldc = DFF; E.col_off = 0;
                  pg8::gemm_phase<pg8::EpiPair<false>, pg8::StaticOrder>(lds, D, D, D, S, E); }
#endif
            PHASE_END
            PHASE_BEGIN L_PTRS
#if FFN2_8
                { pg8::StaticOrder S; S.init(T / 256, 4, GRD, bid, (bf16_t*)(wsp + W::ACT), DFF / 2, WF2, DFF / 2);
                  pg8::EpiStoreS E; E.O = (bf16_t*)(wsp + W::FB); E.ldc = D; E.scale = 1.f / (pg8::S8_ACT * pg8::S8_W2);
                  pg8::gemm_phase<pg8::EpiStoreS, pg8::StaticOrder, true>(lds, DFF / 2, DFF / 2, DFF / 2, S, E); }
#else
                { pg8::StaticOrder S; S.init(T / 256, 4, GRD, bid, (bf16_t*)(wsp + W::ACT), DFF, WF2, DFF);
                  pg8::EpiStore E; E.O = (bf16_t*)(wsp + W::FB); E.ldc = D;
                  pg8::gemm_phase<pg8::EpiStore, pg8::StaticOrder>(lds, DFF, DFF, DFF, S, E); }
#endif
            PHASE_END
            }
            PHASE_BEGIN L_PTRS MK_L2
                l2.Y = (bf16_t*)(wsp + W::FB); ln_rows<false, false>(l2, planL);
            PHASE_END
        } else {
            PHASE_BEGIN L_PTRS
                moe_plan_lds(PLANG, planL);
                { const int nrows = planL[16] * 256;
#if FFN8
                  for (int pr0 = gw; pr0 < nrows; pr0 += 4 * NGW) {
                      int tok[4]; u32x4 v0[4]; float hsv[4];
#pragma unroll
                      for (int q = 0; q < 4; ++q) { const int pr = pr0 + q * NGW; tok[q] = -1; if (pr < nrows) { const int e = planL[32 + (pr >> 8)], slot = pr - planL[8 + e]; if (slot < planL[e]) tok[q] = LTOK[e * T + slot]; } }
#pragma unroll
                      for (int q = 0; q < 4; ++q) { v0[q] = (u32x4){0u, 0u, 0u, 0u}; hsv[q] = 0.f; if (tok[q] >= 0) { v0[q] = ((const u32x4*)((const unsigned char*)Hb + (size_t)tok[q] * D))[lane]; if (MOEQ) hsv[q] = ((const float*)(wsp + W::HSM))[tok[q]]; } }
#pragma unroll
                      for (int q = 0; q < 4; ++q) { const int pr = pr0 + q * NGW; if (pr < nrows) { if (MOEQ && lane == 0) ((float*)(wsp + W::HGS))[pr] = hsv[q]; ((u32x4*)((unsigned char*)(wsp + W::HG) + (size_t)pr * D))[lane] = v0[q]; } } } }
#else
                  for (int pr = gw; pr < nrows; pr += NGW) { const int e = planL[32 + (pr >> 8)], slot = pr - planL[8 + e];
                      u32x4 v0 = (u32x4){0u, 0u, 0u, 0u}, v1 = v0;
                      if (slot < planL[e]) { const int tok = LTOK[e * T + slot]; const u32x4* src = (const u32x4*)(Hb + (size_t)tok * D); v0 = src[lane]; v1 = src[64 + lane]; }
                      u32x4* dst = (u32x4*)((bf16_t*)(wsp + W::HG) + (size_t)pr * D); dst[lane] = v0; dst[64 + lane] = v1; } }
#endif
            PHASE_END
            for (int rep = 0; rep < DUP_FFN; ++rep) {
            PHASE_BEGIN L_PTRS
                if (lo == pc) moe_plan_lds(PLANG, planL);
#if MOEQ
                { pg8::MoeOrderL S; S.init(planL, 2 * DFF / 256, GRD, bid, (bf16_t*)(wsp + W::HG), D / 2, WF13, D / 2, (size_t)2 * DFF * D / 2);
                  pg8::EpiSwigluQ<true> E; E.O = (bf16_t*)(wsp + W::ACT); E.ldc = DFF; E.hs = (const float*)(wsp + W::HGS); E.ws = (const float*)(wsp + W::WS13M); E.osc = pg8::S8_ACT;
                  pg8::gemm_phase<pg8::EpiSwigluQ<true>, pg8::MoeOrderL, false, true>(lds, D / 2, D / 2, D / 2, S, E); }
#elif FFN8
                { pg8::MoeOrderL S; S.init(planL, 2 * DFF / 256, GRD, bid, (bf16_t*)(wsp + W::HG), D / 2, WF13, D / 2, (size_t)2 * DFF * D / 2);
                  pg8::EpiSwiglu8 E; E.O = (unsigned char*)(wsp + W::ACT); E.ldc = DFF; E.isc = 1.f / (pg8::S8_H * pg8::S8_W13); E.osc = pg8::S8_ACT;
                  pg8::gemm_phase<pg8::EpiSwiglu8, pg8::MoeOrderL, true>(lds, D / 2, D / 2, D / 2, S, E); }
#else
                { pg8::MoeOrderL S; S.init(planL, 2 * DFF / 256, GRD, bid, (bf16_t*)(wsp + W::HG), D, WF13, D, (size_t)2 * DFF * D);
                  pg8::EpiPair<false> E; E.O = (bf16_t*)(wsp + W::ACT); E.ldc = DFF; E.col_off = 0;
                  pg8::gemm_phase<pg8::EpiPair<false>, pg8::MoeOrderL>(lds, D, D, D, S, E); }
#endif
            PHASE_END
            PHASE_BEGIN L_PTRS
                if (lo == pc) moe_plan_lds(PLANG, planL);
#if FFN8
                { pg8::MoeOrderL S; S.init(planL, 4, GRD, bid, (bf16_t*)(wsp + W::ACT), DFF / 2, WF2, DFF / 2, (size_t)D * DFF / 2);
                  pg8::EpiStoreS E; E.O = (bf16_t*)(wsp + W::HG); E.ldc = D; E.scale = 1.f / (pg8::S8_ACT * pg8::S8_W2);
                  pg8::gemm_phase<pg8::EpiStoreS, pg8::MoeOrderL, true>(lds, DFF / 2, DFF / 2, DFF / 2, S, E); }
#else
                { pg8::MoeOrderL S; S.init(planL, 4, GRD, bid, (bf16_t*)(wsp + W::ACT), DFF, WF2, DFF, (size_t)D * DFF);
                  pg8::EpiStore E; E.O = (bf16_t*)(wsp + W::HG); E.ldc = D;
                  pg8::gemm_phase<pg8::EpiStore, pg8::MoeOrderL>(lds, DFF, DFF, DFF, S, E); }
#endif
            PHASE_END
            }
            PHASE_BEGIN L_PTRS
                if (lo == pc) moe_plan_lds(PLANG, planL);
                MK_L2 l2.Y = (bf16_t*)(wsp + W::HG); ln_rows<true, false>(l2, planL);
            PHASE_END
        }
}
__global__ void __launch_bounds__(NTHR, 2) fwd(FwdArgs A) {
    extern __shared__ __attribute__((aligned(16))) unsigned char lds_raw[];
    LAS unsigned char* lds = (LAS unsigned char*)lds_raw;
    unsigned char* ws = A.ws;
    volatile LAS unsigned* bst = (volatile LAS unsigned*)(lds + LDS_UP + 12288);
    if (threadIdx.x < 4) bst[threadIdx.x] = 0u;
    __syncthreads();
    XcdBarrier bar = xcd_barrier_post((unsigned*)(ws + W::CTL), bst);
    const int lo = A.lo, hi = A.hi; int pc = 0; const int l = 0; (void)l;
    const int NGW = gridDim.x * NWAVES;
    PHASE_BEGIN
        { LAS float* condL = (LAS float*)lds;
          float* MODP = (float*)(wsp + W::MODP);
          for (int u = bid; u < 4 * 12 * 8; u += GRD) { const int ks = u & 7, cg = (u >> 3) % 12, l = u / 96;
              __syncthreads();
              for (int i = tid; i < 9 * 128; i += NTHR) { const int r = i >> 7, k = ks * 128 + (i & 127); const float v = r < 8 ? karg_in(1)[r * D + k] : karg_in(3)[k]; condL[i] = v * sigm(v); }
              __syncthreads();
              const int n = cg * 512 + tid; float acc[9];
#pragma unroll
              for (int r = 0; r < 9; ++r) acc[r] = 0.f;
              const float* w = karg_in(4) + ((size_t)l * D + ks * 128) * 6144 + n;
#pragma unroll 4
              for (int k = 0; k < 128; ++k) { const float wv = w[(size_t)k * 6144];
#pragma unroll
                  for (int r = 0; r < 9; ++r) acc[r] += condL[r * 128 + k] * wv; }
#pragma unroll
              for (int r = 0; r < 9; ++r) MODP[(((size_t)ks * 4 + l) * 9 + r) * 6144 + n] = acc[r]; }
          for (int i = bid * NTHR + tid; i < 4 * 2048; i += GRD * NTHR) { const int l = i >> 11, j = i & 2047; unsigned char* tb = wsp + W::S5TAB + (size_t)l * 288 * 1024;
              const int gi = j >> 6, p = j & 63;
              const float* lam_re = karg_in(12) + (size_t)l * 2048; const float* lam_im = karg_in(13) + (size_t)l * 2048; const float* log_dt = karg_in(14) + l * 32;
              const float* b_re = karg_in(15) + (size_t)l * 32768; const float* b_im = karg_in(16) + (size_t)l * 32768; const float* c_re = karg_in(17) + (size_t)l * 32768; const float* c_im = karg_in(18) + (size_t)l * 32768;
              float4* S5A = (float4*)tb; bf16_t* S5B = (bf16_t*)(tb + 32 * 1024); bf16_t* S5C = (bf16_t*)(tb + 160 * 1024);
              const double lre = lam_re[j], lim = lam_im[j], dt = exp((double)log_dt[gi]);
              const double x = lre * dt; double y = lim * dt; y -= 6.283185307179586476925 * rint(y / 6.283185307179586476925);
              float sy, cy; sincosf((float)y, &sy, &cy); const float sh = sinf((float)(0.5 * y));
              const double em1 = x * (1.0 + x * 0.5 * (1.0 + x * (1.0 / 3.0) * (1.0 + x * 0.25 * (1.0 + x * 0.2 * (1.0 + x * (1.0 / 6.0))))));
              const double nr = em1 * (double)cy - 2.0 * (double)sh * (double)sh, ni = (1.0 + em1) * (double)sy;
              const double ar = 1.0 + nr, ai = ni; double pr = ar, pi = ai;
#pragma unroll
              for (int k = 0; k < 6; ++k) { const double t = pr * pr - pi * pi; pi = 2.0 * pr * pi; pr = t; }
              S5A[j] = make_float4((float)ar, (float)ai, (float)pr, (float)pi);
              const double den = lre * lre + lim * lim; const float fr = (float)((nr * lre + ni * lim) / den), fi = (float)((ni * lre - nr * lim) / den);
              for (int c = 0; c < 16; ++c) { const float br = b_re[j * 16 + c], bi = b_im[j * 16 + c];
                  S5B[((size_t)gi * 128 + p) * 16 + c] = (bf16_t)f2bf(fr * br - fi * bi); S5B[((size_t)gi * 128 + 64 + p) * 16 + c] = (bf16_t)f2bf(fr * bi + fi * br);
                  S5C[((size_t)gi * 16 + c) * 128 + p] = (bf16_t)f2bf(c_re[(gi * 16 + c) * 64 + p]); S5C[((size_t)gi * 16 + c) * 128 + 64 + p] = (bf16_t)f2bf(-c_im[(gi * 16 + c) * 64 + p]); } }
          if (bid == 1 % GRD) { float* RT = (float*)(wsp + W::ROPE); const int pos = tid >> 3, i = tid & 7; const float inv = exp2f(-(float)i * 0.125f * 13.287712379549449f); float sn_, cs_; sincosf((float)pos * inv, &sn_, &cs_); RT[pos * 16 + i] = cs_; RT[pos * 16 + 8 + i] = sn_; }
          if (bid == 0) { float* LAMV = (float*)(wsp + W::LAMV); const int l = tid >> 7, wq = (tid >> 5) & 3, j = tid & 31; const float* s0 = karg_in(21); const float* s1 = karg_in(22); const float* s2 = karg_in(23); const float* s3 = karg_in(24); const float* src = wq == 0 ? s0 : (wq == 1 ? s1 : (wq == 2 ? s2 : s3)); LAMV[tid] = src[l * 32 + j]; }
          __syncthreads(); }
    PHASE_END
    PHASE_BEGIN
        { const float* MODP = (const float*)(wsp + W::MODP);
          for (int i = bid * NTHR + tid; i < 4 * 9 * 6144; i += GRD * NTHR) { const int n = i % 6144, l = i / (9 * 6144); float s = karg_in(5)[l * 6144 + n];
#pragma unroll
              for (int ks = 0; ks < 8; ++ks) s += MODP[(size_t)ks * 4 * 9 * 6144 + i];
              MOD[i] = s; } }
    PHASE_END
    PHASE_BEGIN
        for (int r = gw; r < T; r += NGW) { const float* xr = r < TL ? karg_in(0) + (size_t)r * D : karg_in(2) + (size_t)(r - TL) * D; const float* md = MOD + (size_t)modrow(r) * 6144;
#if GQ
            float hq[16]; float am = 0.f;
#pragma unroll
            for (int j = 0; j < 4; ++j) { const int c = j * 256 + lane * 4; const float4 x4 = *(const float4*)(xr + c), sc = *(const float4*)(md + D + c), sh = *(const float4*)(md + c);
                hq[j * 4] = x4.x * (1.f + sc.x) + sh.x; hq[j * 4 + 1] = x4.y * (1.f + sc.y) + sh.y; hq[j * 4 + 2] = x4.z * (1.f + sc.z) + sh.z; hq[j * 4 + 3] = x4.w * (1.f + sc.w) + sh.w;
                am = fmaxf(fmaxf(am, fmaxf(fabsf(hq[j * 4]), fabsf(hq[j * 4 + 1]))), fmaxf(fabsf(hq[j * 4 + 2]), fabsf(hq[j * 4 + 3]))); }
#pragma unroll
            for (int o = 32; o >= 1; o >>= 1) am = fmaxf(am, shx(am, o, lane));
            const float qs = 127.f / fmaxf(am, 1e-30f);
            if (lane == 0) ((float*)(wsp + W::HSM))[r] = am * (1.f / 127.f);
#pragma unroll
            for (int j = 0; j < 4; ++j) *(unsigned*)((signed char*)(wsp + (GLATE ? W::H8M : W::H)) + (size_t)r * D + j * 256 + lane * 4) = pk4_i8(hq[j * 4] * qs, hq[j * 4 + 1] * qs, hq[j * 4 + 2] * qs, hq[j * 4 + 3] * qs);
            continue;
#endif
#pragma unroll
            for (int j = 0; j < 4; ++j) { const int c = j * 256 + lane * 4; const float4 x4 = *(const float4*)(xr + c), sc = *(const float4*)(md + D + c), sh = *(const float4*)(md + c);
                const float h0 = x4.x * (1.f + sc.x) + sh.x, h1 = x4.y * (1.f + sc.y) + sh.y, h2 = x4.z * (1.f + sc.z) + sh.z, h3 = x4.w * (1.f + sc.w) + sh.w;
                u32x2 w; w.x = pk2(h0, h1); w.y = pk2(h2, h3); *(u32x2*)(Hb + (size_t)r * D + c) = w;
                if (GATE8) *(unsigned*)((unsigned char*)(wsp + W::H8M) + (size_t)r * D + c) = pg8::pk4_fp8(h0 * pg8::S8_H, h1 * pg8::S8_H, h2 * pg8::S8_H, h3 * pg8::S8_H); } }
    PHASE_END

    FwdCtx cx{ws, A.out, lo, hi};
    layer_body<0>(cx, lds, bar, pc); layer_body<1>(cx, lds, bar, pc); layer_body<2>(cx, lds, bar, pc); layer_body<3>(cx, lds, bar, pc);
}
#undef PHASE_BEGIN L_PTRS
#undef PHASE_END
#undef QPOP2
#undef L_PTRS
#undef MK_SA
#undef MK_PA
#undef MK_L2
constexpr int NPHASES = 3 + 4 * 9 + 2 * 3 + 2 * 4 + 4 * (DUP_L4 - 1) + 4 * (DUP_L1 - 1) + 4 * (DUP_L6 - 1) + 4 * (DUP_L3 - 1) + 4 * (DUP_L2 - 1) + 4 * 2 * (DUP_FFN - 1);

template <int MODE> static void sgemm(hipStream_t st, const SG& p, int Mgrid) {
    dim3 grid((p.N + 127) / 128, (Mgrid + 127) / 128);
    hipLaunchKernelGGL((k_sgemm<MODE>), grid, dim3(256), 0, st, p);
}

#ifndef FUSED
#define FUSED 1
#endif
#if FUSED
extern "C" void kernel_launch(void* const* d_in, const int* in_sizes, int n_in, void* d_out, int out_size, void* d_ws, size_t ws_size, hipStream_t stream) {
    if (n_in != 41 || ws_size < W::END || out_size != TL * D) { fprintf(stderr, "kernel_launch: bad args n_in %d ws %zu out %d\n", n_in, ws_size, out_size); return; }
    static int grid = 0;
    if (!grid) {
        int dev = 0, cus = 0, per_cu = 0;
        if (hipGetDevice(&dev) != hipSuccess || hipDeviceGetAttribute(&cus, hipDeviceAttributeMultiprocessorCount, dev) != hipSuccess) { fprintf(stderr, "kernel_launch: device query failed\n"); return; }
        if (hipFuncSetAttribute((const void*)fwd, hipFuncAttributeMaxDynamicSharedMemorySize, LDS_BYTES) != hipSuccess) { fprintf(stderr, "kernel_launch: hipFuncSetAttribute failed\n"); return; }
        if (hipOccupancyMaxActiveBlocksPerMultiprocessor(&per_cu, fwd, NTHR, LDS_BYTES) != hipSuccess || per_cu < 1) { fprintf(stderr, "kernel_launch: occupancy query says %d\n", per_cu); return; }
        grid = cus;
    }
    if (hipMemsetAsync((char*)d_ws + W::CTL, 0, W::CTL_ZERO, stream) != hipSuccess) { fprintf(stderr, "kernel_launch: memset failed\n"); return; }
    FwdArgs a{};
    for (int i = 0; i < 41; ++i) a.in[i] = (const float*)d_in[i];
    a.ws = (unsigned char*)d_ws; a.out = (float*)d_out;
#if FUSED == 1
    a.lo = 0; a.hi = NPHASES;
    hipLaunchKernelGGL(fwd, dim3(grid), dim3(NTHR), LDS_BYTES, stream, a);
#else
    for (int p = 0; p < NPHASES; ++p) { a.lo = p; a.hi = p + 1; hipLaunchKernelGGL(fwd, dim3(grid), dim3(NTHR), LDS_BYTES, stream, a); }
#endif
}
#else
extern "C" void kernel_launch(void* const* d_in, const int* in_sizes, int n_in, void* d_out, int out_size, void* d_ws, size_t ws_size, hipStream_t stream) {
    if (n_in != 41 || ws_size < WS_END) { fprintf(stderr, "kernel_launch: bad args n_in %d ws %zu\n", n_in, ws_size); return; }
    const float* const* in = (const float* const*)d_in;
    char* ws = (char*)d_ws;
    float* COND = (float*)(ws + WS_COND); float* MOD = (float*)(ws + WS_MOD); int* CNT = (int*)(ws + WS_CNT); int* LTOK = (int*)(ws + WS_LTOK); float* LGATE = (float*)(ws + WS_LGATE);
    float* X = (float*)(ws + WS_X); float* O = (float*)(ws + WS_O); float* MG = (float*)(ws + WS_MG); float* TG = (float*)(ws + WS_TG); float* E = (float*)(ws + WS_E);
    float* Y5 = (float*)(ws + WS_Y5); float* Z = (float*)(ws + WS_Z); float* ACT = Z;
    bf16_t* Hb = (bf16_t*)(ws + WS_H); bf16_t* W13 = (bf16_t*)(ws + WS_W13); bf16_t* W2T = (bf16_t*)(ws + WS_W2T); bf16_t* ACTb = (bf16_t*)(ws + WS_Z); bf16_t* Fb = (bf16_t*)(ws + WS_TG);
    int* PLAN = (int*)(ws + WS_CNT); int* TSLOT = (int*)(ws + WS_COND + 64 * 1024); float* TGATE = (float*)(ws + WS_COND + 512 * 1024);
    bf16_t* ACTE = (bf16_t*)(ws + 144 * MiB); bf16_t* HG = (bf16_t*)(ws + 636 * MiB); bf16_t* W13E = (bf16_t*)(ws + 778 * MiB); bf16_t* W2TE = (bf16_t*)(ws + 890 * MiB);
    bf16_t* ZB = (bf16_t*)(ws + 280 * MiB); bf16_t* MB = (bf16_t*)(ws + 280 * MiB); bf16_t* YB = (bf16_t*)(ws + 348 * MiB); bf16_t* OB = (bf16_t*)(ws + 144 * MiB); bf16_t* GB = (bf16_t*)(ws + WS_Z);
    bf16_t* WING = (bf16_t*)(ws + 1088 * MiB); bf16_t* WBR = (bf16_t*)(ws + 1101 * MiB); bf16_t* WOUT = (bf16_t*)(ws + 1103 * MiB);
    bf16_t* EB = (bf16_t*)(ws + 552 * MiB); bf16_t* QM = (bf16_t*)(ws + 620 * MiB); bf16_t* KM = (bf16_t*)(ws + 620 * MiB + (size_t)4 * T * 96 * 2);
    bf16_t* VTN = (bf16_t*)(ws + 484 * MiB); bf16_t* VTM = (bf16_t*)(ws + 501 * MiB); bf16_t* VTD = (bf16_t*)(ws + 518 * MiB); bf16_t* QD = (bf16_t*)(ws + 535 * MiB); bf16_t* KD = (bf16_t*)(ws + 1105 * MiB);
    bf16_t* WEXP = (bf16_t*)(ws + 6 * MiB); bf16_t* WGLU = (bf16_t*)(ws + 7 * MiB); float* LAMV = (float*)(ws + WS_COND + 40 * 1024);
    float4* S5A = (float4*)(ws + 7 * MiB + 256 * 1024); bf16_t* S5B = (bf16_t*)(ws + 7 * MiB + 512 * 1024); bf16_t* S5C = (bf16_t*)(ws + 7 * MiB + 768 * 1024);
    bf16_t* Y5B = (bf16_t*)(ws + 671 * MiB); float2* S5S = (float2*)(ws + 688 * MiB);
    static int grid = 0;
    if (!grid) {
        int dev = 0, cus = 0; hipGetDevice(&dev); hipDeviceGetAttribute(&cus, hipDeviceAttributeMultiprocessorCount, dev);
        hipFuncSetAttribute((const void*)k_conv_ffn, hipFuncAttributeMaxDynamicSharedMemorySize, LDS_BYTES);
        hipFuncSetAttribute((const void*)k_conv_mix, hipFuncAttributeMaxDynamicSharedMemorySize, LDS_BYTES);
        hipFuncSetAttribute((const void*)k_conv_exp, hipFuncAttributeMaxDynamicSharedMemorySize, LDS_BYTES);
        hipFuncSetAttribute((const void*)k_prep, hipFuncAttributeMaxDynamicSharedMemorySize, LDS_BYTES);
        hipFuncSetAttribute((const void*)k_na2, hipFuncAttributeMaxDynamicSharedMemorySize, LDS_BYTES);
        hipFuncSetAttribute((const void*)k_s5_pass1, hipFuncAttributeMaxDynamicSharedMemorySize, LDS_BYTES);
        hipFuncSetAttribute((const void*)k_s5_pass2, hipFuncAttributeMaxDynamicSharedMemorySize, LDS_BYTES);
        hipFuncSetAttribute((const void*)k_gemm<pg8::EpiPair<true>>, hipFuncAttributeMaxDynamicSharedMemorySize, LDS_BYTES);
        hipFuncSetAttribute((const void*)k_attn<1>, hipFuncAttributeMaxDynamicSharedMemorySize, LDS_BYTES);
        hipFuncSetAttribute((const void*)k_attn<2>, hipFuncAttributeMaxDynamicSharedMemorySize, LDS_BYTES);
        hipFuncSetAttribute((const void*)k_gemm_gate, hipFuncAttributeMaxDynamicSharedMemorySize, LDS_BYTES);
        hipFuncSetAttribute((const void*)k_gemm_merge, hipFuncAttributeMaxDynamicSharedMemorySize, LDS_BYTES);
        hipFuncSetAttribute((const void*)k_conv_moe, hipFuncAttributeMaxDynamicSharedMemorySize, LDS_BYTES);
        hipFuncSetAttribute((const void*)k_gemm_moe<pg8::EpiPair<false>>, hipFuncAttributeMaxDynamicSharedMemorySize, LDS_BYTES);
        hipFuncSetAttribute((const void*)k_gemm_moe<pg8::EpiStore>, hipFuncAttributeMaxDynamicSharedMemorySize, LDS_BYTES);
        hipFuncSetAttribute((const void*)k_gemm<pg8::EpiPair<false>>, hipFuncAttributeMaxDynamicSharedMemorySize, LDS_BYTES);
        hipFuncSetAttribute((const void*)k_gemm<pg8::EpiStore>, hipFuncAttributeMaxDynamicSharedMemorySize, LDS_BYTES);
        grid = cus > 0 ? cus : 256;
    }
    unsigned long long* CHKT = (unsigned long long*)(ws + WS_CNT + 65536);
    hipMemsetAsync(CHKT, 0, 2048, stream);
#define CHK(id, ptr, bytes) do { if (SELFCHECK) hipLaunchKernelGGL(k_chk, dim3(1024), dim3(256), 0, stream, (const unsigned*)(ptr), (size_t)(bytes) / 4, CHKT + run * 64 + (id)); } while (0)
#ifndef SELFCHECK
#define SELFCHECK 0
#endif
    for (int run = 0; run < (SELFCHECK ? 2 : 1); ++run) {
    hipLaunchKernelGGL(k_cond, dim3(36), dim3(256), 0, stream, in[1], in[3], COND);
    hipLaunchKernelGGL(k_lamv, dim3(1), dim3(512), 0, stream, in[21], in[22], in[23], in[24], LAMV);
    hipLaunchKernelGGL(k_mod, dim3(24, 4), dim3(256), 0, stream, COND, in[4], in[5], MOD);
    hipLaunchKernelGGL(k_copy_in, dim3((unsigned)((size_t)T * D / 4 / 256)), dim3(256), 0, stream, in[0], in[2], X);
    for (int l = 0; l < DEPTH; ++l) {
        const float* MODl = MOD + (size_t)l * 9 * 6144;
        const float lam_init = 0.8f - 0.6f * expf(-0.3f * (float)l);
        SG p{};
        ConvMix cx{in[6] + (size_t)l * D * INC, in[27] + (size_t)l * D * 4 * D, in[26] + (size_t)l * 4 * 256 * D, in[29] + (size_t)l * D * D, WING, WBR, WOUT};
        hipLaunchKernelGGL(k_conv_mix, dim3(grid), dim3(NTHR), LDS_BYTES, stream, cx);
        { ConvExp ce{in[10] + (size_t)l * 256 * 384, in[11] + (size_t)l * 128 * 512, in[8] + l * 256, in[9] + l * 128, in[20] + (size_t)l * 256 * 512, WEXP, WGLU};
          hipLaunchKernelGGL(k_conv_exp, dim3(grid), dim3(NTHR), LDS_BYTES, stream, ce); }
        { S5Prep sp{in[12] + (size_t)l * 2048, in[13] + (size_t)l * 2048, in[14] + l * 32, in[15] + (size_t)l * 32768, in[16] + (size_t)l * 32768, in[17] + (size_t)l * 32768, in[18] + (size_t)l * 32768, S5A, S5B, S5C};
          hipLaunchKernelGGL(k_s5prep, dim3(8), dim3(256), 0, stream, sp); }
        CHK(l * 16 + 2, S5A, (size_t)32768); CHK(l * 16 + 3, S5B, (size_t)131072); CHK(l * 16 + 4, S5C, (size_t)131072);
        if (l == 0) hipLaunchKernelGGL(k_modh, dim3(T * D / 4 / 256), dim3(256), 0, stream, X, MODl, 0, D, Hb);
        { GemmArgs ga{Hb, WING, ZB, T / 256, ZC / 256, D, D, D, ZC, 0, 0};
          hipLaunchKernelGGL(k_gemm<pg8::EpiStore>, dim3(grid), dim3(NTHR), LDS_BYTES, stream, ga); }
        CHK(l * 16 + 0, Hb, (size_t)T * D * 2); CHK(l * 16 + 1, ZB, (size_t)T * ZC * 2);
        { GemmArgs ga{ZB + O_MQ, WEXP, EB, T / 256, 4, 384, ZC, 384, D, 0, 0};
          hipLaunchKernelGGL(k_gemm<pg8::EpiStore>, dim3(grid), dim3(NTHR), LDS_BYTES, stream, ga); }
        { PrepArgs pa{ZB, EB, QM, KM, QD, KD, VTN, VTM, VTD};
          hipLaunchKernelGGL(k_prep, dim3(grid), dim3(NTHR), LDS_BYTES, stream, pa); }
        CHK(l * 16 + 5, EB, (size_t)T * D * 2); CHK(l * 16 + 5, QM, (size_t)8 * T * 96 * 2); CHK(l * 16 + 5, VTN, (size_t)51 * MiB); CHK(l * 16 + 5, QD, (size_t)17 * MiB); CHK(l * 16 + 5, KD, (size_t)17 * MiB);
        { S5Args sa{ZB, S5A, S5B, S5C, in[19] + l * 256, S5S, Y5B, SELFCHECK ? CHKT + run * 64 + l * 16 + 5 : (unsigned long long*)nullptr};
          CHK(l * 16 + 5, ZB, (size_t)T * ZC * 2); CHK(l * 16 + 5, S5A, (size_t)32768); CHK(l * 16 + 5, S5B, (size_t)131072);
          hipLaunchKernelGGL(k_s5_pass1, dim3(grid), dim3(NTHR), LDS_BYTES, stream, sa);
          CHK(l * 16 + 6, S5S, (size_t)NB * 2 * NCHK * 16 * 64 * 8);
          hipLaunchKernelGGL(k_s5_pass2, dim3(grid), dim3(NTHR), LDS_BYTES, stream, sa); }
        CHK(l * 16 + 7, Y5B, (size_t)17 * MiB);
        { NaArgs na{ZB, VTN, OB, in[7] + (size_t)l * 4 * 15 * 31};
          hipLaunchKernelGGL(k_na2, dim3(grid), dim3(NTHR), LDS_BYTES, stream, na); }
        { AttnArgs aa{QM, KM, VTM, OB, nullptr, nullptr, lam_init, 0};
          hipLaunchKernelGGL(k_attn<1>, dim3(grid), dim3(NTHR), LDS_BYTES, stream, aa); }
        { AttnArgs aa{QD, KD, VTD, OB, LAMV + l * 128, in[25] + l * 64, lam_init, 0};
          hipLaunchKernelGGL(k_attn<2>, dim3(grid), dim3(NTHR), LDS_BYTES, stream, aa); }
        { GemmArgs ga{Y5B, WGLU, OB, T / 256, 2, 256, 256, 256, D, 512, 0};
          hipLaunchKernelGGL(k_gemm<pg8::EpiPair<true>>, dim3(grid), dim3(NTHR), LDS_BYTES, stream, ga); }
        CHK(l * 16 + 9, OB, (size_t)T * D * 2);
        { Gemm2Args ga{Hb, WING + (size_t)ZC * D, GB, in[28] + (size_t)l * 4 * D, nullptr, T / 256, 4 * D / 256, D, D, D, 4 * D};
          hipLaunchKernelGGL(k_gemm_gate, dim3(grid), dim3(NTHR), LDS_BYTES, stream, ga); }
        CHK(l * 16 + 10, GB, (size_t)T * 4 * D * 2);
        { Gemm2Args ga{OB, WBR, MB, nullptr, GB, T / 256, 4, 256, D, 256, D};
          hipLaunchKernelGGL(k_gemm_merge, dim3(grid), dim3(NTHR), LDS_BYTES, stream, ga); }
        CHK(l * 16 + 11, MB, (size_t)T * D * 2);
        { GemmArgs ga{MB, WOUT, YB, T / 256, D / 256, D, D, D, D, 0, 0};
          hipLaunchKernelGGL(k_gemm<pg8::EpiStore>, dim3(grid), dim3(NTHR), LDS_BYTES, stream, ga); }
        CHK(l * 16 + 12, YB, (size_t)T * D * 2);
        hipLaunchKernelGGL(k_lnh<true>, dim3(T / 4), dim3(256), 0, stream, X, (const void*)YB, MODl, 2 * D, in[30] + l * D, in[31] + l * D, (float*)nullptr, Hb, MODl, 3 * D, 4 * D);
        CHK(l * 16 + 13, X, (size_t)T * D * 4);
        const int j = l / 2;
        if ((l & 1) == 0) {
            ConvFfn cf{in[34] + (size_t)j * D * DFF, in[35] + (size_t)j * D * DFF, in[36] + (size_t)j * DFF * D, W13, W2T};
            hipLaunchKernelGGL(k_conv_ffn, dim3(grid), dim3(NTHR), LDS_BYTES, stream, cf);
            GemmArgs g1{Hb, W13, ACTb, T / 256, 2 * DFF / 256, D, D, D, DFF, 0, 0};
            hipLaunchKernelGGL(k_gemm<pg8::EpiPair<false>>, dim3(grid), dim3(NTHR), LDS_BYTES, stream, g1);
            GemmArgs g2{ACTb, W2T, Fb, T / 256, D / 256, DFF, DFF, DFF, D, 0, 0};
            hipLaunchKernelGGL(k_gemm<pg8::EpiStore>, dim3(grid), dim3(NTHR), LDS_BYTES, stream, g2);
        } else {
            hipMemsetAsync(PLAN, 0, 4096, stream);
            ConvMoe cm{in[38] + (size_t)j * NE * D * DFF, in[39] + (size_t)j * NE * D * DFF, in[40] + (size_t)j * NE * DFF * D, W13E, W2TE};
            hipLaunchKernelGGL(k_conv_moe, dim3(grid), dim3(NTHR), LDS_BYTES, stream, cm);
            hipLaunchKernelGGL(k_route2, dim3(T / 4), dim3(256), 0, stream, X, MODl, in[37] + (size_t)j * D * 8, PLAN, LTOK, TSLOT, TGATE);
            hipLaunchKernelGGL(k_moe_plan, dim3(1), dim3(64), 0, stream, PLAN);
            hipLaunchKernelGGL(k_gather, dim3(MAXTILES * 256 / 4), dim3(256), 0, stream, Hb, HG, PLAN, LTOK);
            MoeGemmArgs m1{HG, W13E, ACTE, PLAN, 2 * DFF / 256, D, D, D, DFF, 0, (size_t)2 * DFF * D};
            hipLaunchKernelGGL(k_gemm_moe<pg8::EpiPair<false>>, dim3(grid), dim3(NTHR), LDS_BYTES, stream, m1);
            MoeGemmArgs m2{ACTE, W2TE, HG, PLAN, D / 256, DFF, DFF, DFF, D, 0, (size_t)D * DFF};
            hipLaunchKernelGGL(k_gemm_moe<pg8::EpiStore>, dim3(grid), dim3(NTHR), LDS_BYTES, stream, m2);
        }
        if ((l & 1) == 0) hipLaunchKernelGGL(k_lnh<true>, dim3(T / 4), dim3(256), 0, stream, X, (const void*)Fb, MODl, 5 * D, in[32] + l * D, in[33] + l * D, l == DEPTH - 1 ? (float*)d_out : (float*)nullptr, l == DEPTH - 1 ? (bf16_t*)nullptr : Hb, MODl + 9 * 6144, 0, D);
        else hipLaunchKernelGGL(k_ln_moe, dim3(T / 4), dim3(256), 0, stream, X, HG, PLAN, TSLOT, TGATE, MODl, 5 * D, in[32] + l * D, in[33] + l * D, l == DEPTH - 1 ? (float*)d_out : (float*)nullptr, l == DEPTH - 1 ? (bf16_t*)nullptr : Hb, MODl + 9 * 6144);
        CHK(l * 16 + 14, X, (size_t)T * D * 4);
    }
    }
    if (SELFCHECK) hipLaunchKernelGGL(k_chk_final, dim3(1024), dim3(256), 0, stream, CHKT, 64, (float*)d_out, (size_t)TL * D);
}
#endif
```

```cpp
#include <hip/hip_runtime.h>
#include <cstdint>
#include <cstdio>
#include <type_traits>
#ifndef XBF
#define XBF 1
#endif
#ifndef G8
#define G8 1
#endif

constexpr int D = 1024, NB = 8, SQ = 4096, CL = 256, DEPTH = 4;
constexpr int TL = NB * SQ, TC = NB * CL, T = TL + TC;
constexpr int INC = 2208, EC = 896, DFF = 3584, NE = 8;
constexpr int O_NAQ = 0, O_NAK = 256, O_NAV = 512, O_MQ = 768, O_MKV = 1024, O_MKR = 1152, O_S5 = 1184, O_DQ = 1440, O_DK = 1696, O_DV = 1952;
constexpr float ALPHA = 1.681792830507429f;
constexpr size_t MiB = 1u << 20;
constexpr size_t WS_COND = 0, WS_MOD = 1 * MiB, WS_CNT = 3 * MiB, WS_LTOK = 4 * MiB, WS_LGATE = 6 * MiB, WS_X = 8 * MiB, WS_O = 144 * MiB, WS_MG = 280 * MiB,
                 WS_TG = 416 * MiB, WS_E = 552 * MiB, WS_Y5 = 671 * MiB, WS_Z = 705 * MiB, WS_H = 999 * MiB, WS_W13 = 1067 * MiB, WS_W2T = 1081 * MiB, WS_END = 1122 * MiB;
constexpr int CH = 8704;
#ifndef MERGE_NAIVE
#define MERGE_NAIVE 0
#endif

__device__ __forceinline__ int modrow(int r) { return r < TL ? (r >> 12) : 8; }
__device__ __forceinline__ float sigm(float v) { return 1.f / (1.f + expf(-v)); }

__global__ void k_lamv(const float* q1, const float* k1, const float* q2, const float* k2, float* LAMV) {
    const int i = threadIdx.x, l = i >> 7, w = (i >> 5) & 3, j = i & 31; const float* src = w == 0 ? q1 : (w == 1 ? k1 : (w == 2 ? q2 : k2)); LAMV[i] = src[l * 32 + j];
}
__global__ void k_cond(const float* c, const float* c_ctx, float* COND) {
    int i = blockIdx.x * 256 + threadIdx.x;
    if (i >= 9 * D) return;
    float v = i < 8 * D ? c[i] : c_ctx[i - 8 * D];
    COND[i] = v * sigm(v);
}
__global__ void k_mod(const float* COND, const float* w_ada, const float* b_ada, float* MOD) {
    int n = blockIdx.x * 256 + threadIdx.x, l = blockIdx.y;
    float acc[9];
#pragma unroll
    for (int r = 0; r < 9; ++r) acc[r] = 0.f;
    const float* w = w_ada + (size_t)l * D * 6144 + n;
    for (int k = 0; k < D; ++k) { float wv = w[(size_t)k * 6144];
#pragma unroll
        for (int r = 0; r < 9; ++r) acc[r] += COND[r * D + k] * wv; }
    float bb = b_ada[l * 6144 + n];
#pragma unroll
    for (int r = 0; r < 9; ++r) MOD[((size_t)l * 9 + r) * 6144 + n] = acc[r] + bb;
}
__global__ void k_copy_in(const float* x, const float* ctx, float* X) {
    size_t i = (size_t)blockIdx.x * 256 + threadIdx.x;
    const size_t nl = (size_t)TL * D / 4, nt = (size_t)T * D / 4;
    if (i >= nt) return;
    ((float4*)X)[i] = i < nl ? ((const float4*)x)[i] : ((const float4*)ctx)[i - nl];
}

struct SG { const float* A; const float* B; float* C; const float* bias; const float* aux; const float* mod; const int* gather; const int* cnt; const float* gatew; const int* scat;
            int lda, ldb, ldc, ldaux, M, N, K, sh_off, sc_off, row0, arow0, first; };
template <int MODE> __global__ __launch_bounds__(256) void k_sgemm(SG p) {
    __shared__ float As[8][132];
    __shared__ float Bs[8][132];
    int Mlim = p.M;
    if (p.cnt) { int c = *p.cnt - p.row0; Mlim = c < Mlim ? c : Mlim; }
    const int bm = blockIdx.y * 128, bn = blockIdx.x * 128;
    if (bm >= Mlim) return;
    const int tid = threadIdx.x, ty = tid >> 4, tx = tid & 15;
    float acc[8][8];
#pragma unroll
    for (int i = 0; i < 8; ++i)
#pragma unroll
        for (int j = 0; j < 8; ++j) acc[i][j] = 0.f;
    const int ar = tid >> 1, ak = (tid & 1) * 4;
    int arow = bm + ar; const bool avalid = arow < Mlim;
    int asrc = 0; if (avalid) asrc = p.gather ? p.gather[p.arow0 + arow] : p.arow0 + arow;
    const float* ap = p.A + (size_t)asrc * p.lda + ak;
    const float* modp = nullptr; if (p.mod) modp = p.mod + (size_t)modrow(asrc) * 6144;
    const int bk = tid >> 5, bnn = (tid & 31) * 4;
    const bool bvalid = (bn + bnn) < p.N;
    const float* bp = p.B + (size_t)bk * p.ldb + bn + bnn;
    for (int k0 = 0; k0 < p.K; k0 += 8) {
        float4 av = make_float4(0.f, 0.f, 0.f, 0.f), bv = make_float4(0.f, 0.f, 0.f, 0.f);
        if (avalid) { av = *(const float4*)(ap + k0);
            if (modp) { const float4 sc = *(const float4*)(modp + p.sc_off + k0 + ak), sh = *(const float4*)(modp + p.sh_off + k0 + ak);
                av.x = av.x * (1.f + sc.x) + sh.x; av.y = av.y * (1.f + sc.y) + sh.y; av.z = av.z * (1.f + sc.z) + sh.z; av.w = av.w * (1.f + sc.w) + sh.w; } }
        if (bvalid) bv = *(const float4*)(bp + (size_t)k0 * p.ldb);
        __syncthreads();
        As[ak + 0][ar] = av.x; As[ak + 1][ar] = av.y; As[ak + 2][ar] = av.z; As[ak + 3][ar] = av.w;
        *(float4*)&Bs[bk][bnn] = bv;
        __syncthreads();
#pragma unroll
        for (int k = 0; k < 8; ++k) {
            float a[8], b[8];
            *(float4*)&a[0] = *(const float4*)&As[k][ty * 8]; *(float4*)&a[4] = *(const float4*)&As[k][ty * 8 + 4];
            *(float4*)&b[0] = *(const float4*)&Bs[k][tx * 8]; *(float4*)&b[4] = *(const float4*)&Bs[k][tx * 8 + 4];
#pragma unroll
            for (int i = 0; i < 8; ++i)
#pragma unroll
                for (int j = 0; j < 8; ++j) acc[i][j] += a[i] * b[j];
        }
    }
#pragma unroll
    for (int i = 0; i < 8; ++i) {
        const int r = bm + ty * 8 + i; if (r >= Mlim) continue;
        int tok = 0; float gw = 0.f;
        if (MODE == 5) { tok = p.scat[p.row0 + r]; gw = p.gatew[p.row0 + r]; }
#pragma unroll
        for (int j = 0; j < 8; ++j) {
            const int c = bn + tx * 8 + j; if (c >= p.N) continue;
            float v = acc[i][j];
            float* cp = p.C + (size_t)r * p.ldc + c;
            if (MODE == 0) { if (p.bias) v += p.bias[c]; *cp = v; }
            if (MODE == 1) { *cp = sigm(v + p.bias[c]); }
            if (MODE == 2) { float o = p.first ? 0.f : *cp; *cp = o + p.aux[(size_t)r * p.ldaux + c] * v; }
            if (MODE == 3) { *cp = v * sigm(v); }
            if (MODE == 4) { *cp = *cp * v; }
            if (MODE == 5) { float* fp = p.C + (size_t)tok * p.ldc + c; *fp = *fp + gw * v; }
        }
    }
}

__global__ __launch_bounds__(256) void k_rms(float* Z, const float* gq, const float* gkv) {
    const int r = blockIdx.x * 4 + (threadIdx.x >> 6), lane = threadIdx.x & 63;
    float* z = Z + (size_t)r * INC;
    float4 q = *(float4*)(z + O_MQ + lane * 4); float2 kv = *(float2*)(z + O_MKV + lane * 2);
    float sq = q.x * q.x + q.y * q.y + q.z * q.z + q.w * q.w, sk = kv.x * kv.x + kv.y * kv.y;
#pragma unroll
    for (int o = 1; o < 64; o <<= 1) { sq += __shfl_xor(sq, o); sk += __shfl_xor(sk, o); }
    const float rq = rsqrtf(sq / 256.f + 1e-6f), rk = rsqrtf(sk / 128.f + 1e-6f);
    const float4 g4 = *(const float4*)(gq + lane * 4); const float2 g2 = *(const float2*)(gkv + lane * 2);
    q.x *= rq * g4.x; q.y *= rq * g4.y; q.z *= rq * g4.z; q.w *= rq * g4.w; kv.x *= rk * g2.x; kv.y *= rk * g2.y;
    *(float4*)(z + O_MQ + lane * 4) = q; *(float2*)(z + O_MKV + lane * 2) = kv;
}
__global__ __launch_bounds__(256) void k_rope(float* Z, float* E) {
    const int idx = blockIdx.x * 256 + threadIdx.x;
    if (idx >= TL * 21) return;
    const int r = idx / 21, v = idx % 21;
    float* z;
    if (v == 0) z = Z + (size_t)r * INC + O_MKR;
    else if (v < 9) z = Z + (size_t)r * INC + O_DQ + (v - 1) * 32;
    else if (v < 17) z = Z + (size_t)r * INC + O_DK + (v - 9) * 32;
    else z = E + (size_t)r * EC + (v - 17) * 96 + 64;
    const int t = r & (SQ - 1), prow = t >> 6, pcol = t & 63;
#pragma unroll
    for (int half = 0; half < 2; ++half) { const float pp = (float)(half ? pcol : prow);
#pragma unroll
        for (int i = 0; i < 8; ++i) { const float inv = exp2f(-(float)i * 0.125f * 13.287712379549449f); float sn, cs; sincosf(pp * inv, &sn, &cs);
            const float z1 = z[half * 16 + i], z2 = z[half * 16 + 8 + i];
            z[half * 16 + i] = z1 * cs - z2 * sn; z[half * 16 + 8 + i] = z1 * sn + z2 * cs; } }
}

#define ONLINE(m, l, acc, s, vp) do { const float mn_ = fmaxf(m, s); const float c_ = __expf(m - mn_), p_ = __expf(s - mn_); l = l * c_ + p_; m = mn_; \
    _Pragma("unroll") for (int d_ = 0; d_ < 64; d_ += 4) { const float4 v4_ = *(const float4*)((vp) + d_); acc[d_] = acc[d_] * c_ + p_ * v4_.x; acc[d_ + 1] = acc[d_ + 1] * c_ + p_ * v4_.y; \
        acc[d_ + 2] = acc[d_ + 2] * c_ + p_ * v4_.z; acc[d_ + 3] = acc[d_ + 3] * c_ + p_ * v4_.w; } } while (0)

__global__ __launch_bounds__(256) void k_mla(const float* __restrict__ E, const float* __restrict__ Z, float* __restrict__ O) {
    const int r = blockIdx.x * 256 + threadIdx.x, h = blockIdx.y;
    const bool isctx = r >= TL; const int b = isctx ? (r - TL) / CL : r / SQ;
    float q[96];
#pragma unroll
    for (int i = 0; i < 96; ++i) q[i] = E[(size_t)r * EC + h * 96 + i] * 0.10206207261596575f;
    float m = -1e30f, l = 0.f, acc[64];
#pragma unroll
    for (int i = 0; i < 64; ++i) acc[i] = 0.f;
    const int nk = isctx ? CL : SQ + CL;
    for (int j = 0; j < nk; ++j) {
        const int kr = isctx ? TL + b * CL + j : (j < SQ ? b * SQ + j : TL + b * CL + (j - SQ));
        const float* kn = E + (size_t)kr * EC + 384 + h * 128; const float* kp = Z + (size_t)kr * INC + O_MKR;
        float s = 0.f;
#pragma unroll
        for (int i = 0; i < 64; i += 4) { const float4 k4 = *(const float4*)(kn + i); s += q[i] * k4.x + q[i + 1] * k4.y + q[i + 2] * k4.z + q[i + 3] * k4.w; }
#pragma unroll
        for (int i = 0; i < 32; i += 4) { const float4 k4 = *(const float4*)(kp + i); s += q[64 + i] * k4.x + q[65 + i] * k4.y + q[66 + i] * k4.z + q[67 + i] * k4.w; }
        ONLINE(m, l, acc, s, kn + 64);
    }
    const float il = 1.f / l;
#pragma unroll
    for (int d = 0; d < 64; ++d) O[(size_t)r * D + 256 + h * 64 + d] = acc[d] * il;
}

__global__ __launch_bounds__(256) void k_diff(const float* __restrict__ Z, float* __restrict__ O, const float* lq1, const float* lk1, const float* lq2, const float* lk2, const float* subln, float lam_init) {
    const int r = blockIdx.x * 256 + threadIdx.x, h = blockIdx.y;
    const bool isctx = r >= TL; const int b = isctx ? (r - TL) / CL : r / SQ;
    float s1 = 0.f, s2 = 0.f;
    for (int i = 0; i < 32; ++i) { s1 += lq1[i] * lk1[i]; s2 += lq2[i] * lk2[i]; }
    const float lam = expf(s1) - expf(s2) + lam_init;
    float q1[32], q2[32];
#pragma unroll
    for (int i = 0; i < 32; ++i) { q1[i] = Z[(size_t)r * INC + O_DQ + h * 64 + i] * 0.17677669529663687f; q2[i] = Z[(size_t)r * INC + O_DQ + h * 64 + 32 + i] * 0.17677669529663687f; }
    float m1 = -1e30f, l1 = 0.f, m2 = -1e30f, l2 = 0.f, a1[64], a2[64];
#pragma unroll
    for (int i = 0; i < 64; ++i) { a1[i] = 0.f; a2[i] = 0.f; }
    const int nk = isctx ? CL : SQ + CL;
    for (int j = 0; j < nk; ++j) {
        const int kr = isctx ? TL + b * CL + j : (j < SQ ? b * SQ + j : TL + b * CL + (j - SQ));
        const float* k1 = Z + (size_t)kr * INC + O_DK + h * 64; const float* vp = Z + (size_t)kr * INC + O_DV + h * 64;
        float sa = 0.f, sb = 0.f;
#pragma unroll
        for (int i = 0; i < 32; i += 4) { const float4 ka = *(const float4*)(k1 + i), kb = *(const float4*)(k1 + 32 + i);
            sa += q1[i] * ka.x + q1[i + 1] * ka.y + q1[i + 2] * ka.z + q1[i + 3] * ka.w; sb += q2[i] * kb.x + q2[i + 1] * kb.y + q2[i + 2] * kb.z + q2[i + 3] * kb.w; }
        ONLINE(m1, l1, a1, sa, vp);
        ONLINE(m2, l2, a2, sb, vp);
    }
    const float i1 = 1.f / l1, i2 = lam / l2; float ss = 0.f;
#pragma unroll
    for (int d = 0; d < 64; ++d) { a1[d] = a1[d] * i1 - a2[d] * i2; ss += a1[d] * a1[d]; }
    const float rr = rsqrtf(ss / 64.f + 1e-6f) * (1.f - lam_init);
#pragma unroll
    for (int d = 0; d < 64; ++d) O[(size_t)r * D + 768 + h * 64 + d] = a1[d] * rr * subln[d];
}

__global__ __launch_bounds__(256) void k_na(const float* __restrict__ Z, float* __restrict__ O, const float* __restrict__ rpb) {
    const int r = blockIdx.x * 256 + threadIdx.x, h = blockIdx.y;
    const bool isctx = r >= TL; const int b = isctx ? (r - TL) / CL : r / SQ;
    float q[64];
#pragma unroll
    for (int i = 0; i < 64; ++i) q[i] = Z[(size_t)r * INC + O_NAQ + h * 64 + i] * 0.125f;
    float m = -1e30f, l = 0.f, acc[64];
#pragma unroll
    for (int i = 0; i < 64; ++i) acc[i] = 0.f;
    if (!isctx) {
        const int t = r & (SQ - 1), gr = t >> 6, gc = t & 63;
        const int r0 = min(max(gr - 4, 0), 56), cs = min(max(gc - 8, 0), 48);
        for (int i = 0; i < 8; ++i) for (int j = 0; j < 16; ++j) {
            const int kt = b * SQ + (r0 + i) * 64 + cs + j;
            const float* kp = Z + (size_t)kt * INC + O_NAK + h * 64; const float* vp = Z + (size_t)kt * INC + O_NAV + h * 64;
            float s = rpb[(h * 15 + (r0 + i - gr + 7)) * 31 + (cs + j - gc + 15)];
#pragma unroll
            for (int d = 0; d < 64; d += 4) { const float4 k4 = *(const float4*)(kp + d); s += q[d] * k4.x + q[d + 1] * k4.y + q[d + 2] * k4.z + q[d + 3] * k4.w; }
            ONLINE(m, l, acc, s, vp);
        }
    }
    for (int j = 0; j < CL; ++j) {
        const int kt = TL + b * CL + j;
        const float* kp = Z + (size_t)kt * INC + O_NAK + h * 64; const float* vp = Z + (size_t)kt * INC + O_NAV + h * 64;
        float s = 0.f;
#pragma unroll
        for (int d = 0; d < 64; d += 4) { const float4 k4 = *(const float4*)(kp + d); s += q[d] * k4.x + q[d + 1] * k4.y + q[d + 2] * k4.z + q[d + 3] * k4.w; }
        ONLINE(m, l, acc, s, vp);
    }
    const float il = 1.f / l;
#pragma unroll
    for (int d = 0; d < 64; ++d) O[(size_t)r * D + h * 64 + d] = acc[d] * il;
}

__global__ __launch_bounds__(64) void k_s5(int dir, const float* __restrict__ Z, float* Y5, const float* lam_re, const float* lam_im, const float* log_dt,
                                           const float* b_re, const float* b_im, const float* c_re, const float* c_im, const float* s5d) {
    const int b = blockIdx.x >> 4, g = blockIdx.x & 15, p = threadIdx.x;
    const int gi = dir * 16 + g;
    const double lre = lam_re[gi * 64 + p], lim = lam_im[gi * 64 + p], dt = exp((double)log_dt[gi]);
    const double er = exp(lre * dt); double ang = lim * dt; ang -= 6.283185307179586476925 * rint(ang / 6.283185307179586476925);
    float sn, cs; sincosf((float)ang, &sn, &cs);
    const double ar = er * cs, ai = er * sn;
    const double nr = ar - 1.0, ni = ai, den = lre * lre + lim * lim;
    const float fr = (float)((nr * lre + ni * lim) / den), fi = (float)((ni * lre - nr * lim) / den);
    float bbr[16], bbi[16], cr[16], ci[16], dsk[16];
#pragma unroll
    for (int c = 0; c < 16; ++c) { const float br = b_re[(gi * 64 + p) * 16 + c], bi = b_im[(gi * 64 + p) * 16 + c];
        bbr[c] = fr * br - fi * bi; bbi[c] = fr * bi + fi * br; cr[c] = c_re[(gi * 16 + c) * 64 + p]; ci[c] = c_im[(gi * 16 + c) * 64 + p]; dsk[c] = s5d[g * 16 + c]; }
    double hr = 0.0, hi = 0.0;
    for (int s = 0; s < SQ + CL; ++s) {
        int row;
        if (dir == 0) row = s < CL ? TL + b * CL + s : b * SQ + (s - CL);
        else row = s < CL ? TL + b * CL + (CL - 1 - s) : b * SQ + (SQ - 1 - (s - CL));
        const float* u = Z + (size_t)row * INC + O_S5 + g * 16;
        float uu[16];
#pragma unroll
        for (int c = 0; c < 16; c += 4) *(float4*)&uu[c] = *(const float4*)(u + c);
        float bur = 0.f, bui = 0.f;
#pragma unroll
        for (int c = 0; c < 16; ++c) { bur += bbr[c] * uu[c]; bui += bbi[c] * uu[c]; }
        const double nh = ar * hr - ai * hi + (double)bur; hi = ar * hi + ai * hr + (double)bui; hr = nh;
        const float hrf = (float)hr, hif = (float)hi;
        float v[16];
#pragma unroll
        for (int c = 0; c < 16; ++c) { v[c] = cr[c] * hrf - ci[c] * hif;
#pragma unroll
            for (int o = 1; o < 64; o <<= 1) v[c] += __shfl_xor(v[c], o); }
        if (p == 0) { float* y = Y5 + (size_t)row * 256 + g * 16;
#pragma unroll
            for (int c = 0; c < 16; ++c) y[c] = (dir == 0 ? dsk[c] * uu[c] : y[c]) + v[c]; }
    }
}
__global__ void k_glu(const float* G5, float* O) {
    const int i = blockIdx.x * 256 + threadIdx.x; const int r = i >> 8, c = i & 255;
    O[(size_t)r * D + 512 + c] = G5[(size_t)r * 512 + c] * sigm(G5[(size_t)r * 512 + 256 + c]);
}
__global__ __launch_bounds__(256) void k_ln(float* X, const float* Y, const float* MODl, int goff, const float* g, const float* bta, float* out) {
    const int r = blockIdx.x * 4 + (threadIdx.x >> 6), lane = threadIdx.x & 63;
    const float* md = MODl + (size_t)modrow(r) * 6144 + goff;
    float v[16]; float s = 0.f;
#pragma unroll
    for (int j = 0; j < 4; ++j) { const int c = j * 256 + lane * 4; const float4 x4 = *(const float4*)(X + (size_t)r * D + c), y4 = *(const float4*)(Y + (size_t)r * D + c), m4 = *(const float4*)(md + c);
        v[j * 4] = ALPHA * x4.x + m4.x * y4.x; v[j * 4 + 1] = ALPHA * x4.y + m4.y * y4.y; v[j * 4 + 2] = ALPHA * x4.z + m4.z * y4.z; v[j * 4 + 3] = ALPHA * x4.w + m4.w * y4.w;
        s += v[j * 4] + v[j * 4 + 1] + v[j * 4 + 2] + v[j * 4 + 3]; }
#pragma unroll
    for (int o = 1; o < 64; o <<= 1) s += __shfl_xor(s, o);
    const float mean = s / D; float q = 0.f;
#pragma unroll
    for (int j = 0; j < 16; ++j) { v[j] -= mean; q += v[j] * v[j]; }
#pragma unroll
    for (int o = 1; o < 64; o <<= 1) q += __shfl_xor(q, o);
    const float rstd = rsqrtf(q / D + 1e-5f);
#pragma unroll
    for (int j = 0; j < 4; ++j) { const int c = j * 256 + lane * 4; const float4 g4 = *(const float4*)(g + c), b4 = *(const float4*)(bta + c);
        float4 o4; o4.x = v[j * 4] * rstd * g4.x + b4.x; o4.y = v[j * 4 + 1] * rstd * g4.y + b4.y; o4.z = v[j * 4 + 2] * rstd * g4.z + b4.z; o4.w = v[j * 4 + 3] * rstd * g4.w + b4.w;
        *(float4*)(X + (size_t)r * D + c) = o4; if (out && r < TL) *(float4*)(out + (size_t)r * D + c) = o4; }
}
__global__ __launch_bounds__(256) void k_route(const float* X, const float* MODl, const float* wr, int* cnt, int* ltok, float* lgate) {
    const int r = blockIdx.x * 4 + (threadIdx.x >> 6), lane = threadIdx.x & 63;
    const float* md = MODl + (size_t)modrow(r) * 6144;
    float lg[8];
#pragma unroll
    for (int e = 0; e < 8; ++e) lg[e] = 0.f;
    for (int j = 0; j < 16; ++j) { const int k = j * 64 + lane; const float hv = X[(size_t)r * D + k] * (1.f + md[4 * D + k]) + md[3 * D + k];
        const float4 w0 = *(const float4*)(wr + k * 8), w1 = *(const float4*)(wr + k * 8 + 4);
        lg[0] += hv * w0.x; lg[1] += hv * w0.y; lg[2] += hv * w0.z; lg[3] += hv * w0.w; lg[4] += hv * w1.x; lg[5] += hv * w1.y; lg[6] += hv * w1.z; lg[7] += hv * w1.w; }
#pragma unroll
    for (int e = 0; e < 8; ++e)
#pragma unroll
        for (int o = 1; o < 64; o <<= 1) lg[e] += __shfl_xor(lg[e], o);
    if (lane == 0) {
        int e1 = 0; float v1 = lg[0];
#pragma unroll
        for (int e = 1; e < 8; ++e) if (lg[e] > v1) { v1 = lg[e]; e1 = e; }
        int e2 = -1; float v2 = -3e38f;
#pragma unroll
        for (int e = 0; e < 8; ++e) if (e != e1 && lg[e] > v2) { v2 = lg[e]; e2 = e; }
        const float p2 = expf(v2 - v1), g1 = 1.f / (1.f + p2), g2 = p2 / (1.f + p2);
        const int s1 = atomicAdd(cnt + e1, 1); ltok[e1 * T + s1] = r; lgate[e1 * T + s1] = g1;
        const int s2 = atomicAdd(cnt + e2, 1); ltok[e2 * T + s2] = r; lgate[e2 * T + s2] = g2;
    }
}


#define LAS __attribute__((address_space(3)))
__device__ __forceinline__ int otid() { int w = __builtin_amdgcn_readfirstlane((int)threadIdx.x); asm volatile("" : "+s"(w));
    int t = (w & ~63) + (int)__builtin_amdgcn_mbcnt_hi(~0u, __builtin_amdgcn_mbcnt_lo(~0u, 0u)); asm volatile("" : "+v"(t)); return t; }
typedef unsigned short bf16_t;
typedef short bf16x8 __attribute__((ext_vector_type(8)));
typedef float f32x4 __attribute__((ext_vector_type(4)));
typedef float f32x2 __attribute__((ext_vector_type(2)));
typedef unsigned u32x4 __attribute__((ext_vector_type(4)));
typedef unsigned u32x2 __attribute__((ext_vector_type(2)));
#ifndef LNPF
#define LNPF 1
#endif
#ifndef PFL2
#define PFL2 0
#endif
#ifdef KREP
#define KSC (1.f / KREP)
#else
#define KSC 1.f
#endif
namespace pg8 {
constexpr int BM = 256, BK = 64, HALF = 128, HTB = HALF * BK * 2, STAGE_BYTES = 8 * HTB, NXCD = 8, WGM = 4;
__host__ __device__ __forceinline__ int lds_byte(int r, int c) { const int st = (r >> 4) * 2 + (c >> 5), rr = r & 15, cc = c & 31, ob = rr * 64 + cc * 2; return st * 1024 + (ob ^ (((ob >> 9) & 1) << 5)); }
__host__ __device__ __forceinline__ void stage_rc(int b, int& R, int& C) { const int st = b / 1024, sb = b % 1024, swz = sb ^ (((sb >> 9) & 1) << 5); R = (st >> 1) * 16 + swz / 64; C = (st & 1) * 32 + (swz % 64) / 2; }
__host__ __device__ __forceinline__ int perm32(int rho) { const int n = rho >> 4, i = rho & 15; return 8 * (i >> 2) + 4 * n + (i & 3); }
typedef __bf16 bf16x2_t __attribute__((ext_vector_type(2)));
__device__ __forceinline__ unsigned cvt_pk_bf16(float lo, float hi) { const f32x2 v = {lo, hi}; return __builtin_bit_cast(unsigned, __builtin_convertvector(v, bf16x2_t)); }
typedef int v8i_t __attribute__((ext_vector_type(8)));
typedef int v4i_t __attribute__((ext_vector_type(4)));
__device__ __forceinline__ v8i_t cat8(bf16x8 lo, bf16x8 hi) { return __builtin_shufflevector(__builtin_bit_cast(v4i_t, lo), __builtin_bit_cast(v4i_t, hi), 0, 1, 2, 3, 4, 5, 6, 7); }
__device__ __forceinline__ float clamp8(float v) { return fminf(fmaxf(v, -448.f), 448.f); }
__device__ __forceinline__ unsigned pk4_fp8(float a, float b, float c, float d) { int w = 0; w = __builtin_amdgcn_cvt_pk_fp8_f32(clamp8(a), clamp8(b), w, false); w = __builtin_amdgcn_cvt_pk_fp8_f32(clamp8(c), clamp8(d), w, true); return (unsigned)w; }
constexpr float S8_H = 4.f, S8_W13 = 64.f, S8_ACT = 2.f, S8_W2 = 256.f;
struct Unit { const char* A; const char* B; int pm, pn, x0, x1; };
struct StaticOrder {
    int nM, nN, nwg, G, c; const char* A; const char* B; size_t tA, tB;
    __device__ void init(int nM_, int nN_, int G_, int c_, const void* A_, int lda, const void* B_, int ldb) { nM = nM_; nN = nN_; nwg = nM * nN; G = G_; c = c_; A = (const char*)A_; B = (const char*)B_; tA = (size_t)BM * lda * 2; tB = (size_t)BM * ldb * 2; }
    __device__ bool next(int i, Unit& u) const {
        const long L = (long)i * G + c; if (L >= nwg) return false;
        int wgid = (int)L; { const int q = nwg / NXCD, r = nwg % NXCD, xcd = wgid % NXCD, off = wgid / NXCD; wgid = (xcd < r ? xcd * (q + 1) : r * (q + 1) + (xcd - r) * q) + off; }
        const int nig = WGM * nN, gid = wgid / nig, fm = gid * WGM, gsz = (nM - fm) < WGM ? (nM - fm) : WGM;
        u.pm = fm + ((wgid % nig) % gsz); u.pn = (wgid % nig) / gsz; u.x0 = 0; u.x1 = 0;
        u.A = A + (size_t)u.pm * tA; u.B = B + (size_t)u.pn * tB; return true;
    }
};
template <class Epi, class Sched, bool F8 = false, bool I8 = false>
__device__ __forceinline__ void gemm_phase(LAS unsigned char* lds, const int K, const int lda, const int ldb, const Sched& S, const Epi& E) {
    const int tid = otid(), wid = __builtin_amdgcn_readfirstlane(tid >> 6), lane = tid & 63, wr = wid >> 2, wc = wid & 3, fr = lane & 15, fq = lane >> 4;
    const int nt = K / BK;
    constexpr bool PF = PFL2 && (I8 || F8);
    unsigned voffA[2], voffB[2];
#pragma unroll
    for (int i = 0; i < 2; ++i) { int R, C; stage_rc(tid * 16 + i * 8192, R, C); const int Rb = Epi::PERM ? ((R & ~31) + perm32(R & 31)) : R;
        voffA[i] = (unsigned)(R * lda + C) * 2u; voffB[i] = (unsigned)(Rb * ldb + C) * 2u; }
    const size_t kstep = (size_t)(BK * 2);
    const size_t hA = (size_t)HALF * lda * 2, hB = (size_t)HALF * ldb * 2;
    const unsigned ldsw = (unsigned)wid * 1024u;
    const int aoff = lds_byte(wr * 64 + fr, fq * 8), boff = lds_byte(wc * 32 + fr, fq * 8);
#define PG8_SA(b, h) (((b) * 2 + (h)) * HTB)
#define PG8_SB(b, h) ((4 + (b) * 2 + (h)) * HTB)
#define PG8_STAGE(bufoff, gbase, voff) do { _Pragma("unroll") for (int _i = 0; _i < 2; ++_i) \
        __builtin_amdgcn_global_load_lds((const unsigned*)((const char*)(gbase) + (voff)[_i]), (LAS unsigned*)(lds + (bufoff) + ldsw + _i * 8192), 16, 0, 0); } while (0)
#define PG8_LDA(dst, b, h) do { _Pragma("unroll") for (int m = 0; m < 4; ++m) { if constexpr (F8) dst##8[m] = cat8(*(const LAS bf16x8*)(lds + PG8_SA(b, h) + aoff + m * 2048), *(const LAS bf16x8*)(lds + PG8_SA(b, h) + aoff + m * 2048 + 1024)); \
        else { _Pragma("unroll") for (int k = 0; k < 2; ++k) dst[m][k] = *(const LAS bf16x8*)(lds + PG8_SA(b, h) + aoff + m * 2048 + k * 1024); } } } while (0)
#define PG8_LDB(dst, b, h) do { _Pragma("unroll") for (int n = 0; n < 2; ++n) { if constexpr (F8) dst##8[n] = cat8(*(const LAS bf16x8*)(lds + PG8_SB(b, h) + boff + n * 2048), *(const LAS bf16x8*)(lds + PG8_SB(b, h) + boff + n * 2048 + 1024)); \
        else { _Pragma("unroll") for (int k = 0; k < 2; ++k) dst[n][k] = *(const LAS bf16x8*)(lds + PG8_SB(b, h) + boff + n * 2048 + k * 1024); } } } while (0)
#define PG8_MMA(ai, bj, At, Bt) do { __builtin_amdgcn_s_setprio(1); _Pragma("unroll") for (int m = 0; m < 4; ++m) _Pragma("unroll") for (int n = 0; n < 2; ++n) { \
        if constexpr (F8) asm volatile("v_mfma_f32_16x16x128_f8f6f4 %0, %1, %2, %0" : "+v"(acc[ai][bj][m][n]) : "v"(Bt##8[n]), "v"(At##8[m]));   \
        else if constexpr (I8) { _Pragma("unroll") for (int k = 0; k < 2; ++k) acc[ai][bj][m][n] = __builtin_bit_cast(f32x4, __builtin_amdgcn_mfma_i32_16x16x64_i8(__builtin_bit_cast(v4i_t, Bt[n][k]), __builtin_bit_cast(v4i_t, At[m][k]), __builtin_bit_cast(v4i_t, acc[ai][bj][m][n]), 0, 0, 0)); } \
        else { _Pragma("unroll") for (int k = 0; k < 2; ++k) acc[ai][bj][m][n] = __builtin_amdgcn_mfma_f32_16x16x32_bf16(Bt[n][k], At[m][k], acc[ai][bj][m][n], 0, 0, 0); } } \
        __builtin_amdgcn_s_setprio(0); } while (0)
#define PG8_WAIT_V(n) asm volatile("s_waitcnt vmcnt(" #n ")" ::: "memory")
#define PG8_WAIT_L(n) asm volatile("s_waitcnt lgkmcnt(" #n ")" ::: "memory")
#define PG8_PREFETCH() do { const int prow_ = (wid & 3) * 64 + (int)__builtin_amdgcn_mbcnt_hi(~0u, __builtin_amdgcn_mbcnt_lo(~0u, 0u));     \
        const char* pb_ = (wid & 4) ? nB + (size_t)prow_ * ldb * 2 : nA + (size_t)prow_ * lda * 2; \
        _Pragma("unroll") for (int c_ = 0; c_ < 6; ++c_) { const int cc_ = (2 + c_ < nt) ? 2 + c_ : nt - 1; \
            __builtin_amdgcn_global_load_lds((const unsigned*)(pb_ + (size_t)cc_ * 128), (LAS unsigned*)(lds + 131072 + wid * 256), 4, 0, 0); } } while (0)
#define PG8_WAIT_V8P do { if (pfi) asm volatile("s_waitcnt vmcnt(14)" ::: "memory"); else asm volatile("s_waitcnt vmcnt(8)" ::: "memory"); } while (0)
#define PG8_BAR __builtin_amdgcn_s_barrier()
#define PG8_SCHED __builtin_amdgcn_sched_barrier(0)
    Unit cur, nxt; int ui = 0;
    if (!S.next(0, cur)) return;
    f32x4 acc[2][2][4][2];
#pragma unroll
    for (int a = 0; a < 2; ++a)
#pragma unroll
        for (int b = 0; b < 2; ++b)
#pragma unroll
            for (int m = 0; m < 4; ++m)
#pragma unroll
                for (int n = 0; n < 2; ++n) acc[a][b][m][n] = (f32x4){0.f, 0.f, 0.f, 0.f};
    bf16x8 At[4][2], B0[2][2], B1[2][2]; v8i_t At8[4], B08[2], B18[2]; (void)At; (void)B0; (void)B1; (void)At8; (void)B08; (void)B18;
    const char* cA = cur.A; const char* cB = cur.B;
    PG8_STAGE(PG8_SB(0, 0), cB, voffB); PG8_STAGE(PG8_SB(0, 1), cB + hB, voffB); PG8_STAGE(PG8_SA(0, 0), cA, voffA); PG8_STAGE(PG8_SA(0, 1), cA + hA, voffA);
    if (wr == 1) PG8_BAR;
    PG8_WAIT_V(2); PG8_BAR;
    PG8_STAGE(PG8_SB(1, 0), cB + kstep, voffB); PG8_STAGE(PG8_SA(1, 0), cA + kstep, voffA); PG8_STAGE(PG8_SB(1, 1), cB + hB + kstep, voffB);
    PG8_WAIT_V(6); PG8_BAR;
    for (;;) {
        const bool has_next = S.next(ui + 1, nxt);
        const char* nA = has_next ? nxt.A : cA; const char* nB = has_next ? nxt.B : cB;
#ifdef KREP
#pragma unroll 1
        for (int kr = 0; kr < (I8 ? KREP : 1); ++kr) { const char* eA = (kr == (I8 ? KREP : 1) - 1) ? nA : cA; const char* eB = (kr == (I8 ? KREP : 1) - 1) ? nB : cB;
#else
        { const char* eA = nA; const char* eB = nB;
#endif
#pragma unroll 1
        for (int t = 0; t < nt; t += 2) {
            const bool last = (t == nt - 2);
            const bool pfi = PF && last && has_next;
            const char* a1 = cA + (size_t)(t + 1) * kstep;
            const char* a2 = last ? eA : cA + (size_t)(t + 2) * kstep; const char* b2 = last ? eB : cB + (size_t)(t + 2) * kstep;
            const char* a3 = a2 + kstep; const char* b3 = b2 + kstep;
            PG8_LDB(B0, 0, 0); PG8_LDB(B1, 0, 1); PG8_SCHED; PG8_LDA(At, 0, 0); PG8_STAGE(PG8_SA(1, 1), a1 + hA, voffA);
            PG8_WAIT_V(8); PG8_WAIT_L(0); PG8_BAR; PG8_MMA(0, 0, At, B0); PG8_MMA(0, 1, At, B1); PG8_BAR; PG8_SCHED;
            PG8_LDA(At, 0, 1); if (pfi) PG8_PREFETCH(); PG8_STAGE(PG8_SB(0, 0), b2, voffB); PG8_STAGE(PG8_SB(0, 1), b2 + hB, voffB); PG8_STAGE(PG8_SA(0, 0), a2, voffA);
            PG8_WAIT_V8P; PG8_WAIT_L(0); PG8_BAR; PG8_MMA(1, 0, At, B0); PG8_MMA(1, 1, At, B1); PG8_BAR; PG8_SCHED;
            PG8_LDB(B0, 1, 0); PG8_LDB(B1, 1, 1); PG8_SCHED; PG8_LDA(At, 1, 0); PG8_STAGE(PG8_SA(0, 1), a2 + hA, voffA);
            PG8_WAIT_V8P; PG8_WAIT_L(0); PG8_BAR; PG8_MMA(0, 0, At, B0); PG8_MMA(0, 1, At, B1); PG8_BAR; PG8_SCHED;
            PG8_LDA(At, 1, 1); PG8_STAGE(PG8_SB(1, 0), b3, voffB); PG8_STAGE(PG8_SB(1, 1), b3 + hB, voffB); PG8_STAGE(PG8_SA(1, 0), a3, voffA);
            PG8_WAIT_V(8); PG8_WAIT_L(0); PG8_BAR; PG8_MMA(1, 0, At, B0); PG8_MMA(1, 1, At, B1); PG8_BAR; PG8_SCHED;
        }
        }
        if (wr == 0) PG8_BAR;
        if constexpr (F8) asm volatile("s_nop 15\n\ts_nop 15" ::: "memory");
        { int le_ = (int)__builtin_amdgcn_mbcnt_hi(~0u, __builtin_amdgcn_mbcnt_lo(~0u, 0u)); asm volatile("" : "+v"(le_));
          E(acc, cur, wr, wc, le_ & 15, le_ >> 4); }
#ifdef DUP_EPI
        if constexpr (I8) { asm volatile("" ::: "memory"); E(acc, cur, wr, wc, fr, fq); }
#endif
        if (!has_next) break;
#pragma unroll
        for (int a = 0; a < 2; ++a)
#pragma unroll
            for (int b = 0; b < 2; ++b)
#pragma unroll
                for (int m = 0; m < 4; ++m)
#pragma unroll
                    for (int n = 0; n < 2; ++n) acc[a][b][m][n] = (f32x4){0.f, 0.f, 0.f, 0.f};
        cur = nxt; cA = nA; cB = nB; ++ui;
        if (wr == 1) PG8_BAR;
    }
    PG8_WAIT_V(0);
    PG8_BAR;
#undef PG8_SA
#undef PG8_SB
#undef PG8_STAGE
#undef PG8_LDA
#undef PG8_LDB
#undef PG8_MMA
#undef PG8_WAIT_V
#undef PG8_PREFETCH
#undef PG8_WAIT_V8P
#undef PG8_WAIT_L
#undef PG8_BAR
#undef PG8_SCHED
}
struct EpiStoreS {
    static constexpr bool PERM = true;
    bf16_t* O; int ldc; float scale;
    __device__ __forceinline__ void operator()(const f32x4 (&acc)[2][2][4][2], const Unit& u, int wr, int wc, int fr, int fq) const {
        const int row0 = u.pm * BM + wr * 64 + fr, col0 = u.pn * BM + wc * 32 + 8 * fq;
#pragma unroll
        for (int ai = 0; ai < 2; ++ai)
#pragma unroll
            for (int m = 0; m < 4; ++m) { bf16_t* rowp = O + (size_t)(row0 + ai * HALF + m * 16) * ldc + col0;
#pragma unroll
                for (int bj = 0; bj < 2; ++bj) { const f32x4 v0 = acc[ai][bj][m][0] * scale, v1 = acc[ai][bj][m][1] * scale;
                    u32x4 w; w.x = cvt_pk_bf16(v0[0], v0[1]); w.y = cvt_pk_bf16(v0[2], v0[3]); w.z = cvt_pk_bf16(v1[0], v1[1]); w.w = cvt_pk_bf16(v1[2], v1[3]);
                    *(u32x4*)(rowp + bj * HALF) = w; } }
    }
};
struct EpiStore {
    static constexpr bool PERM = true;
    bf16_t* O; int ldc;
    __device__ __forceinline__ void operator()(const f32x4 (&acc)[2][2][4][2], const Unit& u, int wr, int wc, int fr, int fq) const {
        const int row0 = u.pm * BM + wr * 64 + fr, col0 = u.pn * BM + wc * 32 + 8 * fq;
#pragma unroll
        for (int ai = 0; ai < 2; ++ai)
#pragma unroll
            for (int m = 0; m < 4; ++m) { bf16_t* rowp = O + (size_t)(row0 + ai * HALF + m * 16) * ldc + col0;
#pragma unroll
                for (int bj = 0; bj < 2; ++bj) { const f32x4 v0 = acc[ai][bj][m][0], v1 = acc[ai][bj][m][1];
                    u32x4 w; w.x = cvt_pk_bf16(v0[0], v0[1]); w.y = cvt_pk_bf16(v0[2], v0[3]); w.z = cvt_pk_bf16(v1[0], v1[1]); w.w = cvt_pk_bf16(v1[2], v1[3]);
                    *(u32x4*)(rowp + bj * HALF) = w; } }
    }
};
__device__ __forceinline__ float fsig(float v) { return __builtin_amdgcn_rcpf(1.f + __builtin_amdgcn_exp2f(-1.4426950408889634f * v)); }
template <bool GLU> struct EpiPair {
    static constexpr bool PERM = true;
    bf16_t* O; int ldc; int col_off;
    __device__ __forceinline__ void operator()(const f32x4 (&acc)[2][2][4][2], const Unit& u, int wr, int wc, int fr, int fq) const {
        const int row0 = u.pm * BM + wr * 64 + fr, col0 = col_off + u.pn * 128 + wc * 16 + 4 * fq;
#pragma unroll
        for (int ai = 0; ai < 2; ++ai)
#pragma unroll
            for (int m = 0; m < 4; ++m) { bf16_t* rowp = O + (size_t)(row0 + ai * HALF + m * 16) * ldc + col0;
#pragma unroll
                for (int bj = 0; bj < 2; ++bj) { const f32x4 v0 = acc[ai][bj][m][0], v1 = acc[ai][bj][m][1];
                    float o0, o1, o2, o3;
                    if (GLU) { o0 = v0[0] * fsig(v0[1]); o1 = v0[2] * fsig(v0[3]); o2 = v1[0] * fsig(v1[1]); o3 = v1[2] * fsig(v1[3]); }
                    else { o0 = v0[0] * fsig(v0[0]) * v0[1]; o1 = v0[2] * fsig(v0[2]) * v0[3]; o2 = v1[0] * fsig(v1[0]) * v1[1]; o3 = v1[2] * fsig(v1[2]) * v1[3]; }
                    u32x2 w; w.x = cvt_pk_bf16(o0, o1); w.y = cvt_pk_bf16(o2, o3);
                    *(u32x2*)(rowp + bj * 64) = w; } }
    }
};
struct EpiSwiglu8 {
    static constexpr bool PERM = true;
    unsigned char* O; int ldc; float isc, osc;
    __device__ __forceinline__ void operator()(const f32x4 (&acc)[2][2][4][2], const Unit& u, int wr, int wc, int fr, int fq) const {
        const int row0 = u.pm * BM + wr * 64 + fr, col0 = u.pn * 128 + wc * 16 + 4 * fq;
#pragma unroll
        for (int ai = 0; ai < 2; ++ai)
#pragma unroll
            for (int m = 0; m < 4; ++m) { unsigned char* rowp = O + (size_t)(row0 + ai * HALF + m * 16) * ldc + col0;
#pragma unroll
                for (int bj = 0; bj < 2; ++bj) { const f32x4 v0 = acc[ai][bj][m][0] * isc, v1 = acc[ai][bj][m][1] * isc;
                    const float o0 = v0[0] * fsig(v0[0]) * v0[1] * osc, o1 = v0[2] * fsig(v0[2]) * v0[3] * osc, o2 = v1[0] * fsig(v1[0]) * v1[1] * osc, o3 = v1[2] * fsig(v1[2]) * v1[3] * osc;
                    *(unsigned*)(rowp + bj * 64) = pk4_fp8(o0, o1, o2, o3); } }
    }
};
template <bool OUT8> struct EpiSwigluQ {
    static constexpr bool PERM = true;
    bf16_t* O; int ldc; const float* hs; const float* ws; float osc;
    __device__ __forceinline__ void operator()(const f32x4 (&acc)[2][2][4][2], const Unit& u, int wr, int wc, int fr, int fq) const {
        const int row0 = u.pm * BM + wr * 64 + fr, col0 = u.pn * 128 + wc * 16 + 4 * fq;
        const float* wsp_ = ws + u.x0 * (2 * 3584) + u.pn * BM + wc * 32 + 8 * fq;
        constexpr float NL = -1.4426950408889634f;
        const float ob = OUT8 ? osc : 1.f;
        f32x2 sw[2][2][2];
#pragma unroll
        for (int bj = 0; bj < 2; ++bj)
#pragma unroll
            for (int n = 0; n < 2; ++n) { const float4 w = *(const float4*)(wsp_ + bj * HALF + 4 * n); sw[bj][n][0] = (f32x2){w.x, w.y * ob}; sw[bj][n][1] = (f32x2){w.z, w.w * ob}; }
        float hrv[2][4];
#pragma unroll
        for (int ai = 0; ai < 2; ++ai)
#pragma unroll
            for (int m = 0; m < 4; ++m) hrv[ai][m] = hs[row0 + ai * HALF + m * 16] * KSC;
#pragma unroll
        for (int ai = 0; ai < 2; ++ai)
#pragma unroll
            for (int m = 0; m < 4; ++m) { const int row = row0 + ai * HALF + m * 16; bf16_t* rowp = O + (size_t)row * ldc + col0; const float hr = hrv[ai][m]; const f32x2 hr2 = {hr, hr};
#pragma unroll
                for (int bj = 0; bj < 2; ++bj) { float o[4];
#pragma unroll
                    for (int n = 0; n < 2; ++n) { const v4i_t iv = __builtin_bit_cast(v4i_t, acc[ai][bj][m][n]);
                        const f32x2 p0 = (f32x2){(float)iv[0], (float)iv[1]} * (sw[bj][n][0] * hr2), p1 = (f32x2){(float)iv[2], (float)iv[3]} * (sw[bj][n][1] * hr2);
                        o[2 * n] = (p0.x * p0.y) * __builtin_amdgcn_rcpf(1.f + __builtin_amdgcn_exp2f(NL * p0.x));
                        o[2 * n + 1] = (p1.x * p1.y) * __builtin_amdgcn_rcpf(1.f + __builtin_amdgcn_exp2f(NL * p1.x)); }
                    if constexpr (OUT8) { *(unsigned*)((unsigned char*)O + (size_t)row * ldc + col0 + bj * 64) = pk4_fp8(o[0], o[1], o[2], o[3]); continue; }
                    u32x2 w; w.x = cvt_pk_bf16(o[0], o[1]); w.y = cvt_pk_bf16(o[2], o[3]);
                    *(u32x2*)(rowp + bj * 64) = w; } }
    }
};
struct EpiStoreQ {
    static constexpr bool PERM = true;
    bf16_t* O; int ldc; const float* hs; const float* ws;
    __device__ __forceinline__ void operator()(const f32x4 (&acc)[2][2][4][2], const Unit& u, int wr, int wc, int fr, int fq) const {
        const int row0 = u.pm * BM + wr * 64 + fr, col0 = u.pn * BM + wc * 32 + 8 * fq;
        float hrv[2][4];
#pragma unroll
        for (int ai = 0; ai < 2; ++ai)
#pragma unroll
            for (int m = 0; m < 4; ++m) hrv[ai][m] = hs[row0 + ai * HALF + m * 16] * KSC;
        float4 wq[2][2];
#pragma unroll
        for (int bj = 0; bj < 2; ++bj) { wq[bj][0] = *(const float4*)(ws + col0 + bj * HALF); wq[bj][1] = *(const float4*)(ws + col0 + bj * HALF + 4); }
#pragma unroll
        for (int ai = 0; ai < 2; ++ai)
#pragma unroll
            for (int m = 0; m < 4; ++m) { const int row = row0 + ai * HALF + m * 16; bf16_t* rowp = O + (size_t)row * ldc + col0; const float hr = hrv[ai][m];
#pragma unroll
                for (int bj = 0; bj < 2; ++bj) { const v4i_t i0 = __builtin_bit_cast(v4i_t, acc[ai][bj][m][0]), i1 = __builtin_bit_cast(v4i_t, acc[ai][bj][m][1]);
                    const float4 w0 = wq[bj][0], w1 = wq[bj][1];
                    u32x4 w; w.x = cvt_pk_bf16((float)i0[0] * (hr * w0.x), (float)i0[1] * (hr * w0.y)); w.y = cvt_pk_bf16((float)i0[2] * (hr * w0.z), (float)i0[3] * (hr * w0.w));
                    w.z = cvt_pk_bf16((float)i1[0] * (hr * w1.x), (float)i1[1] * (hr * w1.y)); w.w = cvt_pk_bf16((float)i1[2] * (hr * w1.z), (float)i1[3] * (hr * w1.w));
                    *(u32x4*)(rowp + bj * HALF) = w; } }
    }
};
struct EpiGateQ {
    static constexpr bool PERM = true;
    unsigned char* O; int ldc; const float* bias; const float* hs; const float* ws;
    __device__ __forceinline__ void operator()(const f32x4 (&acc)[2][2][4][2], const Unit& u, int wr, int wc, int fr, int fq) const {
        const int row0 = u.pm * BM + wr * 64 + fr, col0 = u.pn * BM + wc * 32 + 8 * fq;
        constexpr float NL = -1.4426950408889634f, K255 = 1.f / 255.f;
        f32x2 sw[2][2][2], bw[2][2][2];
#pragma unroll
        for (int bj = 0; bj < 2; ++bj)
#pragma unroll
            for (int n = 0; n < 2; ++n) { const float4 w = *(const float4*)(ws + col0 + bj * HALF + 4 * n), b = *(const float4*)(bias + col0 + bj * HALF + 4 * n);
                sw[bj][n][0] = (f32x2){w.x * NL, w.y * NL}; sw[bj][n][1] = (f32x2){w.z * NL, w.w * NL}; bw[bj][n][0] = (f32x2){b.x * NL, b.y * NL}; bw[bj][n][1] = (f32x2){b.z * NL, b.w * NL}; }
        float hrv[2][4];
#pragma unroll
        for (int ai = 0; ai < 2; ++ai)
#pragma unroll
            for (int m = 0; m < 4; ++m) hrv[ai][m] = hs[row0 + ai * HALF + m * 16] * KSC;
#pragma unroll
        for (int ai = 0; ai < 2; ++ai)
#pragma unroll
            for (int m = 0; m < 4; ++m) { const int row = row0 + ai * HALF + m * 16; const float hr = hrv[ai][m]; const f32x2 hr2 = {hr, hr}, k2 = {K255, K255};
                unsigned a4[4];
#pragma unroll
                for (int bj = 0; bj < 2; ++bj) { unsigned a[2];
#pragma unroll
                    for (int n = 0; n < 2; ++n) { const v4i_t iv = __builtin_bit_cast(v4i_t, acc[ai][bj][m][n]);
                        const f32x2 z0 = (f32x2){(float)iv[0], (float)iv[1]} * (sw[bj][n][0] * hr2) + bw[bj][n][0], z1 = (f32x2){(float)iv[2], (float)iv[3]} * (sw[bj][n][1] * hr2) + bw[bj][n][1];
                        const f32x2 x0 = (f32x2){__builtin_amdgcn_exp2f(z0.x), __builtin_amdgcn_exp2f(z0.y)} * k2 + k2, x1 = (f32x2){__builtin_amdgcn_exp2f(z1.x), __builtin_amdgcn_exp2f(z1.y)} * k2 + k2;
                        unsigned t = 0;
                        t = __builtin_amdgcn_cvt_pk_u8_f32(__builtin_amdgcn_rcpf(x0.x), 0, t); t = __builtin_amdgcn_cvt_pk_u8_f32(__builtin_amdgcn_rcpf(x0.y), 1, t);
                        t = __builtin_amdgcn_cvt_pk_u8_f32(__builtin_amdgcn_rcpf(x1.x), 2, t); t = __builtin_amdgcn_cvt_pk_u8_f32(__builtin_amdgcn_rcpf(x1.y), 3, t); a[n] = t; }
                    a4[bj * 2] = a[0]; a4[bj * 2 + 1] = a[1]; }
                *(u32x4*)(O + ((size_t)u.pm * 16 + u.pn) * 65536 + (size_t)((((wr * 4 + wc) * 2 + ai) * 4 + m) * 1024 + (fr + 16 * fq) * 16)) = (u32x4){a4[0], a4[1], a4[2], a4[3]}; }
    }
};
}

constexpr int NWAVES = 8, NTHR = 512;
constexpr int LDS_BYTES = 147456;
__device__ __forceinline__ unsigned f2bf(float f) { unsigned u = __builtin_bit_cast(unsigned, f); return (u + 0x7fffu + ((u >> 16) & 1u)) >> 16; }
__device__ __forceinline__ unsigned pk2(float lo, float hi) { return f2bf(lo) | (f2bf(hi) << 16); }
__device__ __forceinline__ float bf2f(unsigned short b) { return __builtin_bit_cast(float, (unsigned)b << 16); }
#define LDS_WAIT() asm volatile("s_waitcnt lgkmcnt(0)" ::: "memory")
__device__ __forceinline__ void transpose_item(const float* W, int ldw, int nblk, bf16_t* WT, int ldo, int row_off, int row_mul, int k_off, const float* kscale, LAS float* scr, int item, int lane) {
    const int kb = item / nblk, nb = item % nblk, k0 = 64 * kb, n0 = 32 * nb;
#pragma unroll 8
    for (int i = 0; i < 32; ++i) { const int kk = 2 * i + (lane >> 5); float v = W[(size_t)(k0 + kk) * ldw + n0 + (lane & 31)]; if (kscale) v *= kscale[k0 + kk]; scr[kk * 33 + (lane & 31)] = v; }
    LDS_WAIT(); asm volatile("" ::: "memory");
    const int c = lane & 7;
#pragma unroll
    for (int j = 0; j < 4; ++j) { const int n = (lane >> 3) + 8 * j; const LAS float* s = scr + (8 * c) * 33 + n;
        u32x4 o; o.x = pk2(s[0 * 33], s[1 * 33]); o.y = pk2(s[2 * 33], s[3 * 33]); o.z = pk2(s[4 * 33], s[5 * 33]); o.w = pk2(s[6 * 33], s[7 * 33]);
        *(u32x4*)(WT + (size_t)(row_off + (n0 + n) * row_mul) * ldo + k_off + k0 + 8 * c) = o; }
    LDS_WAIT(); asm volatile("" ::: "memory");
}
__device__ __forceinline__ void transpose_item8(const float* W, int ldw, int nblk, unsigned char* WT, int ldo, int row_off, int row_mul, float scale, LAS float* scr, int item, int lane) {
    const int kb = item / nblk, nb = item % nblk, k0 = 64 * kb, n0 = 32 * nb;
#pragma unroll 8
    for (int i = 0; i < 32; ++i) { const int kk = 2 * i + (lane >> 5); scr[kk * 33 + (lane & 31)] = W[(size_t)(k0 + kk) * ldw + n0 + (lane & 31)] * scale; }
    LDS_WAIT(); asm volatile("" ::: "memory");
    const int c = lane & 7;
#pragma unroll
    for (int j = 0; j < 4; ++j) { const int n = (lane >> 3) + 8 * j; const LAS float* sp = scr + (8 * c) * 33 + n;
        u32x2 o; o.x = pg8::pk4_fp8(sp[0 * 33], sp[1 * 33], sp[2 * 33], sp[3 * 33]); o.y = pg8::pk4_fp8(sp[4 * 33], sp[5 * 33], sp[6 * 33], sp[7 * 33]);
        *(u32x2*)(WT + (size_t)(row_off + (n0 + n) * row_mul) * ldo + k0 + 8 * c) = o; }
    LDS_WAIT(); asm volatile("" ::: "memory");
}
__device__ __forceinline__ unsigned pk4_i8(float a, float b, float c, float d) {
    const int ia = (int)__builtin_rintf(a), ib = (int)__builtin_rintf(b), ic = (int)__builtin_rintf(c), id = (int)__builtin_rintf(d);
    return (unsigned)(ia & 255) | ((unsigned)(ib & 255) << 8) | ((unsigned)(ic & 255) << 16) | ((unsigned)id << 24); }
__device__ __forceinline__ float shx_(float v, int o, int lane) { return __int_as_float(__builtin_amdgcn_ds_bpermute((lane ^ o) << 2, __float_as_int(v))); }
__device__ __forceinline__ void transpose_item_q(const float* W, int K, int ldw, int n0, signed char* WT, int ldo, int row_off, int row_mul, float* wscale, LAS float* scr, int lane) {
    const float* wp = W + (size_t)(lane >> 5) * ldw + n0 + (lane & 31);
    float am = 0.f;
#pragma unroll 16
    for (int i = 0; i < K / 2; ++i) am = fmaxf(am, fabsf(wp[(size_t)(2 * i) * ldw]));
    am = fmaxf(am, shx_(am, 32, lane));
    const float qs = 127.f / fmaxf(am, 1e-30f);
    if (lane < 32) wscale[row_off + (n0 + lane) * row_mul] = am * (1.f / 127.f);
#pragma unroll 1
    for (int kb = 0; kb < K / 64; ++kb) { const int k0 = 64 * kb;
#pragma unroll 8
        for (int i = 0; i < 32; ++i) { const int kk = 2 * i + (lane >> 5); scr[kk * 33 + (lane & 31)] = wp[(size_t)(k0 + 2 * i) * ldw] * qs; }
        LDS_WAIT(); asm volatile("" ::: "memory");
        const int c = lane & 7;
#pragma unroll
        for (int j = 0; j < 4; ++j) { const int n = (lane >> 3) + 8 * j; const LAS float* sp = scr + (8 * c) * 33 + n;
            u32x2 o; o.x = pk4_i8(sp[0 * 33], sp[1 * 33], sp[2 * 33], sp[3 * 33]); o.y = pk4_i8(sp[4 * 33], sp[5 * 33], sp[6 * 33], sp[7 * 33]);
            *(u32x2*)(WT + (size_t)(row_off + (n0 + n) * row_mul) * ldo + k0 + 8 * c) = o; }
        LDS_WAIT(); asm volatile("" ::: "memory"); }
}
__device__ __forceinline__ void colgroup_q_block(const float* W, int ldw, int n0, signed char* WT, int ldo, int row_off, int row_mul, float* wscale, LAS unsigned char* lds) {
    const int tid_ = otid(); const int wave = __builtin_amdgcn_readfirstlane(tid_ >> 6), lane = tid_ & 63;
    LAS float* scr = (LAS float*)(lds + wave * 16384); LAS float* red = (LAS float*)(lds + 12288);
    const float* wp = W + (size_t)(128 * wave + (lane >> 5)) * ldw + n0 + (lane & 31);
    float v[64]; float am = 0.f;
#pragma unroll
    for (int i = 0; i < 64; ++i) v[i] = wp[(size_t)(2 * i) * ldw];
#pragma unroll
    for (int i = 0; i < 64; ++i) am = fmaxf(am, fabsf(v[i]));
    am = fmaxf(am, shx_(am, 32, lane));
    if (lane < 32) red[wave * 4096 + lane] = am;
    __syncthreads();
#pragma unroll
    for (int w = 0; w < 8; ++w) am = fmaxf(am, red[w * 4096 + (lane & 31)]);
    const float qs = 127.f / fmaxf(am, 1e-30f);
    if (wave == 0 && lane < 32) wscale[row_off + (n0 + lane) * row_mul] = am * (1.f / 127.f);
#pragma unroll
    for (int kt = 0; kt < 2; ++kt) { const int k0 = 128 * wave + 64 * kt;
#pragma unroll
        for (int i = 0; i < 32; ++i) scr[(2 * i + (lane >> 5)) * 33 + (lane & 31)] = v[32 * kt + i] * qs;
        LDS_WAIT(); asm volatile("" ::: "memory");
        const int c = lane & 7;
#pragma unroll
        for (int j = 0; j < 4; ++j) { const int n = (lane >> 3) + 8 * j; const LAS float* sp = scr + (8 * c) * 33 + n;
            u32x2 o; o.x = pk4_i8(sp[0 * 33], sp[1 * 33], sp[2 * 33], sp[3 * 33]); o.y = pk4_i8(sp[4 * 33], sp[5 * 33], sp[6 * 33], sp[7 * 33]);
            *(u32x2*)(WT + (size_t)(row_off + (n0 + n) * row_mul) * ldo + k0 + 8 * c) = o; }
        LDS_WAIT(); asm volatile("" ::: "memory"); }
    __syncthreads();
}
__device__ __forceinline__ void conv_matrix8(const float* W, int K, int N, int ldw, unsigned char* WT, int ldo, int row_off, int row_mul, float scale, LAS unsigned char* lds, int& cursor) {
    const int tid_ = otid(); const int wave = __builtin_amdgcn_readfirstlane(tid_ >> 6), lane = tid_ & 63;
    LAS float* scr = (LAS float*)(lds + wave * 16384);
    const int gw = blockIdx.x * NWAVES + wave, NGW = gridDim.x * NWAVES;
    const int nblk = N / 32, nitems = (K / 64) * nblk;
    for (int it = (gw + NGW - (cursor % NGW)) % NGW; it < nitems; it += NGW) transpose_item8(W, ldw, nblk, WT, ldo, row_off, row_mul, scale, scr, it, lane);
    cursor += nitems;
}
__device__ __forceinline__ void conv_matrix(const float* W, int K, int N, int ldw, bf16_t* WT, int ldo, int row_off, int row_mul, int k_off, const float* kscale, LAS unsigned char* lds, int& cursor) {
    const int tid_ = otid(); const int wave = __builtin_amdgcn_readfirstlane(tid_ >> 6), lane = tid_ & 63;
    LAS float* scr = (LAS float*)(lds + wave * 16384);
    const int gw = blockIdx.x * NWAVES + wave, NGW = gridDim.x * NWAVES;
    const int nblk = N / 32, nitems = (K / 64) * nblk;
    for (int it = (gw + NGW - (cursor % NGW)) % NGW; it < nitems; it += NGW) transpose_item(W, ldw, nblk, WT, ldo, row_off, row_mul, k_off, kscale, scr, it, lane);
    cursor += nitems;
}

struct ConvFfn { const float* w1; const float* w3; const float* w2; bf16_t* W13; bf16_t* W2t; };
__global__ __launch_bounds__(NTHR, 2) void k_conv_ffn(ConvFfn a) {
    extern __shared__ __attribute__((aligned(16))) unsigned char lds_raw[];
    LAS unsigned char* lds = (LAS unsigned char*)lds_raw;
    int cursor = 0;
    conv_matrix(a.w1, D, DFF, DFF, a.W13, D, 0, 2, 0, nullptr, lds, cursor);
    conv_matrix(a.w3, D, DFF, DFF, a.W13, D, 1, 2, 0, nullptr, lds, cursor);
    conv_matrix(a.w2, DFF, D, D, a.W2t, DFF, 0, 1, 0, nullptr, lds, cursor);
}
struct GemmArgs { const bf16_t* A; const bf16_t* B; bf16_t* O; int nM, nN, K, lda, ldb, ldc, col_off, pad; };
template <class Epi> __global__ __launch_bounds__(NTHR, 2) void k_gemm(GemmArgs a) {
    extern __shared__ __attribute__((aligned(16))) unsigned char lds_raw[];
    LAS unsigned char* lds = (LAS unsigned char*)lds_raw;
    pg8::StaticOrder S; S.init(a.nM, a.nN, (int)gridDim.x, (int)blockIdx.x, a.A, a.lda, a.B, a.ldb);
    Epi E; E.O = a.O; E.ldc = a.ldc; if constexpr (!std::is_same<Epi, pg8::EpiStore>::value) E.col_off = a.col_off;
    pg8::gemm_phase<Epi, pg8::StaticOrder>(lds, a.K, a.lda, a.ldb, S, E);
}
template <bool YBF> __global__ __launch_bounds__(256) void k_lnh(float* X, const void* Yv, const float* MODl, int goff, const float* g, const float* bta, float* out, bf16_t* H, const float* MODh, int hsh, int hsc) {
    const int r = blockIdx.x * 4 + (threadIdx.x >> 6), lane = threadIdx.x & 63;
    const float* md = MODl + (size_t)modrow(r) * 6144 + goff;
    float v[16]; float s = 0.f;
#pragma unroll
    for (int j = 0; j < 4; ++j) { const int c = j * 256 + lane * 4; const float4 x4 = *(const float4*)(X + (size_t)r * D + c), m4 = *(const float4*)(md + c);
        float y0, y1, y2, y3;
        if (YBF) { const u32x2 yw = *(const u32x2*)((const bf16_t*)Yv + (size_t)r * D + c);
            y0 = __builtin_bit_cast(float, yw.x << 16); y1 = __builtin_bit_cast(float, yw.x & 0xffff0000u); y2 = __builtin_bit_cast(float, yw.y << 16); y3 = __builtin_bit_cast(float, yw.y & 0xffff0000u); }
        else { const float4 y4 = *(const float4*)((const float*)Yv + (size_t)r * D + c); y0 = y4.x; y1 = y4.y; y2 = y4.z; y3 = y4.w; }
        v[j * 4] = ALPHA * x4.x + m4.x * y0; v[j * 4 + 1] = ALPHA * x4.y + m4.y * y1; v[j * 4 + 2] = ALPHA * x4.z + m4.z * y2; v[j * 4 + 3] = ALPHA * x4.w + m4.w * y3;
        s += v[j * 4] + v[j * 4 + 1] + v[j * 4 + 2] + v[j * 4 + 3]; }
#pragma unroll
    for (int o = 1; o < 64; o <<= 1) s += __shfl_xor(s, o);
    const float mean = s / D; float q = 0.f;
#pragma unroll
    for (int j = 0; j < 16; ++j) { v[j] -= mean; q += v[j] * v[j]; }
#pragma unroll
    for (int o = 1; o < 64; o <<= 1) q += __shfl_xor(q, o);
    const float rstd = rsqrtf(q / D + 1e-5f);
    const float* mh = MODh ? MODh + (size_t)modrow(r) * 6144 : nullptr;
#pragma unroll
    for (int j = 0; j < 4; ++j) { const int c = j * 256 + lane * 4; const float4 g4 = *(const float4*)(g + c), b4 = *(const float4*)(bta + c);
        float4 o4; o4.x = v[j * 4] * rstd * g4.x + b4.x; o4.y = v[j * 4 + 1] * rstd * g4.y + b4.y; o4.z = v[j * 4 + 2] * rstd * g4.z + b4.z; o4.w = v[j * 4 + 3] * rstd * g4.w + b4.w;
        *(float4*)(X + (size_t)r * D + c) = o4; if (out && r < TL) *(float4*)(out + (size_t)r * D + c) = o4;
        if (H) { const float4 sc = *(const float4*)(mh + hsc + c), sh = *(const float4*)(mh + hsh + c);
            u32x2 w; w.x = pk2(o4.x * (1.f + sc.x) + sh.x, o4.y * (1.f + sc.y) + sh.y); w.y = pk2(o4.z * (1.f + sc.z) + sh.z, o4.w * (1.f + sc.w) + sh.w);
            *(u32x2*)(H + (size_t)r * D + c) = w; } }
}


constexpr int MAXTILES = 288;
__global__ __launch_bounds__(256) void k_route2(const float* X, const float* MODl, const float* wr, int* plan, int* ltok, int* tslot, float* tgate) {
    const int r = blockIdx.x * 4 + (threadIdx.x >> 6), lane = threadIdx.x & 63;
    const float* md = MODl + (size_t)modrow(r) * 6144;
    float lg[8];
#pragma unroll
    for (int e = 0; e < 8; ++e) lg[e] = 0.f;
    for (int j = 0; j < 16; ++j) { const int k = j * 64 + lane; const float hv = X[(size_t)r * D + k] * (1.f + md[4 * D + k]) + md[3 * D + k];
        const float4 w0 = *(const float4*)(wr + k * 8), w1 = *(const float4*)(wr + k * 8 + 4);
        lg[0] += hv * w0.x; lg[1] += hv * w0.y; lg[2] += hv * w0.z; lg[3] += hv * w0.w; lg[4] += hv * w1.x; lg[5] += hv * w1.y; lg[6] += hv * w1.z; lg[7] += hv * w1.w; }
#pragma unroll
    for (int e = 0; e < 8; ++e)
#pragma unroll
        for (int o = 1; o < 64; o <<= 1) lg[e] += __shfl_xor(lg[e], o);
    if (lane == 0) {
        int e1 = 0; float v1 = lg[0];
#pragma unroll
        for (int e = 1; e < 8; ++e) if (lg[e] > v1) { v1 = lg[e]; e1 = e; }
        int e2 = -1; float v2 = -3e38f;
#pragma unroll
        for (int e = 0; e < 8; ++e) if (e != e1 && lg[e] > v2) { v2 = lg[e]; e2 = e; }
        const float p2 = expf(v2 - v1), g1 = 1.f / (1.f + p2), g2 = p2 / (1.f + p2);
        const int s1 = atomicAdd(plan + e1, 1); ltok[e1 * T + s1] = r; tslot[r * 2] = e1 * T + s1; tgate[r * 2] = g1;
        const int s2 = atomicAdd(plan + e2, 1); ltok[e2 * T + s2] = r; tslot[r * 2 + 1] = e2 * T + s2; tgate[r * 2 + 1] = g2;
    }
}
__global__ void k_moe_plan(int* plan) {
    if (threadIdx.x == 0) { int start = 0;
        for (int e = 0; e < 8; ++e) { const int nt = (plan[e] + 255) >> 8; plan[8 + e] = start * 256; for (int t = 0; t < nt; ++t) plan[32 + start + t] = e; start += nt; }
        plan[16] = start; }
}
__global__ __launch_bounds__(256) void k_gather(const bf16_t* H, bf16_t* Hg, const int* plan, const int* ltok) {
    const int pr = blockIdx.x * 4 + (threadIdx.x >> 6), lane = threadIdx.x & 63;
    if (pr >= plan[16] * 256) return;
    const int e = plan[32 + (pr >> 8)], slot = pr - plan[8 + e];
    u32x4 v0 = (u32x4){0u, 0u, 0u, 0u}, v1 = v0;
    if (slot < plan[e]) { const int tok = ltok[e * T + slot]; const u32x4* src = (const u32x4*)(H + (size_t)tok * D); v0 = src[lane]; v1 = src[64 + lane]; }
    u32x4* dst = (u32x4*)(Hg + (size_t)pr * D); dst[lane] = v0; dst[64 + lane] = v1;
}
namespace pg8 {
struct MoeOrder {
    int nM, nN, nwg, G, c; const int* tileE; const char* A; const char* B; size_t tA, tB, tBe;
    __device__ void init(const int* plan, int nN_, int G_, int c_, const void* A_, int lda, const void* B_, int ldb, size_t expert_elems) {
        nM = plan[16]; nN = nN_; nwg = nM * nN; G = G_; c = c_; tileE = plan + 32; A = (const char*)A_; B = (const char*)B_; tA = (size_t)BM * lda * 2; tB = (size_t)BM * ldb * 2; tBe = expert_elems * 2; }
    __device__ bool next(int i, Unit& u) const {
        const long L = (long)i * G + c; if (L >= nwg) return false;
        int wgid = (int)L; { const int q = nwg / NXCD, r = nwg % NXCD, xcd = wgid % NXCD, off = wgid / NXCD; wgid = (xcd < r ? xcd * (q + 1) : r * (q + 1) + (xcd - r) * q) + off; }
        const int nig = WGM * nN, gid = wgid / nig, fm = gid * WGM, gsz = (nM - fm) < WGM ? (nM - fm) : WGM;
        u.pm = fm + ((wgid % nig) % gsz); u.pn = (wgid % nig) / gsz; u.x0 = tileE[u.pm]; u.x1 = 0;
        u.A = A + (size_t)u.pm * tA; u.B = B + (size_t)u.x0 * tBe + (size_t)u.pn * tB; return true;
    }
};
}
struct MoeGemmArgs { const bf16_t* A; const bf16_t* B; bf16_t* O; const int* plan; int nN, K, lda, ldb, ldc, pad; size_t expert_elems; };
template <class Epi> __global__ __launch_bounds__(NTHR, 2) void k_gemm_moe(MoeGemmArgs a) {
    extern __shared__ __attribute__((aligned(16))) unsigned char lds_raw[];
    LAS unsigned char* lds = (LAS unsigned char*)lds_raw;
    pg8::MoeOrder S; S.init(a.plan, a.nN, (int)gridDim.x, (int)blockIdx.x, a.A, a.lda, a.B, a.ldb, a.expert_elems);
    Epi E; E.O = a.O; E.ldc = a.ldc; if constexpr (!std::is_same<Epi, pg8::EpiStore>::value) E.col_off = 0;
    pg8::gemm_phase<Epi, pg8::MoeOrder>(lds, a.K, a.lda, a.ldb, S, E);
}
struct ConvMoe { const float* w1; const float* w3; const float* w2; bf16_t* W13; bf16_t* W2t; };
__global__ __launch_bounds__(NTHR, 2) void k_conv_moe(ConvMoe a) {
    extern __shared__ __attribute__((aligned(16))) unsigned char lds_raw[];
    LAS unsigned char* lds = (LAS unsigned char*)lds_raw;
    int cursor = 0;
    for (int e = 0; e < NE; ++e) {
        conv_matrix(a.w1 + (size_t)e * D * DFF, D, DFF, DFF, a.W13 + (size_t)e * 2 * DFF * D, D, 0, 2, 0, nullptr, lds, cursor);
        conv_matrix(a.w3 + (size_t)e * D * DFF, D, DFF, DFF, a.W13 + (size_t)e * 2 * DFF * D, D, 1, 2, 0, nullptr, lds, cursor);
        conv_matrix(a.w2 + (size_t)e * DFF * D, DFF, D, D, a.W2t + (size_t)e * D * DFF, DFF, 0, 1, 0, nullptr, lds, cursor);
    }
}
__global__ __launch_bounds__(256) void k_ln_moe(float* X, const bf16_t* Y2, const int* plan, const int* tslot, const float* tgate, const float* MODl, int goff, const float* g, const float* bta, float* out, bf16_t* H, const float* MODh) {
    const int r = blockIdx.x * 4 + (threadIdx.x >> 6), lane = threadIdx.x & 63;
    const float* md = MODl + (size_t)modrow(r) * 6144 + goff;
    const int t0 = tslot[r * 2], t1 = tslot[r * 2 + 1]; const float g0 = tgate[r * 2], g1 = tgate[r * 2 + 1];
    const int e0 = t0 / T, e1 = t1 / T; const size_t p0 = (size_t)(plan[8 + e0] + (t0 - e0 * T)), p1 = (size_t)(plan[8 + e1] + (t1 - e1 * T));
    float v[16]; float s = 0.f;
#pragma unroll
    for (int j = 0; j < 4; ++j) { const int c = j * 256 + lane * 4; const float4 x4 = *(const float4*)(X + (size_t)r * D + c), m4 = *(const float4*)(md + c);
        const u32x2 ya = *(const u32x2*)(Y2 + p0 * D + c), yb = *(const u32x2*)(Y2 + p1 * D + c);
        const float y0 = g0 * __builtin_bit_cast(float, ya.x << 16) + g1 * __builtin_bit_cast(float, yb.x << 16), y1 = g0 * __builtin_bit_cast(float, ya.x & 0xffff0000u) + g1 * __builtin_bit_cast(float, yb.x & 0xffff0000u);
        const float y2 = g0 * __builtin_bit_cast(float, ya.y << 16) + g1 * __builtin_bit_cast(float, yb.y << 16), y3 = g0 * __builtin_bit_cast(float, ya.y & 0xffff0000u) + g1 * __builtin_bit_cast(float, yb.y & 0xffff0000u);
        v[j * 4] = ALPHA * x4.x + m4.x * y0; v[j * 4 + 1] = ALPHA * x4.y + m4.y * y1; v[j * 4 + 2] = ALPHA * x4.z + m4.z * y2; v[j * 4 + 3] = ALPHA * x4.w + m4.w * y3;
        s += v[j * 4] + v[j * 4 + 1] + v[j * 4 + 2] + v[j * 4 + 3]; }
#pragma unroll
    for (int o = 1; o < 64; o <<= 1) s += __shfl_xor(s, o);
    const float mean = s / D; float q = 0.f;
#pragma unroll
    for (int j = 0; j < 16; ++j) { v[j] -= mean; q += v[j] * v[j]; }
#pragma unroll
    for (int o = 1; o < 64; o <<= 1) q += __shfl_xor(q, o);
    const float rstd = rsqrtf(q / D + 1e-5f);
#pragma unroll
    for (int j = 0; j < 4; ++j) { const int c = j * 256 + lane * 4; const float4 g4 = *(const float4*)(g + c), b4 = *(const float4*)(bta + c);
        float4 o4; o4.x = v[j * 4] * rstd * g4.x + b4.x; o4.y = v[j * 4 + 1] * rstd * g4.y + b4.y; o4.z = v[j * 4 + 2] * rstd * g4.z + b4.z; o4.w = v[j * 4 + 3] * rstd * g4.w + b4.w;
        *(float4*)(X + (size_t)r * D + c) = o4; if (out && r < TL) *(float4*)(out + (size_t)r * D + c) = o4;
        if (H) { const float* mh = MODh + (size_t)modrow(r) * 6144; const float4 sc = *(const float4*)(mh + D + c), sh = *(const float4*)(mh + c);
            u32x2 w; w.x = pk2(o4.x * (1.f + sc.x) + sh.x, o4.y * (1.f + sc.y) + sh.y); w.y = pk2(o4.z * (1.f + sc.z) + sh.z, o4.w * (1.f + sc.w) + sh.w);
            *(u32x2*)(H + (size_t)r * D + c) = w; } }
}


constexpr int ZC = 2304;
constexpr int NWG = ZC + 4 * D;
namespace pg8 {
struct EpiGate {
    static constexpr bool PERM = true;
    bf16_t* O; int ldc; const float* bias; float isc = 1.f; bool u8 = false;
    __device__ __forceinline__ void operator()(const f32x4 (&acc)[2][2][4][2], const Unit& u, int wr, int wc, int fr, int fq) const {
        const int row0 = u.pm * BM + wr * 64 + fr, col0 = u.pn * BM + wc * 32 + 8 * fq;
        f32x4 bv[2][2];
#pragma unroll
        for (int bj = 0; bj < 2; ++bj)
#pragma unroll
            for (int n = 0; n < 2; ++n) bv[bj][n] = *(const f32x4*)(bias + col0 + bj * HALF + 4 * n);
#pragma unroll
        for (int ai = 0; ai < 2; ++ai)
#pragma unroll
            for (int m = 0; m < 4; ++m) { bf16_t* rowp = O + (size_t)(row0 + ai * HALF + m * 16) * ldc + col0;
#pragma unroll
                for (int bj = 0; bj < 2; ++bj) { const f32x4 v0 = acc[ai][bj][m][0] * isc + bv[bj][0], v1 = acc[ai][bj][m][1] * isc + bv[bj][1];
                    if (u8) { unsigned a0 = 0, a1 = 0;
                        a0 = __builtin_amdgcn_cvt_pk_u8_f32(fsig(v0[0]) * 255.f, 0, a0); a0 = __builtin_amdgcn_cvt_pk_u8_f32(fsig(v0[1]) * 255.f, 1, a0); a0 = __builtin_amdgcn_cvt_pk_u8_f32(fsig(v0[2]) * 255.f, 2, a0); a0 = __builtin_amdgcn_cvt_pk_u8_f32(fsig(v0[3]) * 255.f, 3, a0);
                        a1 = __builtin_amdgcn_cvt_pk_u8_f32(fsig(v1[0]) * 255.f, 0, a1); a1 = __builtin_amdgcn_cvt_pk_u8_f32(fsig(v1[1]) * 255.f, 1, a1); a1 = __builtin_amdgcn_cvt_pk_u8_f32(fsig(v1[2]) * 255.f, 2, a1); a1 = __builtin_amdgcn_cvt_pk_u8_f32(fsig(v1[3]) * 255.f, 3, a1);
                        *(u32x2*)((unsigned char*)O + (size_t)(row0 + ai * HALF + m * 16) * ldc + col0 + bj * HALF) = (u32x2){a0, a1}; continue; }
                    u32x4 w; w.x = cvt_pk_bf16(fsig(v0[0]), fsig(v0[1])); w.y = cvt_pk_bf16(fsig(v0[2]), fsig(v0[3])); w.z = cvt_pk_bf16(fsig(v1[0]), fsig(v1[1])); w.w = cvt_pk_bf16(fsig(v1[2]), fsig(v1[3]));
                    *(u32x4*)(rowp + bj * HALF) = w; } }
    }
};
struct MergeOrder {
    StaticOrder so; const char* A; const char* B; size_t tA;
    __device__ void init(int nM, int G_, int c_, const void* A_, const void* B_) { so.init(nM, 4, G_, c_, A_, D, B_, 256); A = (const char*)A_; B = (const char*)B_; tA = (size_t)BM * D * 2; }
    __device__ bool next(int j, Unit& u) const {
        if (!so.next(j >> 2, u)) return false;
        const int i = j & 3; u.x0 = i;
        u.A = A + (size_t)u.pm * tA + (size_t)i * 256 * 2;
        u.B = B + ((size_t)i * D + (size_t)u.pn * BM) * 256 * 2;
        return true;
    }
};
__device__ __forceinline__ float bflo(unsigned w) { return __builtin_bit_cast(float, w << 16); }
__device__ __forceinline__ float bfhi(unsigned w) { return __builtin_bit_cast(float, w & 0xffff0000u); }
struct EpiMerge {
    static constexpr bool PERM = true;
    bf16_t* M; const bf16_t* G;
    __device__ __forceinline__ void operator()(const f32x4 (&acc)[2][2][4][2], const Unit& u, int wr, int wc, int fr, int fq) const {
        const int i = u.x0;
        const unsigned char* G8p = (const unsigned char*)G + ((size_t)u.pm * BM + (wr * 64 + fr)) * (4 * D) + (size_t)i * D + (size_t)u.pn * BM + wc * 32 + 8 * fq;
        const bf16_t* Gt = G + ((size_t)u.pm * BM * (4 * D) + (size_t)i * D + (size_t)u.pn * BM) + (size_t)((wr * 64 + fr) * (4 * D) + wc * 32 + 8 * fq);
        bf16_t* Mt = M + ((size_t)u.pm * BM * D + (size_t)u.pn * BM) + (size_t)((wr * 64 + fr) * D + wc * 32 + 8 * fq);
        u32x4 g[2][4][2], p[4][2], w[4][2];
#pragma unroll
        for (int ai = 0; ai < 2; ++ai)
#pragma unroll
            for (int m = 0; m < 4; ++m)
#pragma unroll
                for (int bj = 0; bj < 2; ++bj) { if (G8) { if (bj == 0) { const u32x4 gq = *(const u32x4*)((const unsigned char*)G + ((size_t)u.pm * 16 + (size_t)i * 4 + u.pn) * 65536 + (size_t)((((wr * 4 + wc) * 2 + ai) * 4 + m) * 1024 + (fr + 16 * fq) * 16));
                        g[ai][m][0] = (u32x4){gq.x, gq.y, 0u, 0u}; g[ai][m][1] = (u32x4){gq.z, gq.w, 0u, 0u}; } }
                    else g[ai][m][bj] = *(const u32x4*)(Gt + (size_t)(ai * HALF + m * 16) * (4 * D) + bj * HALF); }
#pragma unroll
        for (int m = 0; m < 4; ++m)
#pragma unroll
            for (int bj = 0; bj < 2; ++bj) { p[m][bj] = (u32x4){0u, 0u, 0u, 0u}; if (i) p[m][bj] = *(const u32x4*)(Mt + (size_t)(m * 16) * D + bj * HALF); }
#pragma unroll
        for (int ai = 0; ai < 2; ++ai) {
#pragma unroll
            for (int m = 0; m < 4; ++m)
#pragma unroll
                for (int bj = 0; bj < 2; ++bj) { const f32x4 v0 = acc[ai][bj][m][0], v1 = acc[ai][bj][m][1]; const u32x4 gg = g[ai][m][bj], pp = p[m][bj]; u32x4 o;
                    if (G8) { constexpr float k = 1.f / 255.f;
                        o.x = cvt_pk_bf16(bflo(pp.x) + (float)(gg.x & 255u) * k * v0[0], bfhi(pp.x) + (float)((gg.x >> 8) & 255u) * k * v0[1]); o.y = cvt_pk_bf16(bflo(pp.y) + (float)((gg.x >> 16) & 255u) * k * v0[2], bfhi(pp.y) + (float)(gg.x >> 24) * k * v0[3]);
                        o.z = cvt_pk_bf16(bflo(pp.z) + (float)(gg.y & 255u) * k * v1[0], bfhi(pp.z) + (float)((gg.y >> 8) & 255u) * k * v1[1]); o.w = cvt_pk_bf16(bflo(pp.w) + (float)((gg.y >> 16) & 255u) * k * v1[2], bfhi(pp.w) + (float)(gg.y >> 24) * k * v1[3]); }
                    else { o.x = cvt_pk_bf16(bflo(pp.x) + bflo(gg.x) * v0[0], bfhi(pp.x) + bfhi(gg.x) * v0[1]); o.y = cvt_pk_bf16(bflo(pp.y) + bflo(gg.y) * v0[2], bfhi(pp.y) + bfhi(gg.y) * v0[3]);
                        o.z = cvt_pk_bf16(bflo(pp.z) + bflo(gg.z) * v1[0], bfhi(pp.z) + bfhi(gg.z) * v1[1]); o.w = cvt_pk_bf16(bflo(pp.w) + bflo(gg.w) * v1[2], bfhi(pp.w) + bfhi(gg.w) * v1[3]); }
                    w[m][bj] = o; }
            if (ai == 0) {
#pragma unroll
                for (int m = 0; m < 4; ++m)
#pragma unroll
                    for (int bj = 0; bj < 2; ++bj) { p[m][bj] = (u32x4){0u, 0u, 0u, 0u}; if (i) p[m][bj] = *(const u32x4*)(Mt + (size_t)(HALF + m * 16) * D + bj * HALF); } }
#pragma unroll
            for (int m = 0; m < 4; ++m)
#pragma unroll
                for (int bj = 0; bj < 2; ++bj) *(u32x4*)(Mt + (size_t)(ai * HALF + m * 16) * D + bj * HALF) = w[m][bj];
        }
    }
};
}
struct ConvMix { const float* w_in; const float* w_gate; const float* w_branch; const float* w_out; bf16_t* WinG; bf16_t* Wbr; bf16_t* Wout; };
__global__ __launch_bounds__(NTHR, 2) void k_conv_mix(ConvMix a) {
    extern __shared__ __attribute__((aligned(16))) unsigned char lds_raw[];
    LAS unsigned char* lds = (LAS unsigned char*)lds_raw;
    int cursor = 0;
    conv_matrix(a.w_in, D, INC, INC, a.WinG, D, 0, 1, 0, nullptr, lds, cursor);
    conv_matrix(a.w_gate, D, 4 * D, 4 * D, a.WinG, D, ZC, 1, 0, nullptr, lds, cursor);
    for (int i = 0; i < 4; ++i) conv_matrix(a.w_branch + (size_t)i * 256 * D, 256, D, D, a.Wbr, 256, i * D, 1, 0, nullptr, lds, cursor);
    conv_matrix(a.w_out, D, D, D, a.Wout, D, 0, 1, 0, nullptr, lds, cursor);
    for (int i = blockIdx.x * NTHR + threadIdx.x; i < (ZC - INC) * D / 8; i += gridDim.x * NTHR) ((u32x4*)(a.WinG + (size_t)INC * D))[i] = (u32x4){0u, 0u, 0u, 0u};
}
struct Gemm2Args { const bf16_t* A; const bf16_t* B; bf16_t* O; const float* bias; const bf16_t* G; int nM, nN, K, lda, ldb, ldc; };
__global__ __launch_bounds__(NTHR, 2) void k_gemm_gate(Gemm2Args a) {
    extern __shared__ __attribute__((aligned(16))) unsigned char lds_raw[];
    LAS unsigned char* lds = (LAS unsigned char*)lds_raw;
    pg8::StaticOrder S; S.init(a.nM, a.nN, (int)gridDim.x, (int)blockIdx.x, a.A, a.lda, a.B, a.ldb);
    pg8::EpiGate E; E.O = a.O; E.ldc = a.ldc; E.bias = a.bias;
    pg8::gemm_phase<pg8::EpiGate, pg8::StaticOrder>(lds, a.K, a.lda, a.ldb, S, E);
}
__global__ __launch_bounds__(NTHR, 2) void k_gemm_merge(Gemm2Args a) {
    extern __shared__ __attribute__((aligned(16))) unsigned char lds_raw[];
    LAS unsigned char* lds = (LAS unsigned char*)lds_raw;
    pg8::MergeOrder S; S.init(a.nM, (int)gridDim.x, (int)blockIdx.x, a.A, a.B);
    pg8::EpiMerge E; E.M = a.O; E.G = a.G;
    pg8::gemm_phase<pg8::EpiMerge, pg8::MergeOrder>(lds, 256, D, 256, S, E);
}
__global__ void k_modh(const float* X, const float* MODl, int sh, int sc, bf16_t* H) {
    const size_t i = ((size_t)blockIdx.x * 256 + threadIdx.x) * 4; const int r = (int)(i >> 10), c = (int)(i & 1023);
    const float* md = MODl + (size_t)modrow(r) * 6144; const float4 x = *(const float4*)(X + i), s4 = *(const float4*)(md + sc + c), h4 = *(const float4*)(md + sh + c);
    u32x2 w; w.x = pk2(x.x * (1.f + s4.x) + h4.x, x.y * (1.f + s4.y) + h4.y); w.y = pk2(x.z * (1.f + s4.z) + h4.z, x.w * (1.f + s4.w) + h4.w);
    *(u32x2*)(H + i) = w;
}
__global__ void k_z_expand(const bf16_t* Zb, float* Z) {
    const size_t i = (size_t)blockIdx.x * 256 + threadIdx.x; if (i >= (size_t)T * INC) return; const size_t r = i / INC, c = i % INC;
    Z[i] = bf2f(Zb[r * ZC + c]);
}
__global__ void k_o_compress(const float* O, bf16_t* Ob) {
    const size_t i = ((size_t)blockIdx.x * 256 + threadIdx.x) * 4; const float4 v = *(const float4*)(O + i);
    u32x2 w; w.x = pk2(v.x, v.y); w.y = pk2(v.z, v.w); *(u32x2*)(Ob + i) = w;
}


constexpr int KB = SQ + CL;
constexpr float C_MLA = 0.10206207261596575f * 1.4426950408889634f, C_DIFF = 0.17677669529663687f * 1.4426950408889634f, C_NA = 0.125f * 1.4426950408889634f;
typedef float f32x16 __attribute__((ext_vector_type(16)));
using pg8::bflo; using pg8::bfhi;
__device__ __forceinline__ float shx(float v, int o, int lane) { return __int_as_float(__builtin_amdgcn_ds_bpermute((lane ^ o) << 2, __float_as_int(v))); }
__device__ __forceinline__ float wave_sum(float v, int lane) {
#pragma unroll
    for (int o = 1; o < 64; o <<= 1) v += shx(v, o, lane);
    return v;
}
__device__ __forceinline__ void zero_rect(bf16_t* W, int ldo, int r0, int r1, int k0, int k1) {
    const int kw = (k1 - k0) / 8, n = (r1 - r0) * kw;
    for (int i = blockIdx.x * NTHR + otid(); i < n; i += gridDim.x * NTHR) { const int r = r0 + i / kw, k = k0 + (i % kw) * 8; *(u32x4*)(W + (size_t)r * ldo + k) = (u32x4){0u, 0u, 0u, 0u}; }
}
struct ConvExp { const float* w_uq; const float* w_ukv; const float* gq; const float* gkv; const float* w_glu; bf16_t* Wexp; bf16_t* Wglu; };
__global__ __launch_bounds__(NTHR, 2) void k_conv_exp(ConvExp a) {
    extern __shared__ __attribute__((aligned(16))) unsigned char lds_raw[];
    LAS unsigned char* lds = (LAS unsigned char*)lds_raw;
    int cursor = 0;
    conv_matrix(a.w_uq, 256, 384, 384, a.Wexp, 384, 0, 1, 0, a.gq, lds, cursor);
    conv_matrix(a.w_ukv, 128, 512, 512, a.Wexp, 384, 384, 1, 256, a.gkv, lds, cursor);
    zero_rect(a.Wexp, 384, 0, 384, 256, 384); zero_rect(a.Wexp, 384, 384, 896, 0, 256); zero_rect(a.Wexp, 384, 896, 1024, 0, 384);
    conv_matrix(a.w_glu, 256, 256, 512, a.Wglu, 256, 0, 2, 0, nullptr, lds, cursor);
    conv_matrix(a.w_glu + 256, 256, 256, 512, a.Wglu, 256, 1, 2, 0, nullptr, lds, cursor);
}
struct PrepArgs { const bf16_t* ZB; const bf16_t* EB; bf16_t* QM; bf16_t* KM; bf16_t* QD; bf16_t* KD; bf16_t* VTN; bf16_t* VTM; bf16_t* VTD; };
__device__ __forceinline__ void prep_row(const PrepArgs& a, int r, int lane) {
    const bf16_t* z = a.ZB + (size_t)r * ZC; const bf16_t* e = a.EB + (size_t)r * D;
    float sq, sk;
    { const u32x2 w = *(const u32x2*)(z + O_MQ + 4 * lane); const float a0 = bflo(w.x), a1 = bfhi(w.x), a2 = bflo(w.y), a3 = bfhi(w.y); sq = a0 * a0 + a1 * a1 + a2 * a2 + a3 * a3;
      const unsigned v = *(const unsigned*)(z + O_MKV + 2 * lane); const float b0 = bflo(v), b1 = bfhi(v); sk = b0 * b0 + b1 * b1; }
    sq = wave_sum(sq, lane); sk = wave_sum(sk, lane);
    const float rq = rsqrtf(sq * (1.f / 256.f) + 1e-6f), rk = rsqrtf(sk * (1.f / 128.f) + 1e-6f);
    const bool lat = r < TL; const int t = r & (SQ - 1), j = lane & 31;
    float sn = 0.f, cs = 1.f;
    if (lat) { const float pos = (float)((j & 16) ? (t & 63) : (t >> 6)); const float inv = exp2f(-(float)(j & 7) * 0.125f * 13.287712379549449f); sincosf(pos * inv, &sn, &cs); }
#define ROPE(v) ({ const float v_ = (v); const float p_ = shx(v_, 8, lane); (j & 8) ? (p_ * sn + v_ * cs) : (v_ * cs - p_ * sn); })
#pragma unroll
    for (int h = 0; h < 4; ++h) {
        a.QM[((size_t)h * T + r) * 96 + lane] = (bf16_t)f2bf(bf2f(e[h * 96 + lane]) * rq * C_MLA);
        a.KM[((size_t)h * T + r) * 96 + lane] = (bf16_t)f2bf(bf2f(e[384 + h * 128 + lane]) * rk);
    }
#pragma unroll
    for (int p = 0; p < 2; ++p) { const int hh = 2 * p + (lane >> 5); const float v = ROPE(bf2f(e[hh * 96 + 64 + j]) * rq); a.QM[((size_t)hh * T + r) * 96 + 64 + j] = (bf16_t)f2bf(v * C_MLA); }
    { const float v = ROPE(bf2f(z[O_MKR + j])); const bf16_t o = (bf16_t)f2bf(v); const int h0 = (lane >> 5) * 2;
      a.KM[((size_t)h0 * T + r) * 96 + 64 + j] = o; a.KM[((size_t)(h0 + 1) * T + r) * 96 + 64 + j] = o; }
#pragma unroll
    for (int p = 0; p < 4; ++p) { const int vec = 2 * p + (lane >> 5);
        const float vq = ROPE(bf2f(z[O_DQ + vec * 32 + j])); a.QD[((size_t)vec * T + r) * 32 + j] = (bf16_t)f2bf(vq * C_DIFF);
        const float vk = ROPE(bf2f(z[O_DK + vec * 32 + j])); a.KD[((size_t)vec * T + r) * 32 + j] = (bf16_t)f2bf(vk); }
#undef ROPE
}
__device__ __forceinline__ void prep_vt_tile(const PrepArgs& a, int ti, LAS unsigned char* lds) {
    const int tid = otid(), wave = tid >> 6, lane = tid & 63;
    const int r0 = ti * 64; const bool lat = r0 < TL;
    const int b = lat ? (r0 >> 12) : ((r0 - TL) >> 8), slot0 = lat ? (r0 & (SQ - 1)) : (SQ + ((r0 - TL) & (CL - 1)));
    LAS bf16_t* tile = (LAS bf16_t*)lds;
    for (int src = 0; src < 3; ++src) {
        bf16_t* dst = src == 0 ? a.VTN : (src == 1 ? a.VTM : a.VTD);
        for (int i = 0; i < 8; ++i) { const int tok = wave * 8 + i, r = r0 + tok;
            float v0, v1, v2, v3;
            if (src == 1) { const bf16_t* z = a.ZB + (size_t)r * ZC; const unsigned kv = *(const unsigned*)(z + O_MKV + 2 * lane); const float b0 = bflo(kv), b1 = bfhi(kv);
                const float rk = rsqrtf(wave_sum(b0 * b0 + b1 * b1, lane) * (1.f / 128.f) + 1e-6f);
                const int c = 4 * lane, h = c >> 6, d = c & 63; const u32x2 w = *(const u32x2*)(a.EB + (size_t)r * D + 384 + h * 128 + 64 + d);
                v0 = bflo(w.x) * rk; v1 = bfhi(w.x) * rk; v2 = bflo(w.y) * rk; v3 = bfhi(w.y) * rk; }
            else { const u32x2 w = *(const u32x2*)(a.ZB + (size_t)r * ZC + (src == 0 ? O_NAV : O_DV) + 4 * lane); v0 = bflo(w.x); v1 = bfhi(w.x); v2 = bflo(w.y); v3 = bfhi(w.y); }
            tile[(4 * lane + 0) * 72 + tok] = (bf16_t)f2bf(v0); tile[(4 * lane + 1) * 72 + tok] = (bf16_t)f2bf(v1); tile[(4 * lane + 2) * 72 + tok] = (bf16_t)f2bf(v2); tile[(4 * lane + 3) * 72 + tok] = (bf16_t)f2bf(v3); }
        __syncthreads();
        for (int i = tid; i < 1024; i += NTHR) { const int row = i >> 2, g = i & 3; const LAS u32x2* p = (const LAS u32x2*)(tile + row * 72 + g * 16);
            const u32x2 q0 = p[0], q1 = p[1], q2 = p[2], q3 = p[3];
            bf16_t* o = dst + ((size_t)(b * 4 + (row >> 6)) * 64 + (row & 63)) * KB + slot0 + g * 16;
            *(u32x4*)o = (u32x4){q0.x, q0.y, q2.x, q2.y}; *(u32x4*)(o + 8) = (u32x4){q1.x, q1.y, q3.x, q3.y}; }
        __syncthreads();
    }
}
template <int NT> __device__ __forceinline__ void prep_rows_fast(const PrepArgs& a, const float* rope_tab, int r0, int rstride, int nrows, int lane) {
    const int hq = lane >> 4, d0 = 4 * (lane & 15), vi = lane >> 3, j0 = 4 * (lane & 7);
    const bool second = (lane & 2) != 0, colhalf = (lane & 4) != 0;
    u32x2 zq[NT], eq[NT], ek[NT], rp[NT][3]; unsigned zkv[NT]; f32x4 cs[NT], sn[NT]; int rr[NT]; bool ok[NT];
#pragma unroll
    for (int t = 0; t < NT; ++t) { rr[t] = r0 + t * rstride; ok[t] = rr[t] < nrows; const int r = ok[t] ? rr[t] : 0;
        const bf16_t* z = a.ZB + (size_t)r * ZC; const bf16_t* e = a.EB + (size_t)r * D;
        zq[t] = *(const u32x2*)(z + O_MQ + 4 * lane); zkv[t] = *(const unsigned*)(z + O_MKV + 2 * lane);
        eq[t] = *(const u32x2*)(e + hq * 96 + d0); ek[t] = *(const u32x2*)(e + 384 + hq * 128 + d0);
        rp[t][0] = vi < 4 ? *(const u32x2*)(e + vi * 96 + 64 + j0) : *(const u32x2*)(z + O_DQ + (vi - 4) * 32 + j0);
        rp[t][1] = vi < 4 ? *(const u32x2*)(z + O_DQ + (vi + 4) * 32 + j0) : *(const u32x2*)(z + O_DK + (vi - 4) * 32 + j0);
        rp[t][2] = vi < 4 ? *(const u32x2*)(z + O_DK + (vi + 4) * 32 + j0) : *(const u32x2*)(z + O_MKR + j0);
        const bool lat = r < TL; const int tk = r & (SQ - 1), pos = colhalf ? (tk & 63) : (tk >> 6);
        cs[t] = (f32x4){1.f, 1.f, 1.f, 1.f}; sn[t] = (f32x4){0.f, 0.f, 0.f, 0.f};
        if (lat) { cs[t] = *(const f32x4*)(rope_tab + pos * 16 + 4 * (lane & 1)); sn[t] = *(const f32x4*)(rope_tab + pos * 16 + 8 + 4 * (lane & 1)); } }
#pragma unroll
    for (int t = 0; t < NT; ++t) { const int r = rr[t];
        float sq, sk;
        { const float a0 = bflo(zq[t].x), a1 = bfhi(zq[t].x), a2 = bflo(zq[t].y), a3 = bfhi(zq[t].y); sq = a0 * a0 + a1 * a1 + a2 * a2 + a3 * a3; const float b0 = bflo(zkv[t]), b1 = bfhi(zkv[t]); sk = b0 * b0 + b1 * b1; }
#pragma unroll
        for (int o = 1; o < 64; o <<= 1) { sq += shx(sq, o, lane); sk += shx(sk, o, lane); }
        const float rq = rsqrtf(sq * (1.f / 256.f) + 1e-6f), rk = rsqrtf(sk * (1.f / 128.f) + 1e-6f);
        if (ok[t]) {
            { const float f = rq * C_MLA; u32x2 w; w.x = pk2(bflo(eq[t].x) * f, bfhi(eq[t].x) * f); w.y = pk2(bflo(eq[t].y) * f, bfhi(eq[t].y) * f); *(u32x2*)(a.QM + ((size_t)hq * T + r) * 96 + d0) = w; }
            { u32x2 w; w.x = pk2(bflo(ek[t].x) * rk, bfhi(ek[t].x) * rk); w.y = pk2(bflo(ek[t].y) * rk, bfhi(ek[t].y) * rk); *(u32x2*)(a.KM + ((size_t)hq * T + r) * 96 + d0) = w; } }
#pragma unroll
        for (int p = 0; p < 3; ++p) {
            f32x4 v = (f32x4){bflo(rp[t][p].x), bfhi(rp[t][p].x), bflo(rp[t][p].y), bfhi(rp[t][p].y)};
            f32x4 pr; pr[0] = shx(v[0], 2, lane); pr[1] = shx(v[1], 2, lane); pr[2] = shx(v[2], 2, lane); pr[3] = shx(v[3], 2, lane);
            f32x4 o = second ? pr * sn[t] + v * cs[t] : v * cs[t] - pr * sn[t];
            float f = 1.f; bf16_t* dst;
            if (p == 0) { if (vi < 4) { f = rq * C_MLA; dst = a.QM + ((size_t)vi * T + r) * 96 + 64 + j0; } else { f = C_DIFF; dst = a.QD + ((size_t)(vi - 4) * T + r) * 32 + j0; } }
            else if (p == 1) { if (vi < 4) { f = C_DIFF; dst = a.QD + ((size_t)(vi + 4) * T + r) * 32 + j0; } else dst = a.KD + ((size_t)(vi - 4) * T + r) * 32 + j0; }
            else { if (vi < 4) dst = a.KD + ((size_t)(vi + 4) * T + r) * 32 + j0; else dst = a.KM + ((size_t)(vi - 4) * T + r) * 96 + 64 + j0; }
            if (ok[t]) { u32x2 w; w.x = pk2(o[0] * f, o[1] * f); w.y = pk2(o[2] * f, o[3] * f); *(u32x2*)dst = w; } }
    }
}
__device__ __forceinline__ void prep_vt_tile_fast(const PrepArgs& a, int ti, LAS unsigned char* lds) {
    const int tid = otid(), wave = tid >> 6, lane = tid & 63;
    const int r0 = ti * 64; const bool lat = r0 < TL;
    const int b = lat ? (r0 >> 12) : ((r0 - TL) >> 8), slot0 = lat ? (r0 & (SQ - 1)) : (SQ + ((r0 - TL) & (CL - 1)));
    LAS bf16_t* tile = (LAS bf16_t*)lds;
    u32x2 vv[3][8]; unsigned kv[8];
    { const int c = 4 * lane, h = c >> 6, d = c & 63;
#pragma unroll
      for (int i = 0; i < 8; ++i) { const int r = r0 + wave * 8 + i; const bf16_t* z = a.ZB + (size_t)r * ZC;
          vv[0][i] = *(const u32x2*)(z + O_NAV + 4 * lane); vv[2][i] = *(const u32x2*)(z + O_DV + 4 * lane); vv[1][i] = *(const u32x2*)(a.EB + (size_t)r * D + 384 + h * 128 + 64 + d); kv[i] = *(const unsigned*)(z + O_MKV + 2 * lane); } }
#pragma unroll
    for (int src = 0; src < 3; ++src) {
        bf16_t* dst = src == 0 ? a.VTN : (src == 1 ? a.VTM : a.VTD);
#pragma unroll
        for (int i = 0; i < 8; ++i) { const int tok = wave * 8 + i; u32x2 w = vv[src][i];
            if (src == 1) { const float b0 = bflo(kv[i]), b1 = bfhi(kv[i]); const float rk = rsqrtf(wave_sum(b0 * b0 + b1 * b1, lane) * (1.f / 128.f) + 1e-6f);
                w.x = pk2(bflo(w.x) * rk, bfhi(w.x) * rk); w.y = pk2(bflo(w.y) * rk, bfhi(w.y) * rk); }
            tile[(4 * lane + 0) * 72 + tok] = (bf16_t)(w.x & 0xffffu); tile[(4 * lane + 1) * 72 + tok] = (bf16_t)(w.x >> 16); tile[(4 * lane + 2) * 72 + tok] = (bf16_t)(w.y & 0xffffu); tile[(4 * lane + 3) * 72 + tok] = (bf16_t)(w.y >> 16); }
        __syncthreads();
        for (int i = tid; i < 1024; i += NTHR) { const int row = i >> 2, g = i & 3; const LAS u32x2* p = (const LAS u32x2*)(tile + row * 72 + g * 16);
            const u32x2 q0 = p[0], q1 = p[1], q2 = p[2], q3 = p[3];
            bf16_t* o = dst + ((size_t)(b * 4 + (row >> 6)) * 64 + (row & 63)) * KB + slot0 + g * 16;
            *(u32x4*)o = (u32x4){q0.x, q0.y, q2.x, q2.y}; *(u32x4*)(o + 8) = (u32x4){q1.x, q1.y, q3.x, q3.y}; }
        __syncthreads();
    }
}
__global__ __launch_bounds__(NTHR, 2) void k_prep(PrepArgs a) {
    extern __shared__ __attribute__((aligned(16))) unsigned char lds_raw[];
    LAS unsigned char* lds = (LAS unsigned char*)lds_raw;
    const int wave = threadIdx.x >> 6, lane = threadIdx.x & 63;
    for (int r = blockIdx.x * NWAVES + wave; r < T; r += gridDim.x * NWAVES) prep_row(a, r, lane);
    for (int ti = blockIdx.x; ti < T / 64; ti += gridDim.x) prep_vt_tile(a, ti, lds);
}

#define MFMA32(a, b, c) __builtin_amdgcn_mfma_f32_32x32x16_bf16((a), (b), (c), 0, 0, 0)
__device__ __forceinline__ float xhalf_max(float v) { auto rr = __builtin_amdgcn_permlane32_swap(__float_as_uint(v), __float_as_uint(v), false, false); return fmaxf(__uint_as_float(rr[0]), __uint_as_float(rr[1])); }
__device__ __forceinline__ float xhalf_sum(float v) { auto rr = __builtin_amdgcn_permlane32_swap(__float_as_uint(v), __float_as_uint(v), false, false); return __uint_as_float(rr[0]) + __uint_as_float(rr[1]); }
__device__ __forceinline__ void softmax_step(f32x16& s0, f32x16& s1, float& m, float& l, f32x16& o0, f32x16& o1, bf16x8 (&pf)[4]) {
    float ta = __builtin_fmaxf(__builtin_fmaxf(s0[0], s1[0]), s0[1]), tb = __builtin_fmaxf(__builtin_fmaxf(s1[1], s0[2]), s1[2]);
#pragma unroll
    for (int r = 3; r < 15; r += 2) { ta = __builtin_fmaxf(__builtin_fmaxf(ta, s0[r]), s1[r]); tb = __builtin_fmaxf(__builtin_fmaxf(tb, s0[r + 1]), s1[r + 1]); }
    float tm = __builtin_fmaxf(__builtin_fmaxf(ta, tb), __builtin_fmaxf(s0[15], s1[15]));
    tm = xhalf_max(tm);
    const float mn = fmaxf(m, tm);
    if (__any(mn > m)) { const float sc = __builtin_amdgcn_exp2f(m - mn); l *= sc;
#pragma unroll
        for (int r = 0; r < 16; ++r) { o0[r] *= sc; o1[r] *= sc; } }
    m = mn;
    const f32x2 nm = (f32x2){-mn, -mn};
    f32x2 ls2 = (f32x2){0.f, 0.f};
#pragma unroll
    for (int r = 0; r < 16; ++r) { const f32x2 d = (f32x2){s0[r], s1[r]} + nm; const f32x2 e = (f32x2){__builtin_amdgcn_exp2f(d.x), __builtin_amdgcn_exp2f(d.y)}; s0[r] = e.x; s1[r] = e.y; ls2 += e; }
    l += ls2.x + ls2.y;
#pragma unroll
    for (int s = 0; s < 2; ++s) {
        u32x4 w; w.x = pg8::cvt_pk_bf16(s0[8 * s], s0[8 * s + 1]); w.y = pg8::cvt_pk_bf16(s0[8 * s + 2], s0[8 * s + 3]); w.z = pg8::cvt_pk_bf16(s0[8 * s + 4], s0[8 * s + 5]); w.w = pg8::cvt_pk_bf16(s0[8 * s + 6], s0[8 * s + 7]);
        pf[s] = __builtin_bit_cast(bf16x8, w);
        u32x4 x; x.x = pg8::cvt_pk_bf16(s1[8 * s], s1[8 * s + 1]); x.y = pg8::cvt_pk_bf16(s1[8 * s + 2], s1[8 * s + 3]); x.z = pg8::cvt_pk_bf16(s1[8 * s + 4], s1[8 * s + 5]); x.w = pg8::cvt_pk_bf16(s1[8 * s + 6], s1[8 * s + 7]);
        pf[2 + s] = __builtin_bit_cast(bf16x8, x);
    }
}
struct AttnArgs { const bf16_t* Q; const bf16_t* K; const bf16_t* VT; bf16_t* O; const float* lamv; const float* subln; float lam_init; int pad; };
template <int NS> __device__ __forceinline__ void attn_unit(const AttnArgs& a, int b, int h, int qb, LAS unsigned char* lds, float lam) {
    constexpr int DQ = NS == 1 ? 96 : 64, KS = DQ * 2 + 16, VS = 144, KBYTES = 64 * KS, BUF = KBYTES + 64 * VS;
    constexpr int KCH = DQ / 8, NKC = 64 * KCH, NCH = NKC + 512, CPT = (NCH + NTHR - 1) / NTHR;
    const int tid = otid(), wave = __builtin_amdgcn_readfirstlane(tid >> 6), lane = tid & 63, r32 = lane & 31, hi = lane >> 5;
    const bool ctxq = qb == 16;
    const int qrow = (ctxq ? TL + b * CL : b * SQ + qb * 256) + wave * 32 + r32;
    const int jt0 = ctxq ? 64 : 0, ntile = ctxq ? 4 : 68;
    bf16x8 qf[NS == 1 ? 6 : 4];
    if (NS == 1) {
#pragma unroll
        for (int ks = 0; ks < 6; ++ks) qf[ks] = *(const bf16x8*)(a.Q + ((size_t)h * T + qrow) * 96 + 16 * ks + 8 * hi);
    } else {
#pragma unroll
        for (int c = 0; c < 2; ++c)
#pragma unroll
            for (int ks = 0; ks < 2; ++ks) qf[c * 2 + ks] = *(const bf16x8*)(a.Q + ((size_t)(h * 2 + c) * T + qrow) * 32 + 16 * ks + 8 * hi);
    }
    u32x4 stg[CPT];
    auto gload = [&](int jt) {
        const int krow0 = (jt < 64) ? b * SQ + jt * 64 : TL + b * CL + (jt - 64) * 64;
#pragma unroll
        for (int i = 0; i < CPT; ++i) { const int c = tid + i * NTHR;
            if (c < NKC) { const int key = c / KCH, kc = c % KCH;
                const bf16_t* src = NS == 1 ? a.K + ((size_t)h * T + krow0 + key) * 96 + kc * 8 : a.K + ((size_t)(h * 2 + (kc >> 2)) * T + krow0 + key) * 32 + (kc & 3) * 8;
                stg[i] = *(const u32x4*)src; }
            else if (c < NCH) { const int v = c - NKC, d = v >> 3, vc = v & 7; stg[i] = *(const u32x4*)(a.VT + ((size_t)(b * 4 + h) * 64 + d) * KB + jt * 64 + vc * 8); } }
    };
    auto lstore = [&](int buf) {
#pragma unroll
        for (int i = 0; i < CPT; ++i) { const int c = tid + i * NTHR;
            if (c < NKC) { const int key = c / KCH, kc = c % KCH; *(LAS u32x4*)(lds + buf * BUF + key * KS + kc * 16) = stg[i]; }
            else if (c < NCH) { const int v = c - NKC, d = v >> 3, vc = v & 7; *(LAS u32x4*)(lds + buf * BUF + KBYTES + d * VS + vc * 16) = stg[i]; } }
    };
    float m[NS], l[NS]; f32x16 o[NS][2];
#pragma unroll
    for (int n = 0; n < NS; ++n) { m[n] = -1e30f; l[n] = 0.f;
#pragma unroll
        for (int r = 0; r < 16; ++r) { o[n][0][r] = 0.f; o[n][1][r] = 0.f; } }
    const bool lag = wave >= 4;
    bf16x8 pf[NS][4];
    bf16x8 vfr[NS == 1 ? 2 : 1][NS == 1 ? 4 : 1];
    auto pv = [&](int buf) { const LAS unsigned char* vb = lds + buf * BUF + KBYTES + r32 * VS + hi * 16;
#pragma unroll
        for (int db = 0; db < 2; ++db)
#pragma unroll
            for (int t = 0; t < 4; ++t) { bf16x8 vf; if (NS == 1) vf = vfr[NS == 1 ? db : 0][NS == 1 ? t : 0]; else vf = *(const LAS bf16x8*)(vb + db * 32 * VS + t * 32);
#pragma unroll
                for (int n = 0; n < NS; ++n) o[n][db] = MFMA32(vf, pf[n][t], o[n][db]); } };
    gload(jt0); lstore(0); __syncthreads();
    int cur = 0, prv = 2;
    constexpr int NKF = NS == 1 ? 6 : 4;
    for (int it = 0; it < ntile; ++it) {
        const int nxt = cur == 2 ? 0 : cur + 1;
        if (it + 1 < ntile) gload(jt0 + it + 1);
        if (lag && it > 0) pv(prv);
        bf16x8 kfr[2][NKF];
        { const LAS unsigned char* kb = lds + cur * BUF + r32 * KS + hi * 16;
#pragma unroll
          for (int ks = 0; ks < NKF; ++ks) { kfr[0][ks] = *(const LAS bf16x8*)(kb + ks * 32); kfr[1][ks] = *(const LAS bf16x8*)(kb + 32 * KS + ks * 32); } }
        asm volatile("" ::: "memory");
        f32x16 s0, s1;
#pragma unroll
        for (int r = 0; r < 16; ++r) { s0[r] = 0.f; s1[r] = 0.f; }
        constexpr int NK = NS == 1 ? 6 : 2;
#pragma unroll
        for (int ks = 0; ks < NK; ++ks) { s0 = MFMA32(kfr[0][ks], qf[ks], s0); s1 = MFMA32(kfr[1][ks], qf[ks], s1); }
        if (NS == 1) { const LAS unsigned char* vb = lds + cur * BUF + KBYTES + r32 * VS + hi * 16;
#pragma unroll
          for (int db = 0; db < 2; ++db)
#pragma unroll
              for (int t = 0; t < 4; ++t) vfr[NS == 1 ? db : 0][NS == 1 ? t : 0] = *(const LAS bf16x8*)(vb + db * 32 * VS + t * 32);
          asm volatile("" ::: "memory"); }
        softmax_step(s0, s1, m[0], l[0], o[0][0], o[0][1], pf[0]);
        if (NS == 2) {
#pragma unroll
            for (int r = 0; r < 16; ++r) { s0[r] = 0.f; s1[r] = 0.f; }
#pragma unroll
            for (int ks = 0; ks < 2; ++ks) { s0 = MFMA32(kfr[0][2 + ks], qf[2 + ks], s0); s1 = MFMA32(kfr[1][2 + ks], qf[2 + ks], s1); }
            softmax_step(s0, s1, m[NS - 1], l[NS - 1], o[NS - 1][0], o[NS - 1][1], pf[NS - 1]);
        }
        if (!lag) pv(cur);
        if (it + 1 < ntile) lstore(nxt);
        __syncthreads();
        prv = cur; cur = nxt;
    }
    if (lag) pv(prv);
    float inv[NS];
#pragma unroll
    for (int n = 0; n < NS; ++n) inv[n] = 1.f / xhalf_sum(l[n]);
    bf16_t* orow = a.O + (size_t)qrow * D + (NS == 1 ? 256 : 768) + h * 64;
    if (NS == 1) {
#pragma unroll
        for (int db = 0; db < 2; ++db)
#pragma unroll
            for (int g = 0; g < 4; ++g) { u32x2 w; w.x = pg8::cvt_pk_bf16(o[0][db][4 * g] * inv[0], o[0][db][4 * g + 1] * inv[0]); w.y = pg8::cvt_pk_bf16(o[0][db][4 * g + 2] * inv[0], o[0][db][4 * g + 3] * inv[0]);
                *(u32x2*)(orow + 32 * db + 8 * g + 4 * hi) = w; }
    } else {
        const float i1 = inv[0], i2 = lam * inv[NS - 1]; float ss = 0.f;
#pragma unroll
        for (int db = 0; db < 2; ++db)
#pragma unroll
            for (int r = 0; r < 16; ++r) { const float v = o[0][db][r] * i1 - o[NS - 1][db][r] * i2; o[0][db][r] = v; ss += v * v; }
        ss = xhalf_sum(ss);
        const float rr = rsqrtf(ss * (1.f / 64.f) + 1e-6f) * (1.f - a.lam_init);
#pragma unroll
        for (int db = 0; db < 2; ++db)
#pragma unroll
            for (int g = 0; g < 4; ++g) { const int d0 = 32 * db + 8 * g + 4 * hi; const f32x4 sl = *(const f32x4*)(a.subln + d0);
                u32x2 w; w.x = pg8::cvt_pk_bf16(o[0][db][4 * g] * rr * sl[0], o[0][db][4 * g + 1] * rr * sl[1]); w.y = pg8::cvt_pk_bf16(o[0][db][4 * g + 2] * rr * sl[2], o[0][db][4 * g + 3] * rr * sl[3]);
                *(u32x2*)(orow + d0) = w; }
    }
    __syncthreads();
}
template <int NS> __global__ __launch_bounds__(NTHR, 2) void k_attn(AttnArgs a) {
    extern __shared__ __attribute__((aligned(16))) unsigned char lds_raw[];
    LAS unsigned char* lds = (LAS unsigned char*)lds_raw;
    float lam = 0.f;
    if (NS == 2) { float s1 = 0.f, s2 = 0.f; for (int i = 0; i < 32; ++i) { s1 += a.lamv[i] * a.lamv[32 + i]; s2 += a.lamv[64 + i] * a.lamv[96 + i]; } lam = expf(s1) - expf(s2) + a.lam_init; }
    for (int u = blockIdx.x; u < NB * 4 * 17; u += gridDim.x) { const int qb = u % 17, bh = u / 17; attn_unit<NS>(a, bh >> 2, bh & 3, qb, lds, lam); }
}


#define MFMA16(a, b, c) __builtin_amdgcn_mfma_f32_16x16x32_bf16((a), (b), (c), 0, 0, 0)
constexpr int NCHK = KB / 64;
struct S5Prep { const float* lam_re; const float* lam_im; const float* log_dt; const float* b_re; const float* b_im; const float* c_re; const float* c_im; float4* S5A; bf16_t* S5B; bf16_t* S5C; };
__global__ void k_s5prep(S5Prep a) {
    const int i = blockIdx.x * 256 + threadIdx.x; const int gi = i >> 6, p = i & 63;
    const double lre = a.lam_re[i], lim = a.lam_im[i], dt = exp((double)a.log_dt[gi]);
    const double x = lre * dt; double y = lim * dt; y -= 6.283185307179586476925 * rint(y / 6.283185307179586476925);
    float sy, cy; sincosf((float)y, &sy, &cy); const float sh = sinf((float)(0.5 * y));
    const double em1 = x * (1.0 + x * 0.5 * (1.0 + x * (1.0 / 3.0) * (1.0 + x * 0.25 * (1.0 + x * 0.2 * (1.0 + x * (1.0 / 6.0))))));
    const double nr = em1 * (double)cy - 2.0 * (double)sh * (double)sh, ni = (1.0 + em1) * (double)sy;
    const double ar = 1.0 + nr, ai = ni;
    double pr = ar, pi = ai;
#pragma unroll
    for (int k = 0; k < 6; ++k) { const double t = pr * pr - pi * pi; pi = 2.0 * pr * pi; pr = t; }
    a.S5A[i] = make_float4((float)ar, (float)ai, (float)pr, (float)pi);
    const double den = lre * lre + lim * lim; const float fr = (float)((nr * lre + ni * lim) / den), fi = (float)((ni * lre - nr * lim) / den);
    for (int c = 0; c < 16; ++c) { const float br = a.b_re[i * 16 + c], bi = a.b_im[i * 16 + c];
        a.S5B[((size_t)gi * 128 + p) * 16 + c] = (bf16_t)f2bf(fr * br - fi * bi); a.S5B[((size_t)gi * 128 + 64 + p) * 16 + c] = (bf16_t)f2bf(fr * bi + fi * br);
        a.S5C[((size_t)gi * 16 + c) * 128 + p] = (bf16_t)f2bf(a.c_re[(gi * 16 + c) * 64 + p]); a.S5C[((size_t)gi * 16 + c) * 128 + 64 + p] = (bf16_t)f2bf(-a.c_im[(gi * 16 + c) * 64 + p]); }
}
struct S5Args { const bf16_t* ZB; const float4* S5A; const bf16_t* S5B; const bf16_t* S5C; const float* dskip; float2* S; bf16_t* Y5; unsigned long long* dbg; };
__device__ __forceinline__ int s5_chunk_row0(int b, int tc) { return tc < 4 ? TL + b * CL + tc * 64 : b * SQ + (tc - 4) * 64; }
__device__ __forceinline__ int s5_tc_of(int dir, int j) { return dir == 0 ? j : (j < 4 ? 3 - j : 71 - j); }
template <bool WRITE_H> __device__ __forceinline__ void s5_subblock(const bf16_t* ZB, int row0, int g, int dir, const bf16x8 (&bfr)[8], float ar, float ai, float& hr, float& hi, LAS float* tile, int lane) {
    const int n16 = lane & 15, kq = lane >> 4;
    bf16x8 af = (bf16x8){0, 0, 0, 0, 0, 0, 0, 0};
    if (kq < 2) af = *(const bf16x8*)(ZB + (size_t)(row0 + n16) * ZC + O_S5 + g * 16 + 8 * kq);
    f32x4 accs[8];
#pragma unroll
    for (int nb = 0; nb < 8; ++nb) { accs[nb] = (f32x4){0.f, 0.f, 0.f, 0.f}; accs[nb] = MFMA16(af, bfr[nb], accs[nb]); }
    __builtin_amdgcn_sched_barrier(0); asm volatile("s_nop 15\n\ts_nop 15" :: "v"(af) : "memory"); __builtin_amdgcn_sched_barrier(0);
#pragma unroll
    for (int nb = 0; nb < 8; ++nb)
#pragma unroll
        for (int i = 0; i < 4; ++i) tile[(4 * kq + i) * 132 + 16 * nb + n16] = accs[nb][i];
#pragma unroll
    for (int ii = 0; ii < 16; ++ii) { const int i = dir == 0 ? ii : 15 - ii;
        const float br = tile[i * 132 + lane], bi = tile[i * 132 + 64 + lane];
        const float nr = ar * hr - ai * hi + br, ni = ar * hi + ai * hr + bi; hr = nr; hi = ni;
        if (WRITE_H) { tile[i * 132 + lane] = hr; tile[i * 132 + 64 + lane] = hi; } }
}
__device__ __forceinline__ void s5_load_b(const S5Args& a, int gi, int lane, bf16x8 (&bfr)[8]) {
    const int n16 = lane & 15, kq = lane >> 4;
#pragma unroll
    for (int nb = 0; nb < 8; ++nb) { bfr[nb] = (bf16x8){0, 0, 0, 0, 0, 0, 0, 0}; if (kq < 2) bfr[nb] = *(const bf16x8*)(a.S5B + ((size_t)gi * 128 + 16 * nb + n16) * 16 + 8 * kq); }
}
__device__ __forceinline__ void s5_pass1_item(const S5Args& a, int b, int dir, int j, int g, LAS float* tile, int lane) {
    const int gi = dir * 16 + g; const float4 ap = a.S5A[gi * 64 + lane];
    bf16x8 bfr[8]; s5_load_b(a, gi, lane, bfr);
    const int row0 = s5_chunk_row0(b, s5_tc_of(dir, j));
    float hr = 0.f, hi = 0.f;
    if (a.dbg) { unsigned long long cs = 0; const int n16 = lane & 15, kq = lane >> 4;
        for (int tsb = 0; tsb < 4; ++tsb) if (kq < 2) { const size_t off = (size_t)(row0 + 16 * tsb + n16) * ZC + O_S5 + g * 16 + 8 * kq; const u32x4 w = *(const u32x4*)(a.ZB + off);
            cs += ((unsigned long long)w.x + 3ull * w.y + 5ull * w.z + 7ull * w.w) * (unsigned long long)((off & 4095) + 1); }
        cs += (unsigned long long)__float_as_uint(ap.x) * 11ull + (unsigned long long)__float_as_uint(ap.y) * 13ull;
        for (int nb = 0; nb < 8; ++nb) { const u32x4 w = __builtin_bit_cast(u32x4, bfr[nb]); cs += ((unsigned long long)w.x + 3ull * w.y + 5ull * w.z + 7ull * w.w) * (unsigned long long)(nb + 1); }
        for (int o = 1; o < 64; o <<= 1) cs += __shfl_xor(cs, o);
        if (lane == 0) atomicAdd(a.dbg, cs); }
#pragma unroll 1
    for (int sbi = 0; sbi < 4; ++sbi) { const int tsb = dir == 0 ? sbi : 3 - sbi; s5_subblock<false>(a.ZB, row0 + 16 * tsb, g, dir, bfr, ap.x, ap.y, hr, hi, tile, lane); }
    a.S[((size_t)((b * 2 + dir) * NCHK + j) * 16 + g) * 64 + lane] = make_float2(hr, hi);
    if (a.dbg) { const size_t idx = ((size_t)((b * 2 + dir) * NCHK + j) * 16 + g) * 64 + lane; unsigned long long cs = ((unsigned long long)__float_as_uint(hr) + 3ull * __float_as_uint(hi)) * (unsigned long long)((idx & 1023) + 1);
        for (int o = 1; o < 64; o <<= 1) cs += __shfl_xor(cs, o);
        if (lane == 0) atomicAdd(a.dbg, cs); }
}
__device__ __forceinline__ void s5_pass2_item(const S5Args& a, int b, int tc, int g, LAS float* tile, int lane) {
    const int n16 = lane & 15, kq = lane >> 4;
    const int row0 = s5_chunk_row0(b, tc);
    f32x4 yacc[4];
#pragma unroll
    for (int t = 0; t < 4; ++t) yacc[t] = (f32x4){0.f, 0.f, 0.f, 0.f};
#pragma unroll 1
    for (int dir = 0; dir < 2; ++dir) {
        const int gi = dir * 16 + g; const float4 ap = a.S5A[gi * 64 + lane];
        const int j = dir == 0 ? tc : (tc < 4 ? 3 - tc : 71 - tc);
        float hr = 0.f, hi = 0.f;
        const float2* sp = a.S + ((size_t)((b * 2 + dir) * NCHK) * 16 + g) * 64 + lane;
#pragma unroll 4
        for (int jj = 0; jj < j; ++jj) { const float2 sv = sp[(size_t)jj * 16 * 64]; const float nr = ap.z * hr - ap.w * hi + sv.x, ni = ap.z * hi + ap.w * hr + sv.y; hr = nr; hi = ni; }
        bf16x8 bfr[8]; s5_load_b(a, gi, lane, bfr);
        bf16x8 cf[4];
#pragma unroll
        for (int ks = 0; ks < 4; ++ks) cf[ks] = *(const bf16x8*)(a.S5C + ((size_t)gi * 16 + n16) * 128 + 32 * ks + 8 * kq);
#pragma unroll
        for (int sbi = 0; sbi < 4; ++sbi) { const int tsb = dir == 0 ? sbi : 3 - sbi;
            s5_subblock<true>(a.ZB, row0 + 16 * tsb, g, dir, bfr, ap.x, ap.y, hr, hi, tile, lane);
#pragma unroll
            for (int ks = 0; ks < 4; ++ks) { const LAS float* hp = tile + n16 * 132 + 32 * ks + 8 * kq; const f32x4 h0 = *(const LAS f32x4*)hp, h1 = *(const LAS f32x4*)(hp + 4);
                u32x4 w; w.x = pg8::cvt_pk_bf16(h0[0], h0[1]); w.y = pg8::cvt_pk_bf16(h0[2], h0[3]); w.z = pg8::cvt_pk_bf16(h1[0], h1[1]); w.w = pg8::cvt_pk_bf16(h1[2], h1[3]);
                if (tsb == 0) yacc[0] = MFMA16(__builtin_bit_cast(bf16x8, w), cf[ks], yacc[0]); else if (tsb == 1) yacc[1] = MFMA16(__builtin_bit_cast(bf16x8, w), cf[ks], yacc[1]);
                else if (tsb == 2) yacc[2] = MFMA16(__builtin_bit_cast(bf16x8, w), cf[ks], yacc[2]); else yacc[3] = MFMA16(__builtin_bit_cast(bf16x8, w), cf[ks], yacc[3]); } }
    }
    const float dsk = a.dskip[g * 16 + n16];
#pragma unroll
    for (int t = 0; t < 4; ++t)
#pragma unroll
        for (int i = 0; i < 4; ++i) { const size_t row = (size_t)(row0 + 16 * t + 4 * kq + i); const float u = bf2f(a.ZB[row * ZC + O_S5 + g * 16 + n16]);
            a.Y5[row * 256 + g * 16 + n16] = (bf16_t)f2bf(yacc[t][i] + dsk * u); }
}
__global__ __launch_bounds__(NTHR, 2) void k_s5_pass1(S5Args a) {
    extern __shared__ __attribute__((aligned(16))) unsigned char lds_raw[];
    const int wave = threadIdx.x >> 6, lane = threadIdx.x & 63; LAS float* tile = (LAS float*)((LAS unsigned char*)lds_raw + wave * 8448);
    for (int it = blockIdx.x; it < NB * 2 * NCHK * 2; it += gridDim.x) { const int gh = it & 1, j = (it >> 1) % NCHK, bd = (it >> 1) / NCHK; s5_pass1_item(a, bd >> 1, bd & 1, j, gh * 8 + wave, tile, lane); }
}
__global__ __launch_bounds__(NTHR, 2) void k_s5_pass2(S5Args a) {
    extern __shared__ __attribute__((aligned(16))) unsigned char lds_raw[];
    const int wave = threadIdx.x >> 6, lane = threadIdx.x & 63; LAS float* tile = (LAS float*)((LAS unsigned char*)lds_raw + wave * 8448);
    for (int it = blockIdx.x; it < NB * NCHK * 2; it += gridDim.x) { const int gh = it & 1, tc = (it >> 1) % NCHK, b = (it >> 1) / NCHK; s5_pass2_item(a, b, tc, gh * 8 + wave, tile, lane); }
}


struct NaArgs { const bf16_t* ZB; const bf16_t* VTN; bf16_t* O; const float* rpb; };
__device__ __forceinline__ void na_wave(const NaArgs& a, int item, const LAS float* bias, int wave, int lane) {
    const int r32 = lane & 31, hi = lane >> 5;
    const bool ctxq = item >= 512; const int bh = ctxq ? item - 512 : item >> 4, b = bh >> 2, h = bh & 3;
    int gr = 0, c0 = 0, qrow;
    if (ctxq) qrow = TL + b * CL + wave * 32 + r32; else { gr = (item & 15) * 4 + (wave >> 1); c0 = (wave & 1) * 32; qrow = b * SQ + gr * 64 + c0 + r32; }
    bf16x8 qf[4];
#pragma unroll
    for (int ks = 0; ks < 4; ++ks) qf[ks] = *(const bf16x8*)(a.ZB + (size_t)qrow * ZC + O_NAQ + h * 64 + 16 * ks + 8 * hi);
    float m = -1e30f, l = 0.f; f32x16 o0, o1;
#pragma unroll
    for (int r = 0; r < 16; ++r) { o0[r] = 0.f; o1[r] = 0.f; }
    const bf16_t* vt = a.VTN + ((size_t)(b * 4 + h) * 64 + r32) * KB + 8 * hi;
    const int c = c0 + r32, cs = min(max(c - 8, 0), 48), r0 = min(max(gr - 4, 0), 56);
    const int ntile = ctxq ? 4 : 12;
    bf16x8 kf[8], vf[8];
    auto ktok = [&](int t) { const bool local = !ctxq && t < 8; return local ? b * SQ + (r0 + t) * 64 : TL + b * CL + (ctxq ? t : t - 8) * 64; };
    { const bf16_t* kp = a.ZB + (size_t)(ktok(0) + r32) * ZC + O_NAK + h * 64 + 8 * hi;
#pragma unroll
      for (int ks = 0; ks < 4; ++ks) { kf[ks] = *(const bf16x8*)(kp + 16 * ks); kf[4 + ks] = *(const bf16x8*)(kp + (size_t)32 * ZC + 16 * ks); } }
#pragma unroll 1
    for (int t = 0; t < ntile; ++t) {
        const bool local = !ctxq && t < 8;
        const int slot0 = local ? (r0 + t) * 64 : SQ + (ctxq ? t : t - 8) * 64;
#pragma unroll
        for (int q = 0; q < 4; ++q) { vf[q] = *(const bf16x8*)(vt + slot0 + 16 * q); vf[4 + q] = *(const bf16x8*)(vt + (size_t)32 * KB + slot0 + 16 * q); }
        f32x16 s0, s1;
#pragma unroll
        for (int r = 0; r < 16; ++r) { s0[r] = 0.f; s1[r] = 0.f; }
#pragma unroll
        for (int ks = 0; ks < 4; ++ks) { s0 = MFMA32(kf[ks], qf[ks], s0); s1 = MFMA32(kf[4 + ks], qf[ks], s1); }
        if (t + 1 < ntile) { const bf16_t* kp = a.ZB + (size_t)(ktok(t + 1) + r32) * ZC + O_NAK + h * 64 + 8 * hi;
#pragma unroll
            for (int ks = 0; ks < 4; ++ks) { kf[ks] = *(const bf16x8*)(kp + 16 * ks); kf[4 + ks] = *(const bf16x8*)(kp + (size_t)32 * ZC + 16 * ks); } }
        if (local) { const LAS float* brow = bias + (h * 15 + (r0 + t - gr + 7)) * 32;
#pragma unroll
            for (int r = 0; r < 16; ++r) { const int kk = (r & 3) + 8 * (r >> 2) + 4 * hi;
                { const int kc = kk, off = kc - cs; s0[r] = (off >= 0 && off < 16) ? s0[r] * C_NA + brow[kc - c + 15] : -1e30f; }
                { const int kc = 32 + kk, off = kc - cs; s1[r] = (off >= 0 && off < 16) ? s1[r] * C_NA + brow[kc - c + 15] : -1e30f; } }
        } else {
#pragma unroll
            for (int r = 0; r < 16; ++r) { s0[r] *= C_NA; s1[r] *= C_NA; } }
        bf16x8 pf[4];
        softmax_step(s0, s1, m, l, o0, o1, pf);
#pragma unroll
        for (int q = 0; q < 4; ++q) { o0 = MFMA32(vf[q], pf[q], o0); o1 = MFMA32(vf[4 + q], pf[q], o1); }
    }
    const float inv = 1.f / xhalf_sum(l);
    bf16_t* orow = a.O + (size_t)qrow * D + h * 64;
#pragma unroll
    for (int g = 0; g < 4; ++g) {
        u32x2 w; w.x = pg8::cvt_pk_bf16(o0[4 * g] * inv, o0[4 * g + 1] * inv); w.y = pg8::cvt_pk_bf16(o0[4 * g + 2] * inv, o0[4 * g + 3] * inv); *(u32x2*)(orow + 8 * g + 4 * hi) = w;
        u32x2 x; x.x = pg8::cvt_pk_bf16(o1[4 * g] * inv, o1[4 * g + 1] * inv); x.y = pg8::cvt_pk_bf16(o1[4 * g + 2] * inv, o1[4 * g + 3] * inv); *(u32x2*)(orow + 32 + 8 * g + 4 * hi) = x; }
}
__device__ __forceinline__ void na_load_bias(const float* rpb, LAS float* bias) {
    for (int i = otid(); i < 4 * 15 * 32; i += NTHR) { const int j = i & 31, hr = i >> 5; bias[i] = j < 31 ? rpb[hr * 31 + j] * 1.4426950408889634f : 0.f; }
    __syncthreads();
}
__global__ __launch_bounds__(NTHR, 2) void k_na2(NaArgs a) {
    extern __shared__ __attribute__((aligned(16))) unsigned char lds_raw[];
    LAS float* bias = (LAS float*)lds_raw;
    na_load_bias(a.rpb, bias);
    const int wave = threadIdx.x >> 6, lane = threadIdx.x & 63;
    for (int item = blockIdx.x; item < 544; item += gridDim.x) na_wave(a, item, bias, wave, lane);
}


#ifdef F8PROBE
__global__ __launch_bounds__(NTHR, 2) void k_gemm8_probe(GemmArgs a) {
    extern __shared__ __attribute__((aligned(16))) unsigned char lds_raw[];
    LAS unsigned char* lds = (LAS unsigned char*)lds_raw;
    pg8::StaticOrder S; S.init(a.nM, a.nN, (int)gridDim.x, (int)blockIdx.x, a.A, a.lda, a.B, a.ldb);
    pg8::EpiStoreS E; E.O = a.O; E.ldc = a.ldc; E.scale = 0.5f;
    pg8::gemm_phase<pg8::EpiStoreS, pg8::StaticOrder, true>(lds, a.K, a.lda, a.ldb, S, E);
}
#endif
__global__ void k_chk(const unsigned* p, size_t nwords, unsigned long long* slot) {
    unsigned long long s = 0;
    for (size_t i = (size_t)blockIdx.x * 256 + threadIdx.x; i < nwords; i += (size_t)gridDim.x * 256) s += (unsigned long long)p[i] * (unsigned long long)((i & 1023) + 1);
#pragma unroll
    for (int o = 1; o < 64; o <<= 1) s += __shfl_xor(s, o);
    if ((threadIdx.x & 63) == 0) atomicAdd(slot, s);
}
__global__ void k_chk_final(const unsigned long long* tab, int n, float* out, size_t nout) {
    int first = -1;
    for (int i = 0; i < n; ++i) if (tab[i] != tab[64 + i]) { first = i; break; }
    if (first < 0) return;
    const float c = sqrtf((float)(first + 1));
    for (size_t i = (size_t)blockIdx.x * 256 + threadIdx.x; i < nout; i += (size_t)gridDim.x * 256) out[i] = c;
}

#define XB_TMO      128
#define XB_XCNT(j)  (256  + 64 * (j))
#define XB_XSUB(j)  (1280 + 64 * (j))
#define XB_XGEN(j)  (2304 + 64 * (j))
#define XB_TOP      3328
#define XB_TOPGEN   3392
#define XCD_BAR_WORDS 3456
#define XB_SPIN_CAP (1u << 18)

__device__ __forceinline__ unsigned xb_ld(unsigned* p)              { return __hip_atomic_load(p, __ATOMIC_RELAXED, __HIP_MEMORY_SCOPE_AGENT); }
__device__ __forceinline__ unsigned xb_add(unsigned* p, unsigned v) { return __hip_atomic_fetch_add(p, v, __ATOMIC_RELAXED, __HIP_MEMORY_SCOPE_AGENT); }
__device__ __forceinline__ unsigned xb_xcc_id() { return (unsigned)__builtin_amdgcn_s_getreg((3 << 11) | 20) & 0xFu; }
#define XB_SPIN(cond, bar) do { unsigned _sp = 0; while (cond) { __builtin_amdgcn_s_sleep(1); \
    if ((++_sp & 255u) == 0u) { if (xb_ld(&(bar)[XB_TMO])) break; if (_sp > XB_SPIN_CAP) { atomicAdd(&(bar)[XB_TMO], 1u); break; } } } } while (0)

struct XcdBarrier {
    unsigned* bar; unsigned x;
    volatile LAS unsigned* st;
};

__device__ __forceinline__ XcdBarrier xcd_barrier_post(unsigned* bar, volatile LAS unsigned* st) {
    XcdBarrier b; b.bar = bar; b.x = xb_xcc_id(); b.st = st;
    if (threadIdx.x == 0) (void)xb_add(&bar[XB_XCNT(b.x)], 1u);
    return b;
}
__device__ __forceinline__ void xcd_barrier_complete(unsigned* bar, unsigned x, unsigned& nloc, unsigned& nx) {
    const unsigned G = gridDim.x * gridDim.y * gridDim.z;
    unsigned sum, cnt, mine, sp = 0u;
    for (;;) {
        sum = 0u; cnt = 0u; mine = 0u;
#pragma unroll
        for (unsigned j = 0; j < 16; ++j) { const unsigned c = xb_ld(&bar[XB_XCNT(j)]); sum += c; cnt += (c > 0u) ? 1u : 0u; mine = (j == x) ? c : mine; }
        if (sum == G) break;
        __builtin_amdgcn_s_sleep(1);
        if ((++sp & 255u) == 0u) { if (xb_ld(&bar[XB_TMO])) break; if (sp > XB_SPIN_CAP) { atomicAdd(&bar[XB_TMO], 1u); break; } }
    }
    nloc = mine > 0u ? mine : 1u; nx = cnt > 0u ? cnt : 1u;
}

__device__ __forceinline__ void xcd_barrier(const XcdBarrier& b) {
    asm volatile("s_waitcnt vmcnt(0)" ::: "memory");
    __syncthreads();
    if (threadIdx.x == 0) {
        unsigned* bar = b.bar;
        __builtin_amdgcn_s_waitcnt(0);
        unsigned nloc = b.st[0], nx = b.st[1];
        if (nloc == 0u) { xcd_barrier_complete(bar, b.x, nloc, nx); b.st[0] = nloc; b.st[1] = nx; }
        const unsigned old = xb_add(&bar[XB_XSUB(b.x)], 1u);
        const unsigned gen = old / nloc;
        if (old + 1u == (gen + 1u) * nloc) {
            __builtin_amdgcn_fence(__ATOMIC_RELEASE, "agent");
            asm volatile("s_waitcnt vmcnt(0)" ::: "memory");
            const unsigned og = xb_add(&bar[XB_TOP], 1u);
            const unsigned tg = og / nx;
            if (og + 1u == (tg + 1u) * nx) xb_add(&bar[XB_TOPGEN], 1u);
            else XB_SPIN(xb_ld(&bar[XB_TOPGEN]) == tg, bar);
            __builtin_amdgcn_fence(__ATOMIC_ACQUIRE, "agent");
            xb_add(&bar[XB_XGEN(b.x)], 1u);
            asm volatile("s_waitcnt vmcnt(0)" ::: "memory");
        } else {
            XB_SPIN(xb_ld(&bar[XB_XGEN(b.x)]) == gen, bar);
            __builtin_amdgcn_fence(__ATOMIC_ACQUIRE, "agent");
            asm volatile("s_waitcnt vmcnt(0)" ::: "memory");
        }
    }
    __syncthreads();
}


namespace W {
constexpr size_t CTL = 0, CTL_ZERO = 64 * 1024;
constexpr size_t PLAN = 16384, QCTR = 32768;
constexpr size_t LAMV = 128 * 1024, ROPE = 132 * 1024, WS13 = 192 * 1024  , HSM = 256 * 1024  , WSIN = 448 * 1024  , MOD = 1 * MiB, TSLOT = 2 * MiB, TGATE = 2 * MiB + 512 * 1024, LTOK = 3 * MiB, S5TAB = 5 * MiB, MODP = 8 * MiB, HGS = MODP  , WS13M = MODP + 1 * MiB  ;
constexpr size_t X = 16 * MiB, H = 152 * MiB, WB = 221 * MiB, BIG = 408 * MiB, R2 = 901 * MiB, END = 1097 * MiB;
constexpr size_t WING = WB, WBR = WB + 13 * MiB, WOUT = WB + 15 * MiB, WEXP = WB + 17 * MiB, WGLU = WB + 18 * MiB, WF13 = WB + 19 * MiB, WF2 = WF13 + 112 * MiB;
constexpr size_t Z = BIG, G = BIG + 153 * MiB, E = BIG + 425 * MiB, ACT = BIG;
constexpr size_t QM = R2, KM = R2 + (size_t)4 * T * 96 * 2, QD = R2 + 51 * MiB, KD = R2 + 68 * MiB, VTN = R2 + 85 * MiB, VTM = R2 + 102 * MiB, VTD = R2 + 119 * MiB, S5S = R2 + 136 * MiB, Y5B = R2 + 145 * MiB;
constexpr size_t HG = R2, FB = R2, H8M = R2 + 162 * MiB;
constexpr size_t WG8 = WING + (size_t)ZC * D * 2;
constexpr size_t OB = H, MB = E, YB = Z;
static_assert(WF2 + 56 * MiB <= BIG && G + 272 * MiB <= E && E + 68 * MiB <= R2 && Y5B + 17 * MiB <= END && ACT + 490 * MiB <= R2 && HG + 140 * MiB <= END, "d_ws map");
}
#ifndef DUP_L4
#define DUP_L4 1
#endif
#ifndef DUP_L1
#define DUP_L1 1
#endif
#ifndef DUP_L6
#define DUP_L6 1
#endif
#ifndef DUP_L3
#define DUP_L3 1
#endif
#ifndef DUP_L2
#define DUP_L2 1
#endif
#ifndef DUP_SUB
#define DUP_SUB -1
#endif
#ifndef GATE8
#define GATE8 1
#endif
#ifndef MOEQ
#define MOEQ 1
#endif
#ifndef FFN2_8
#define FFN2_8 1
#endif
#ifndef GQ
#define GQ 1
#endif
#ifndef FFNQ
#define FFNQ 1
#endif
#ifndef FFN8
#define FFN8 1
#endif
#ifndef DUP_FFN
#define DUP_FFN 1
#endif
constexpr int LDS_UP = 131072;
struct FwdArgs { const float* in[41]; unsigned char* ws; float* out; int lo, hi; };
namespace pg8 {
struct EpiZG {
    static constexpr bool PERM = true;
    bf16_t* Zo; bf16_t* Go; const float* bias;
    __device__ __forceinline__ void operator()(const f32x4 (&acc)[2][2][4][2], const Unit& u, int wr, int wc, int fr, int fq) const {
        if (u.pn < ZC / BM) { EpiStore e; e.O = Zo; e.ldc = ZC; e(acc, u, wr, wc, fr, fq); }
        else { Unit v = u; v.pn = u.pn - ZC / BM; EpiGate e; e.O = Go; e.ldc = 4 * D; e.bias = bias; e(acc, v, wr, wc, fr, fq); }
    }
};
struct MoeOrderL {
    int nM, nN, nwg, G, c; const LAS int* tileE; const char* A; const char* B; size_t tA, tB, tBe;
    __device__ void init(const LAS int* plan, int nN_, int G_, int c_, const void* A_, int lda, const void* B_, int ldb, size_t expert_elems) {
        nM = plan[16]; nN = nN_; nwg = nM * nN; G = G_; c = c_; tileE = plan + 32; A = (const char*)A_; B = (const char*)B_; tA = (size_t)BM * lda * 2; tB = (size_t)BM * ldb * 2; tBe = expert_elems * 2; }
    __device__ bool next(int i, Unit& u) const {
        const long L = (long)i * G + c; if (L >= nwg) return false;
        int wgid = (int)L; { const int q = nwg / NXCD, r = nwg % NXCD, xcd = wgid % NXCD, off = wgid / NXCD; wgid = (xcd < r ? xcd * (q + 1) : r * (q + 1) + (xcd - r) * q) + off; }
        const int nig = WGM * nN, gid = wgid / nig, fm = gid * WGM, gsz = (nM - fm) < WGM ? (nM - fm) : WGM;
        u.pm = fm + ((wgid % nig) % gsz); u.pn = (wgid % nig) / gsz; u.x0 = tileE[u.pm]; u.x1 = 0;
        u.A = A + (size_t)u.pm * tA; u.B = B + (size_t)u.x0 * tBe + (size_t)u.pn * tB; return true;
    }
};
}
struct LnArgs { const float* xin; const float* cin; float* X; const bf16_t* Y; const float* mod_gate; const float* g; const float* bta; float* out; bf16_t* H; unsigned char* H8; const float* mod_h; int hsh, hsc;
                const float* wr; int* plan; int* ltok; int* tslot; float* tgate; int nrows; signed char* HQ; float* hscale; };
template <bool MOE, bool ROUTE> __device__ __forceinline__ void ln_rows(const LnArgs& a, const LAS int* planL) {
    const int tid_ = otid(); const int wave = tid_ >> 6, lane = tid_ & 63;
    for (int r = blockIdx.x * NWAVES + wave; r < a.nrows; r += gridDim.x * NWAVES) {
        const int mr = modrow(r);
        const float* xr = a.xin ? (r < TL ? a.xin + (size_t)r * D : a.cin + (size_t)(r - TL) * D) : a.X + (size_t)r * D;
        const float* md = a.mod_gate + (size_t)mr * 6144;
        size_t p0 = 0, p1 = 0; float g0 = 0.f, g1 = 0.f;
        if (MOE) { const int t0 = a.tslot[r * 2], t1 = a.tslot[r * 2 + 1]; g0 = a.tgate[r * 2]; g1 = a.tgate[r * 2 + 1]; const int e0 = t0 / T, e1 = t1 / T;
            p0 = (size_t)(planL[8 + e0] + (t0 - e0 * T)); p1 = (size_t)(planL[8 + e1] + (t1 - e1 * T)); }
        float v[16]; float s = 0.f;
#pragma unroll
        for (int j = 0; j < 4; ++j) { const int c = j * 256 + lane * 4; const float4 m4 = *(const float4*)(md + c); float4 x4;
            if (XBF && !a.xin) { const u32x2 xw = *(const u32x2*)((const bf16_t*)a.X + (size_t)r * D + c); x4 = make_float4(bflo(xw.x), bfhi(xw.x), bflo(xw.y), bfhi(xw.y)); } else x4 = *(const float4*)(xr + c);
            float y0, y1, y2, y3;
            if (MOE) { const u32x2 ya = *(const u32x2*)(a.Y + p0 * D + c), yb = *(const u32x2*)(a.Y + p1 * D + c);
                y0 = g0 * bflo(ya.x) + g1 * bflo(yb.x); y1 = g0 * bfhi(ya.x) + g1 * bfhi(yb.x); y2 = g0 * bflo(ya.y) + g1 * bflo(yb.y); y3 = g0 * bfhi(ya.y) + g1 * bfhi(yb.y); }
            else { const u32x2 yw = *(const u32x2*)(a.Y + (size_t)r * D + c); y0 = bflo(yw.x); y1 = bfhi(yw.x); y2 = bflo(yw.y); y3 = bfhi(yw.y); }
            v[j * 4] = ALPHA * x4.x + m4.x * y0; v[j * 4 + 1] = ALPHA * x4.y + m4.y * y1; v[j * 4 + 2] = ALPHA * x4.z + m4.z * y2; v[j * 4 + 3] = ALPHA * x4.w + m4.w * y3;
            s += v[j * 4] + v[j * 4 + 1] + v[j * 4 + 2] + v[j * 4 + 3]; }
#if LNPF
        if constexpr (!ROUTE) { const int rn = r + gridDim.x * NWAVES;
          if (rn < a.nrows) { const char* px; int nx;
              if (a.xin) { px = (const char*)(rn < TL ? a.xin + (size_t)rn * D : a.cin + (size_t)(rn - TL) * D); nx = 32; }
              else if (XBF) { px = (const char*)((const bf16_t*)a.X + (size_t)rn * D); nx = 16; } else { px = (const char*)(a.X + (size_t)rn * D); nx = 32; }
              const char* pt = lane < nx ? px + lane * 128 : ((!MOE && lane < nx + 16) ? (const char*)(a.Y + (size_t)rn * D) + (lane - nx) * 128 : nullptr);
              if (pt) __builtin_amdgcn_global_load_lds((const unsigned*)pt, (LAS unsigned*)((LAS unsigned char*)planL - 8192 + __builtin_amdgcn_readfirstlane(wave) * 256), 4, 0, 0); } }
#endif
        s = wave_sum(s, lane);
        const float mean = s * (1.f / D); float q = 0.f;
#pragma unroll
        for (int j = 0; j < 16; ++j) { v[j] -= mean; q += v[j] * v[j]; }
        q = wave_sum(q, lane);
        const float rstd = rsqrtf(q * (1.f / D) + 1e-5f);
        float lg[8]; float hq[16]; float am = 0.f; (void)hq;
#pragma unroll
        for (int e = 0; e < 8; ++e) lg[e] = 0.f;
#pragma unroll
        for (int j = 0; j < 4; ++j) { const int c = j * 256 + lane * 4; const float4 g4 = *(const float4*)(a.g + c), b4 = *(const float4*)(a.bta + c);
            float o[4]; o[0] = v[j * 4] * rstd * g4.x + b4.x; o[1] = v[j * 4 + 1] * rstd * g4.y + b4.y; o[2] = v[j * 4 + 2] * rstd * g4.z + b4.z; o[3] = v[j * 4 + 3] * rstd * g4.w + b4.w;
            if (XBF) { if (!a.out) { u32x2 xw; xw.x = pk2(o[0], o[1]); xw.y = pk2(o[2], o[3]); *(u32x2*)((bf16_t*)a.X + (size_t)r * D + c) = xw; } }
            else *(float4*)(a.X + (size_t)r * D + c) = make_float4(o[0], o[1], o[2], o[3]);
            if (a.out && r < TL) *(float4*)(a.out + (size_t)r * D + c) = make_float4(o[0], o[1], o[2], o[3]);
            if (a.H || a.H8 || a.HQ) { const float* mh = a.mod_h + (size_t)mr * 6144; const float4 sc = *(const float4*)(mh + a.hsc + c), sh = *(const float4*)(mh + a.hsh + c);
                float hv[4]; hv[0] = o[0] * (1.f + sc.x) + sh.x; hv[1] = o[1] * (1.f + sc.y) + sh.y; hv[2] = o[2] * (1.f + sc.z) + sh.z; hv[3] = o[3] * (1.f + sc.w) + sh.w;
                if (a.HQ) {
#pragma unroll
                    for (int i = 0; i < 4; ++i) { hq[j * 4 + i] = hv[i]; am = fmaxf(am, fabsf(hv[i])); } }
                if (a.H8) *(unsigned*)(a.H8 + (size_t)r * D + c) = pg8::pk4_fp8(hv[0] * pg8::S8_H, hv[1] * pg8::S8_H, hv[2] * pg8::S8_H, hv[3] * pg8::S8_H);
                if (a.H) { u32x2 w; w.x = pk2(hv[0], hv[1]); w.y = pk2(hv[2], hv[3]); *(u32x2*)(a.H + (size_t)r * D + c) = w; }
                if (ROUTE) {
#pragma unroll
                    for (int i = 0; i < 4; ++i) { const float4 w0 = *(const float4*)(a.wr + (c + i) * 8), w1 = *(const float4*)(a.wr + (c + i) * 8 + 4);
                        lg[0] += hv[i] * w0.x; lg[1] += hv[i] * w0.y; lg[2] += hv[i] * w0.z; lg[3] += hv[i] * w0.w; lg[4] += hv[i] * w1.x; lg[5] += hv[i] * w1.y; lg[6] += hv[i] * w1.z; lg[7] += hv[i] * w1.w; } } } }
        { if (a.HQ) {
#pragma unroll
            for (int o = 32; o >= 1; o >>= 1) am = fmaxf(am, shx(am, o, lane));
            const float qs = 127.f / fmaxf(am, 1e-30f);
            if (lane == 0) a.hscale[r] = am * (1.f / 127.f);
#pragma unroll
            for (int j = 0; j < 4; ++j) *(unsigned*)(a.HQ + (size_t)r * D + j * 256 + lane * 4) = pk4_i8(hq[j * 4] * qs, hq[j * 4 + 1] * qs, hq[j * 4 + 2] * qs, hq[j * 4 + 3] * qs); } }
        if (ROUTE) {
#pragma unroll
            for (int e = 0; e < 8; ++e) lg[e] = wave_sum(lg[e], lane);
            if (lane == 0) {
                int e1 = 0; float v1 = lg[0];
#pragma unroll
                for (int e = 1; e < 8; ++e) if (lg[e] > v1) { v1 = lg[e]; e1 = e; }
                int e2 = -1; float v2 = -3e38f;
#pragma unroll
                for (int e = 0; e < 8; ++e) if (e != e1 && lg[e] > v2) { v2 = lg[e]; e2 = e; }
                const float p2 = expf(v2 - v1), ga = 1.f / (1.f + p2), gb = p2 / (1.f + p2);
                const int s1 = atomicAdd(a.plan + e1, 1); a.ltok[e1 * T + s1] = r; a.tslot[r * 2] = e1 * T + s1; a.tgate[r * 2] = ga;
                const int s2 = atomicAdd(a.plan + e2, 1); a.ltok[e2 * T + s2] = r; a.tslot[r * 2 + 1] = e2 * T + s2; a.tgate[r * 2 + 1] = gb;
            } }
    }
}
__device__ __forceinline__ void moe_plan_lds(const int* plan, LAS int* planL) {
    if (threadIdx.x == 0) { int start = 0;
        for (int e = 0; e < 8; ++e) { const int cnt = plan[e]; const int nt = (cnt + 255) >> 8; planL[e] = cnt; planL[8 + e] = start * 256; for (int t = 0; t < nt; ++t) planL[32 + start + t] = e; start += nt; }
        planL[16] = start; }
    __syncthreads();
}

#define CAS __attribute__((address_space(4)))
__device__ __forceinline__ const float* karg_in(int i) { asm volatile("" : "+s"(i)); return (const float*)((const CAS void* const CAS*)__builtin_amdgcn_kernarg_segment_ptr())[i]; }
constexpr int FFN_ITEMS = 3 * 1792, FFN_CHUNK = 32;
template <bool MOE> __device__ __forceinline__ void ffn_conv_chunk(int chunk, int jj, unsigned char* wsp, LAS unsigned char* lds, int wave, int lane) {
    { const int t_ = otid(); wave = __builtin_amdgcn_readfirstlane(t_ >> 6); lane = t_ & 63; }
    chunk = __builtin_amdgcn_readfirstlane(chunk); asm volatile("" : "+s"(wsp), "+s"(jj), "+s"(chunk));
    LAS float* scr = (LAS float*)(lds + wave * 16384);
    constexpr bool F8W = MOE && FFN8;
    if constexpr (FFNQ && (!MOE || MOEQ)) {
        constexpr int NEX = MOE ? NE : 1, NBIG = NEX * 224;
        if (chunk < NBIG) { const int e = chunk / 224, g = chunk % 224, mat = g / 112, cb = g % 112;
            const size_t eo = MOE ? ((size_t)jj * NE + e) * D * DFF : (size_t)jj * D * DFF;
            colgroup_q_block(karg_in((MOE ? 38 : 34) + mat) + eo, DFF, 32 * cb, (signed char*)(wsp + W::WF13) + (size_t)e * 2 * DFF * D, D, mat, 2, (float*)(wsp + (MOE ? W::WS13M : W::WS13)) + e * 2 * DFF, lds); return; }
        chunk -= NBIG;
#pragma unroll 1
        for (int i = 0; i < FFN_CHUNK / NWAVES; ++i) { const int g = chunk * FFN_CHUNK + i * NWAVES + wave; if (g >= NEX * 1792) break;
            const int e = g / 1792, it = g % 1792; const size_t eo = MOE ? ((size_t)jj * NE + e) * D * DFF : (size_t)jj * D * DFF;
            if (MOE ? FFN8 : FFN2_8) transpose_item8(karg_in(MOE ? 40 : 36) + eo, D, D / 32, (unsigned char*)(wsp + W::WF2) + (size_t)e * D * DFF, DFF, 0, 1, pg8::S8_W2, scr, it, lane);
            else transpose_item(karg_in(MOE ? 40 : 36) + eo, D, D / 32, (bf16_t*)(wsp + W::WF2) + (size_t)e * D * DFF, DFF, 0, 1, 0, nullptr, scr, it, lane); }
        return; }
#pragma unroll 1
    for (int i = 0; i < FFN_CHUNK / NWAVES; ++i) {
        const int g = chunk * FFN_CHUNK + i * NWAVES + wave; if (g >= (MOE ? NE : 1) * FFN_ITEMS) break;
        const int e = g / FFN_ITEMS, r = g % FFN_ITEMS, mat = r / 1792, it = r % 1792;
        const size_t eo = MOE ? ((size_t)jj * NE + e) * D * DFF : (size_t)jj * D * DFF;
        const float* src = karg_in((MOE ? 38 : 34) + mat) + eo;
        if (F8W) { unsigned char* W13_8 = (unsigned char*)(wsp + W::WF13) + (size_t)e * 2 * DFF * D; unsigned char* W2_8 = (unsigned char*)(wsp + W::WF2) + (size_t)e * D * DFF;
            if (mat < 2) transpose_item8(src, DFF, DFF / 32, W13_8, D, mat, 2, pg8::S8_W13, scr, it, lane); else transpose_item8(src, D, D / 32, W2_8, DFF, 0, 1, pg8::S8_W2, scr, it, lane); }
        else { bf16_t* W13 = (bf16_t*)(wsp + W::WF13) + (size_t)e * 2 * DFF * D; bf16_t* W2 = (bf16_t*)(wsp + W::WF2) + (size_t)e * D * DFF;
            if (mat < 2) transpose_item(src, DFF, DFF / 32, W13, D, mat, 2, 0, nullptr, scr, it, lane); else transpose_item(src, D, D / 32, W2, DFF, 0, 1, 0, nullptr, scr, it, lane); }
    }
}
struct FwdCtx { unsigned char* ws; float* out; int lo, hi; };
#define PHASE_BEGIN if (pc >= lo && pc < hi) { unsigned char* wsp = ws; asm volatile("" : "+s"(wsp)); int lp = l; asm volatile("" : "+s"(lp)); \
        int bid = blockIdx.x; asm volatile("" : "+s"(bid)); int GRD = gridDim.x; asm volatile("" : "+s"(GRD)); \
        const int tid = otid(); const int wave = tid >> 6, lane = tid & 63, gw = bid * NWAVES + wave; (void)lane; (void)gw; (void)lp; \
        float* MOD = (float*)(wsp + W::MOD); float* X = (float*)(wsp + W::X); bf16_t* Hb = (bf16_t*)(wsp + W::H); (void)MOD; (void)X; (void)Hb;
#define PHASE_END   if (pc + 1 < hi) xcd_barrier(bar); } ++pc;
#define L_PTRS const float* MODl = MOD + (size_t)lp * 9 * 6144; const int jj = lp >> 1; const float lam_init = 0.8f - 0.6f * __expf(-0.3f * (float)lp); (void)MODl; (void)jj; (void)lam_init; \
        bf16_t* WING = (bf16_t*)(wsp + W::WING); bf16_t* WBR = (bf16_t*)(wsp + W::WBR); bf16_t* WOUT = (bf16_t*)(wsp + W::WOUT); bf16_t* WEXP = (bf16_t*)(wsp + W::WEXP); bf16_t* WGLU = (bf16_t*)(wsp + W::WGLU); \
        bf16_t* WF13 = (bf16_t*)(wsp + W::WF13); bf16_t* WF2 = (bf16_t*)(wsp + W::WF2); \
        bf16_t* ZB = (bf16_t*)(wsp + W::Z); bf16_t* GB = (bf16_t*)(wsp + W::G); bf16_t* EB = (bf16_t*)(wsp + W::E); bf16_t* OB = (bf16_t*)(wsp + W::OB); bf16_t* MB = (bf16_t*)(wsp + W::MB); bf16_t* YB = (bf16_t*)(wsp + W::YB); \
        int* PLANG = (int*)(wsp + W::CTL + W::PLAN + (size_t)jj * 4096); int* LTOK = (int*)(wsp + W::LTOK); int* TSLOT = (int*)(wsp + W::TSLOT); float* TGATE = (float*)(wsp + W::TGATE); \
        unsigned* QC = (unsigned*)(wsp + W::CTL + W::QCTR + (size_t)lp * 1024); \
        (void)WING; (void)WBR; (void)WOUT; (void)WEXP; (void)WGLU; (void)WF13; (void)WF2; (void)ZB; (void)GB; (void)EB; (void)OB; (void)MB; (void)YB; (void)PLANG; (void)LTOK; (void)TSLOT; (void)TGATE; (void)QC;
#define MK_SA S5Args sa; { unsigned char* s5t = wsp + W::S5TAB + (size_t)lp * 288 * 1024; sa.ZB = ZB; sa.S5A = (const float4*)s5t; sa.S5B = (const bf16_t*)(s5t + 32 * 1024); sa.S5C = (const bf16_t*)(s5t + 160 * 1024); \
        sa.dskip = karg_in(19) + lp * 256; sa.S = (float2*)(wsp + W::S5S); sa.Y5 = (bf16_t*)(wsp + W::Y5B); sa.dbg = nullptr; }
#define MK_PA PrepArgs pa{ZB, EB, (bf16_t*)(wsp + W::QM), (bf16_t*)(wsp + W::KM), (bf16_t*)(wsp + W::QD), (bf16_t*)(wsp + W::KD), (bf16_t*)(wsp + W::VTN), (bf16_t*)(wsp + W::VTM), (bf16_t*)(wsp + W::VTD)};
#define MK_L2 LnArgs l2{}; l2.X = X; l2.mod_gate = MODl + 5 * D; l2.g = karg_in(32) + lp * D; l2.bta = karg_in(33) + lp * D; l2.out = lp == DEPTH - 1 ? OUTP : nullptr; \
        l2.H = (GQ || lp == DEPTH - 1) ? nullptr : Hb; l2.H8 = (!GQ && GATE8 && lp != DEPTH - 1) ? (unsigned char*)(wsp + W::H8M) : nullptr; l2.HQ = (GQ && lp != DEPTH - 1) ? (signed char*)Hb : nullptr; l2.hscale = (float*)(wsp + W::HSM); l2.mod_h = MODl + 9 * 6144; l2.hsh = 0; l2.hsc = D; l2.tslot = TSLOT; l2.tgate = TGATE; l2.nrows = TR;


template <int LAYER> __device__ __forceinline__ void layer_body(const FwdCtx& cx, LAS unsigned char* lds, const XcdBarrier& bar, int& pc) {
    unsigned char* ws = cx.ws; float* OUTP = cx.out; const int lo = cx.lo, hi = cx.hi; const int l = LAYER; constexpr bool moe = (LAYER & 1) != 0;
    constexpr bool LASTL = LAYER == DEPTH - 1; constexpr int NRT = LASTL ? TL / 256 : T / 256, TR = NRT * 256;
    const int NGW = gridDim.x * NWAVES; (void)NGW;
    LAS float* biasL = (LAS float*)(lds + LDS_UP); LAS int* planL = (LAS int*)(lds + LDS_UP + 8192); LAS int* qslot = (LAS int*)(lds + LDS_UP + 12032); (void)biasL; (void)planL; (void)qslot;
        PHASE_BEGIN L_PTRS
            { int cursor = 0;
#if GQ
              for (int it = bid; it < INC / 32 + 4 * D / 32; it += GRD) {
                  if (it < INC / 32) colgroup_q_block(karg_in(6) + (size_t)lp * D * INC, INC, 32 * it, (signed char*)WING, D, 0, 1, (float*)(wsp + W::WSIN), lds);
                  else colgroup_q_block(karg_in(27) + (size_t)lp * D * 4 * D, 4 * D, 32 * (it - INC / 32), (signed char*)(wsp + W::WG8), D, 0, 1, (float*)(wsp + W::WSIN) + ZC, lds); }
              if (bid == GRD - 1 && tid < ZC - INC) ((float*)(wsp + W::WSIN))[INC + tid] = 0.f;
#else
              conv_matrix(karg_in(6) + (size_t)lp * D * INC, D, INC, INC, WING, D, 0, 1, 0, nullptr, lds, cursor);
              if (GATE8) conv_matrix8(karg_in(27) + (size_t)lp * D * 4 * D, D, 4 * D, 4 * D, (unsigned char*)(wsp + W::WG8), D, 0, 1, pg8::S8_W13, lds, cursor);
              else conv_matrix(karg_in(27) + (size_t)lp * D * 4 * D, D, 4 * D, 4 * D, WING, D, ZC, 1, 0, nullptr, lds, cursor);
#endif
              for (int i = 0; i < 4; ++i) conv_matrix(karg_in(26) + ((size_t)lp * 4 + i) * 256 * D, 256, D, D, WBR, 256, i * D, 1, 0, nullptr, lds, cursor);
              conv_matrix(karg_in(29) + (size_t)lp * D * D, D, D, D, WOUT, D, 0, 1, 0, nullptr, lds, cursor);
              if (!GQ) zero_rect(WING, D, INC, ZC, 0, D);
              conv_matrix(karg_in(10) + (size_t)lp * 256 * 384, 256, 384, 384, WEXP, 384, 0, 1, 0, karg_in(8) + lp * 256, lds, cursor);
              conv_matrix(karg_in(11) + (size_t)lp * 128 * 512, 128, 512, 512, WEXP, 384, 384, 1, 256, karg_in(9) + lp * 128, lds, cursor);
              zero_rect(WEXP, 384, 0, 384, 256, 384); zero_rect(WEXP, 384, 384, 896, 0, 256); zero_rect(WEXP, 384, 896, 1024, 0, 384);
              conv_matrix(karg_in(20) + (size_t)lp * 256 * 512, 256, 256, 512, WGLU, 256, 0, 2, 0, nullptr, lds, cursor);
              conv_matrix(karg_in(20) + (size_t)lp * 256 * 512 + 256, 256, 256, 512, WGLU, 256, 1, 2, 0, nullptr, lds, cursor);
              __syncthreads(); }
        PHASE_END
        for (int rep = 0; rep < DUP_L1; ++rep) {
        PHASE_BEGIN L_PTRS
#if GQ
            { pg8::StaticOrder S; S.init(T / 256, ZC / 256, GRD, bid, Hb, D / 2, WING, D / 2);
              pg8::EpiStoreQ E; E.O = ZB; E.ldc = ZC; E.hs = (const float*)(wsp + W::HSM); E.ws = (const float*)(wsp + W::WSIN);
              pg8::gemm_phase<pg8::EpiStoreQ, pg8::StaticOrder, false, true>(lds, D / 2, D / 2, D / 2, S, E);
#ifdef DUP_Z
              asm volatile("" ::: "memory"); pg8::gemm_phase<pg8::EpiStoreQ, pg8::StaticOrder, false, true>(lds, D / 2, D / 2, D / 2, S, E);
#endif
            }
            { pg8::StaticOrder S; S.init(NRT, 4 * D / 256, GRD, bid, Hb, D / 2, (bf16_t*)(wsp + W::WG8), D / 2);
              pg8::EpiGateQ E; E.O = (unsigned char*)GB; E.ldc = 4 * D; E.bias = karg_in(28) + (size_t)lp * 4 * D; E.hs = (const float*)(wsp + W::HSM); E.ws = (const float*)(wsp + W::WSIN) + ZC;
              pg8::gemm_phase<pg8::EpiGateQ, pg8::StaticOrder, false, true>(lds, D / 2, D / 2, D / 2, S, E);
#ifdef DUP_GATE
              asm volatile("" ::: "memory"); pg8::gemm_phase<pg8::EpiGateQ, pg8::StaticOrder, false, true>(lds, D / 2, D / 2, D / 2, S, E);
#endif
            }
#elif GATE8
            { pg8::StaticOrder S; S.init(T / 256, ZC / 256, GRD, bid, Hb, D, WING, D);
              pg8::EpiStore E; E.O = ZB; E.ldc = ZC;
              pg8::gemm_phase<pg8::EpiStore, pg8::StaticOrder>(lds, D, D, D, S, E); }
            { pg8::StaticOrder S; S.init(NRT, 4 * D / 256, GRD, bid, (bf16_t*)(wsp + W::H8M), D / 2, (bf16_t*)(wsp + W::WG8), D / 2);
              pg8::EpiGate E; E.O = GB; E.ldc = 4 * D; E.bias = karg_in(28) + (size_t)lp * 4 * D; E.isc = 1.f / (pg8::S8_H * pg8::S8_W13); E.u8 = G8;
              pg8::gemm_phase<pg8::EpiGate, pg8::StaticOrder, true>(lds, D / 2, D / 2, D / 2, S, E); }
#else
            { pg8::StaticOrder S; S.init(T / 256, NWG / 256, GRD, bid, Hb, D, WING, D);
              pg8::EpiZG E; E.Zo = ZB; E.Go = GB; E.bias = karg_in(28) + (size_t)lp * 4 * D;
              pg8::gemm_phase<pg8::EpiZG, pg8::StaticOrder>(lds, D, D, D, S, E); }
#endif
        PHASE_END
        }
        for (int rep = 0; rep < DUP_L2; ++rep) {
        PHASE_BEGIN L_PTRS MK_SA
            { pg8::StaticOrder S; S.init(T / 256, 4, GRD, bid, ZB + O_MQ, ZC, WEXP, 384);
              pg8::EpiStore E; E.O = EB; E.ldc = D;
              pg8::gemm_phase<pg8::EpiStore, pg8::StaticOrder>(lds, 384, ZC, 384, S, E);
              LAS float* tile = (LAS float*)(lds + wave * 8448);
              for (int it = bid; it < NB * 2 * NCHK * 2; it += GRD) { const int gh = it & 1, j = (it >> 1) % NCHK, bd = (it >> 1) / NCHK; s5_pass1_item(sa, bd >> 1, bd & 1, j, gh * 8 + wave, tile, lane); }
              __syncthreads(); }
        PHASE_END
        }
        for (int rep = 0; rep < DUP_L3; ++rep) {
        PHASE_BEGIN L_PTRS MK_PA
            { const float* rope_tab = (const float*)(wsp + W::ROPE);
              for (int r = gw; r < T; r += 6 * NGW) prep_rows_fast<6>(pa, rope_tab, r, NGW, T, lane); }
            for (int ti = bid; ti < T / 64; ti += GRD) prep_vt_tile_fast(pa, ti, lds);
        PHASE_END
        }
        for (int rep = 0; rep < DUP_L4; ++rep) {
        PHASE_BEGIN L_PTRS
            { float lam; { const float* lv = (const float*)(wsp + W::LAMV) + lp * 128; float s1 = 0.f, s2 = 0.f; for (int i = 0; i < 32; ++i) { s1 += lv[i] * lv[32 + i]; s2 += lv[64 + i] * lv[96 + i]; } lam = __expf(s1) - __expf(s2) + lam_init; }
              na_load_bias(karg_in(7) + (size_t)lp * 4 * 15 * 31, biasL);
#define QPOP2(k, r2) ({ __syncthreads(); if (otid() == 0) *qslot = (int)atomicAdd(QC + 64 * (k) + 32 * rep + 16 * (r2), 1u); __syncthreads(); *qslot; })
#define SUBSCOPE unsigned char* w2 = wsp; asm volatile("" : "+s"(w2)); const int t2_ = otid(); const int wv = __builtin_amdgcn_readfirstlane(t2_ >> 6), ln = t2_ & 63; (void)wv; (void)ln;
              const int nconv = (FFNQ && (!moe || MOEQ)) ? (moe ? NE : 1) * (224 + 1792 / FFN_CHUNK) : ((moe ? NE : 1) * FFN_ITEMS + FFN_CHUNK - 1) / FFN_CHUNK; bool conv_done = false;
#define CONV_SOME(nmax) do { for (int c_ = 0; c_ < (nmax) && !conv_done; ++c_) { __syncthreads(); if (otid() == 0) *qslot = (int)atomicAdd(QC + 8 + 32 * rep, 1u); __syncthreads(); const int q_ = *qslot; \
                  if (q_ >= nconv) conv_done = true; else ffn_conv_chunk<moe>(q_, jj, wsp, lds, wave, lane); } } while (0)
              { SUBSCOPE AttnArgs aa{(bf16_t*)(w2 + W::QD), (bf16_t*)(w2 + W::KD), (bf16_t*)(w2 + W::VTD), (bf16_t*)(w2 + W::OB), nullptr, karg_in(25) + lp * 64, lam_init, 0};
                for (int r2 = 0; r2 < (DUP_SUB == 0 ? 2 : 1); ++r2) for (;;) { const int u = QPOP2(0, r2); if (u >= NB * 4 * (LASTL ? 16 : 17)) break; const int qb = u / 32, bh = u % 32; attn_unit<2>(aa, bh >> 2, bh & 3, qb, lds, lam); CONV_SOME(2); } }
              { SUBSCOPE AttnArgs aa{(bf16_t*)(w2 + W::QM), (bf16_t*)(w2 + W::KM), (bf16_t*)(w2 + W::VTM), (bf16_t*)(w2 + W::OB), nullptr, nullptr, lam_init, 0};
                for (int r2 = 0; r2 < (DUP_SUB == 1 ? 2 : 1); ++r2) for (;;) { const int u = QPOP2(1, r2); if (u >= NB * 4 * (LASTL ? 16 : 17)) break; const int qb = u / 32, bh = u % 32; attn_unit<1>(aa, bh >> 2, bh & 3, qb, lds, 0.f); CONV_SOME(2); } }
              { SUBSCOPE S5Args sa; { unsigned char* s5t = w2 + W::S5TAB + (size_t)lp * 288 * 1024; sa.ZB = (bf16_t*)(w2 + W::Z); sa.S5A = (const float4*)s5t; sa.S5B = (const bf16_t*)(s5t + 32 * 1024); sa.S5C = (const bf16_t*)(s5t + 160 * 1024);
                  sa.dskip = karg_in(19) + lp * 256; sa.S = (float2*)(w2 + W::S5S); sa.Y5 = (bf16_t*)(w2 + W::Y5B); sa.dbg = nullptr; }
                LAS float* tile = (LAS float*)(lds + wv * 8448);
                for (int r2 = 0; r2 < (DUP_SUB == 2 ? 2 : 1); ++r2) for (;;) { const int it = QPOP2(2, r2); if (it >= NB * (LASTL ? NCHK - 4 : NCHK) * 2) break; const int gh = it & 1, tc = LASTL ? 4 + (it >> 1) % (NCHK - 4) : (it >> 1) % NCHK, b = LASTL ? (it >> 1) / (NCHK - 4) : (it >> 1) / NCHK; s5_pass2_item(sa, b, tc, gh * 8 + wv, tile, ln); } }
              { SUBSCOPE NaArgs na{(bf16_t*)(w2 + W::Z), (bf16_t*)(w2 + W::VTN), (bf16_t*)(w2 + W::OB), nullptr};
                for (int r2 = 0; r2 < (DUP_SUB == 3 ? 2 : 1); ++r2) for (;;) { const int it = QPOP2(3, r2); if (it >= (LASTL ? 512 : 544)) break; na_wave(na, it, biasL, wv, ln); } }
#undef SUBSCOPE
              CONV_SOME(1 << 30);
#undef CONV_SOME
              __syncthreads(); }
        PHASE_END
        }
        PHASE_BEGIN L_PTRS
            { pg8::StaticOrder S; S.init(NRT, 2, GRD, bid, (bf16_t*)(wsp + W::Y5B), 256, WGLU, 256);
              pg8::EpiPair<true> E; E.O = OB; E.ldc = D; E.col_off = 512;
              pg8::gemm_phase<pg8::EpiPair<true>, pg8::StaticOrder>(lds, 256, 256, 256, S, E); }
        PHASE_END
        for (int rep = 0; rep < DUP_L6; ++rep) {
        PHASE_BEGIN L_PTRS
            { pg8::MergeOrder S; S.init(NRT, GRD, bid, OB, WBR);
              pg8::EpiMerge E; E.M = MB; E.G = GB;
              pg8::gemm_phase<pg8::EpiMerge, pg8::MergeOrder>(lds, 256, D, 256, S, E); }
        PHASE_END
        }
        PHASE_BEGIN L_PTRS
            { pg8::StaticOrder S; S.init(NRT, 4, GRD, bid, MB, D, WOUT, D);
              pg8::EpiStore E; E.O = YB; E.ldc = D;
              pg8::gemm_phase<pg8::EpiStore, pg8::StaticOrder>(lds, D, D, D, S, E); }
        PHASE_END
        PHASE_BEGIN L_PTRS
            { LnArgs la{}; la.xin = lp == 0 ? karg_in(0) : nullptr; la.cin = karg_in(2); la.X = X; la.Y = YB; la.mod_gate = MODl + 2 * D; la.g = karg_in(30) + lp * D; la.bta = karg_in(31) + lp * D; la.out = nullptr;
              la.H = ((FFN8 && moe) || (FFNQ && !moe)) ? nullptr : Hb; la.H8 = (FFN8 && moe && !MOEQ) ? (unsigned char*)Hb : nullptr; la.HQ = (FFNQ && (!moe || MOEQ)) ? (signed char*)Hb : nullptr; la.hscale = (float*)(wsp + (moe ? W::HSM : W::TSLOT)); la.mod_h = MODl; la.hsh = 3 * D; la.hsc = 4 * D; la.wr = karg_in(37) + (size_t)jj * D * 8; la.plan = PLANG; la.ltok = LTOK; la.tslot = TSLOT; la.tgate = TGATE; la.nrows = TR;
              if (moe) ln_rows<false, true>(la, planL); else ln_rows<false, false>(la, planL); }
        PHASE_END
        if (!moe) {
            for (int rep = 0; rep < DUP_FFN; ++rep) {
            PHASE_BEGIN L_PTRS
#if 0
                { pg8::StaticOrder S; S.init(T / 256, 2 * DFF / 256, GRD, bid, Hb, D / 2, WF13, D / 2);
                  pg8::EpiSwiglu8 E; E.O = (unsigned char*)(wsp + W::ACT); E.ldc = DFF; E.isc = 1.f / (pg8::S8_H * pg8::S8_W13); E.osc = pg8::S8_ACT;
                  pg8::gemm_phase<pg8::EpiSwiglu8, pg8::StaticOrder, true>(lds, D / 2, D / 2, D / 2, S, E); }
#elif FFNQ
                { pg8::StaticOrder S; S.init(T / 256, 2 * DFF / 256, GRD, bid, Hb, D / 2, WF13, D / 2);
                  pg8::EpiSwigluQ<FFN2_8 != 0> E; E.O = (bf16_t*)(wsp + W::ACT); E.ldc = DFF; E.hs = (const float*)(wsp + W::TSLOT); E.ws = (const float*)(wsp + W::WS13); E.osc = pg8::S8_ACT;
                  pg8::gemm_phase<pg8::EpiSwigluQ<FFN2_8 != 0>, pg8::StaticOrder, false, true>(lds, D / 2, D / 2, D / 2, S, E); }
#else
                { pg8::StaticOrder S; S.init(T / 256, 2 * DFF / 256, GRD, bid, Hb, D, WF13, D);
                  pg8::EpiPair<false> E; E.O = (bf16_t*)(wsp + W::ACT); E.ldc = DFF; E.col_off = 0;
                  pg8::gemm_phase<pg8::EpiPair<false>, pg8::StaticOrder>(lds, D, D, D, S, E); }
#endif
            PHASE_END
            PHASE_BEGIN L_PTRS
#if FFN2_8
                { pg8::StaticOrder S; S.init(T / 256, 4, GRD, bid, (bf16_t*)(wsp + W::ACT), DFF / 2, WF2, DFF / 2);
                  pg8::EpiStoreS E; E.O = (bf16_t*)(wsp + W::FB); E.ldc = D; E.scale = 1.f / (pg8::S8_ACT * pg8::S8_W2);
                  pg8::gemm_phase<pg8::EpiStoreS, pg8::StaticOrder, true>(lds, DFF / 2, DFF / 2, DFF / 2, S, E); }
#else
                { pg8::StaticOrder S; S.init(T / 256, 4, GRD, bid, (bf16_t*)(wsp + W::ACT), DFF, WF2, DFF);
                  pg8::EpiStore E; E.O = (bf16_t*)(wsp + W::FB); E.ldc = D;
                  pg8::gemm_phase<pg8::EpiStore, pg8::StaticOrder>(lds, DFF, DFF, DFF, S, E); }
#endif
            PHASE_END
            }
            PHASE_BEGIN L_PTRS MK_L2
                l2.Y = (bf16_t*)(wsp + W::FB); ln_rows<false, false>(l2, planL);
            PHASE_END
        } else {
            PHASE_BEGIN L_PTRS
                moe_plan_lds(PLANG, planL);
                { const int nrows = planL[16] * 256;
#if FFN8
                  for (int pr0 = gw; pr0 < nrows; pr0 += 4 * NGW) {
                      int tok[4]; u32x4 v0[4]; float hsv[4];
#pragma unroll
                      for (int q = 0; q < 4; ++q) { const int pr = pr0 + q * NGW; tok[q] = -1; if (pr < nrows) { const int e = planL[32 + (pr >> 8)], slot = pr - planL[8 + e]; if (slot < planL[e]) tok[q] = LTOK[e * T + slot]; } }
#pragma unroll
                      for (int q = 0; q < 4; ++q) { v0[q] = (u32x4){0u, 0u, 0u, 0u}; hsv[q] = 0.f; if (tok[q] >= 0) { v0[q] = ((const u32x4*)((const unsigned char*)Hb + (size_t)tok[q] * D))[lane]; if (MOEQ) hsv[q] = ((const float*)(wsp + W::HSM))[tok[q]]; } }
#pragma unroll
                      for (int q = 0; q < 4; ++q) { const int pr = pr0 + q * NGW; if (pr < nrows) { if (MOEQ && lane == 0) ((float*)(wsp + W::HGS))[pr] = hsv[q]; ((u32x4*)((unsigned char*)(wsp + W::HG) + (size_t)pr * D))[lane] = v0[q]; } } } }
#else
                  for (int pr = gw; pr < nrows; pr += NGW) { const int e = planL[32 + (pr >> 8)], slot = pr - planL[8 + e];
                      u32x4 v0 = (u32x4){0u, 0u, 0u, 0u}, v1 = v0;
                      if (slot < planL[e]) { const int tok = LTOK[e * T + slot]; const u32x4* src = (const u32x4*)(Hb + (size_t)tok * D); v0 = src[lane]; v1 = src[64 + lane]; }
                      u32x4* dst = (u32x4*)((bf16_t*)(wsp + W::HG) + (size_t)pr * D); dst[lane] = v0; dst[64 + lane] = v1; } }
#endif
            PHASE_END
            for (int rep = 0; rep < DUP_FFN; ++rep) {
            PHASE_BEGIN L_PTRS
                if (lo == pc) moe_plan_lds(PLANG, planL);
#if MOEQ
                { pg8::MoeOrderL S; S.init(planL, 2 * DFF / 256, GRD, bid, (bf16_t*)(wsp + W::HG), D / 2, WF13, D / 2, (size_t)2 * DFF * D / 2);
                  pg8::EpiSwigluQ<true> E; E.O = (bf16_t*)(wsp + W::ACT); E.ldc = DFF; E.hs = (const float*)(wsp + W::HGS); E.ws = (const float*)(wsp + W::WS13M); E.osc = pg8::S8_ACT;
                  pg8::gemm_phase<pg8::EpiSwigluQ<true>, pg8::MoeOrderL, false, true>(lds, D / 2, D / 2, D / 2, S, E); }
#elif FFN8
                { pg8::MoeOrderL S; S.init(planL, 2 * DFF / 256, GRD, bid, (bf16_t*)(wsp + W::HG), D / 2, WF13, D / 2, (size_t)2 * DFF * D / 2);
                  pg8::EpiSwiglu8 E; E.O = (unsigned char*)(wsp + W::ACT); E.ldc = DFF; E.isc = 1.f / (pg8::S8_H * pg8::S8_W13); E.osc = pg8::S8_ACT;
                  pg8::gemm_phase<pg8::EpiSwiglu8, pg8::MoeOrderL, true>(lds, D / 2, D / 2, D / 2, S, E); }
#else
                { pg8::MoeOrderL S; S.init(planL, 2 * DFF / 256, GRD, bid, (bf16_t*)(wsp + W::HG), D, WF13, D, (size_t)2 * DFF * D);
                  pg8::EpiPair<false> E; E.O = (bf16_t*)(wsp + W::ACT); E.ldc = DFF; E.col_off = 0;
                  pg8::gemm_phase<pg8::EpiPair<false>, pg8::MoeOrderL>(lds, D, D, D, S, E); }
#endif
            PHASE_END
            PHASE_BEGIN L_PTRS
                if (lo == pc) moe_plan_lds(PLANG, planL);
#if FFN8
                { pg8::MoeOrderL S; S.init(planL, 4, GRD, bid, (bf16_t*)(wsp + W::ACT), DFF / 2, WF2, DFF / 2, (size_t)D * DFF / 2);
                  pg8::EpiStoreS E; E.O = (bf16_t*)(wsp + W::HG); E.ldc = D; E.scale = 1.f / (pg8::S8_ACT * pg8::S8_W2);
                  pg8::gemm_phase<pg8::EpiStoreS, pg8::MoeOrderL, true>(lds, DFF / 2, DFF / 2, DFF / 2, S, E); }
#else
                { pg8::MoeOrderL S; S.init(planL, 4, GRD, bid, (bf16_t*)(wsp + W::ACT), DFF, WF2, DFF, (size_t)D * DFF);
                  pg8::EpiStore E; E.O = (bf16_t*)(wsp + W::HG); E.ldc = D;
                  pg8::gemm_phase<pg8::EpiStore, pg8::MoeOrderL>(lds, DFF, DFF, DFF, S, E); }
#endif
            PHASE_END
            }
            PHASE_BEGIN L_PTRS
                if (lo == pc) moe_plan_lds(PLANG, planL);
                MK_L2 l2.Y = (bf16_t*)(wsp + W::HG); ln_rows<true, false>(l2, planL);
            PHASE_END
        }
}
__global__ void __launch_bounds__(NTHR, 2) fwd(FwdArgs A) {
    extern __shared__ __attribute__((aligned(16))) unsigned char lds_raw[];
    LAS unsigned char* lds = (LAS unsigned char*)lds_raw;
    unsigned char* ws = A.ws;
    volatile LAS unsigned* bst = (volatile LAS unsigned*)(lds + LDS_UP + 12288);
    if (threadIdx.x < 4) bst[threadIdx.x] = 0u;
    __syncthreads();
    XcdBarrier bar = xcd_barrier_post((unsigned*)(ws + W::CTL), bst);
    const int lo = A.lo, hi = A.hi; int pc = 0; const int l = 0; (void)l;
    const int NGW = gridDim.x * NWAVES;
    PHASE_BEGIN
        { LAS float* condL = (LAS float*)lds;
          float* MODP = (float*)(wsp + W::MODP);
          for (int u = bid; u < 4 * 12 * 8; u += GRD) { const int ks = u & 7, cg = (u >> 3) % 12, l = u / 96;
              __syncthreads();
              for (int i = tid; i < 9 * 128; i += NTHR) { const int r = i >> 7, k = ks * 128 + (i & 127); const float v = r < 8 ? karg_in(1)[r * D + k] : karg_in(3)[k]; condL[i] = v * sigm(v); }
              __syncthreads();
              const int n = cg * 512 + tid; float acc[9];
#pragma unroll
              for (int r = 0; r < 9; ++r) acc[r] = 0.f;
              const float* w = karg_in(4) + ((size_t)l * D + ks * 128) * 6144 + n;
#pragma unroll 4
              for (int k = 0; k < 128; ++k) { const float wv = w[(size_t)k * 6144];
#pragma unroll
                  for (int r = 0; r < 9; ++r) acc[r] += condL[r * 128 + k] * wv; }
#pragma unroll
              for (int r = 0; r < 9; ++r) MODP[(((size_t)ks * 4 + l) * 9 + r) * 6144 + n] = acc[r]; }
          for (int i = bid * NTHR + tid; i < 4 * 2048; i += GRD * NTHR) { const int l = i >> 11, j = i & 2047; unsigned char* tb = wsp + W::S5TAB + (size_t)l * 288 * 1024;
              const int gi = j >> 6, p = j & 63;
              const float* lam_re = karg_in(12) + (size_t)l * 2048; const float* lam_im = karg_in(13) + (size_t)l * 2048; const float* log_dt = karg_in(14) + l * 32;
              const float* b_re = karg_in(15) + (size_t)l * 32768; const float* b_im = karg_in(16) + (size_t)l * 32768; const float* c_re = karg_in(17) + (size_t)l * 32768; const float* c_im = karg_in(18) + (size_t)l * 32768;
              float4* S5A = (float4*)tb; bf16_t* S5B = (bf16_t*)(tb + 32 * 1024); bf16_t* S5C = (bf16_t*)(tb + 160 * 1024);
              const double lre = lam_re[j], lim = lam_im[j], dt = exp((double)log_dt[gi]);
              const double x = lre * dt; double y = lim * dt; y -= 6.283185307179586476925 * rint(y / 6.283185307179586476925);
              float sy, cy; sincosf((float)y, &sy, &cy); const float sh = sinf((float)(0.5 * y));
              const double em1 = x * (1.0 + x * 0.5 * (1.0 + x * (1.0 / 3.0) * (1.0 + x * 0.25 * (1.0 + x * 0.2 * (1.0 + x * (1.0 / 6.0))))));
              const double nr = em1 * (double)cy - 2.0 * (double)sh * (double)sh, ni = (1.0 + em1) * (double)sy;
              const double ar = 1.0 + nr, ai = ni; double pr = ar, pi = ai;
#pragma unroll
              for (int k = 0; k < 6; ++k) { const double t = pr * pr - pi * pi; pi = 2.0 * pr * pi; pr = t; }
              S5A[j] = make_float4((float)ar, (float)ai, (float)pr, (float)pi);
              const double den = lre * lre + lim * lim; const float fr = (float)((nr * lre + ni * lim) / den), fi = (float)((ni * lre - nr * lim) / den);
              for (int c = 0; c < 16; ++c) { const float br = b_re[j * 16 + c], bi = b_im[j * 16 + c];
                  S5B[((size_t)gi * 128 + p) * 16 + c] = (bf16_t)f2bf(fr * br - fi * bi); S5B[((size_t)gi * 128 + 64 + p) * 16 + c] = (bf16_t)f2bf(fr * bi + fi * br);
                  S5C[((size_t)gi * 16 + c) * 128 + p] = (bf16_t)f2bf(c_re[(gi * 16 + c) * 64 + p]); S5C[((size_t)gi * 16 + c) * 128 + 64 + p] = (bf16_t)f2bf(-c_im[(gi * 16 + c) * 64 + p]); } }
          if (bid == 1 % GRD) { float* RT = (float*)(wsp + W::ROPE); const int pos = tid >> 3, i = tid & 7; const float inv = exp2f(-(float)i * 0.125f * 13.287712379549449f); float sn_, cs_; sincosf((float)pos * inv, &sn_, &cs_); RT[pos * 16 + i] = cs_; RT[pos * 16 + 8 + i] = sn_; }
          if (bid == 0) { float* LAMV = (float*)(wsp + W::LAMV); const int l = tid >> 7, wq = (tid >> 5) & 3, j = tid & 31; const float* s0 = karg_in(21); const float* s1 = karg_in(22); const float* s2 = karg_in(23); const float* s3 = karg_in(24); const float* src = wq == 0 ? s0 : (wq == 1 ? s1 : (wq == 2 ? s2 : s3)); LAMV[tid] = src[l * 32 + j]; }
          __syncthreads(); }
    PHASE_END
    PHASE_BEGIN
        { const float* MODP = (const float*)(wsp + W::MODP);
          for (int i = bid * NTHR + tid; i < 4 * 9 * 6144; i += GRD * NTHR) { const int n = i % 6144, l = i / (9 * 6144); float s = karg_in(5)[l * 6144 + n];
#pragma unroll
              for (int ks = 0; ks < 8; ++ks) s += MODP[(size_t)ks * 4 * 9 * 6144 + i];
              MOD[i] = s; } }
    PHASE_END
    PHASE_BEGIN
        for (int r = gw; r < T; r += NGW) { const float* xr = r < TL ? karg_in(0) + (size_t)r * D : karg_in(2) + (size_t)(r - TL) * D; const float* md = MOD + (size_t)modrow(r) * 6144;
#if GQ
            float hq[16]; float am = 0.f;
#pragma unroll
            for (int j = 0; j < 4; ++j) { const int c = j * 256 + lane * 4; const float4 x4 = *(const float4*)(xr + c), sc = *(const float4*)(md + D + c), sh = *(const float4*)(md + c);
                hq[j * 4] = x4.x * (1.f + sc.x) + sh.x; hq[j * 4 + 1] = x4.y * (1.f + sc.y) + sh.y; hq[j * 4 + 2] = x4.z * (1.f + sc.z) + sh.z; hq[j * 4 + 3] = x4.w * (1.f + sc.w) + sh.w;
                am = fmaxf(fmaxf(am, fmaxf(fabsf(hq[j * 4]), fabsf(hq[j * 4 + 1]))), fmaxf(fabsf(hq[j * 4 + 2]), fabsf(hq[j * 4 + 3]))); }
#pragma unroll
            for (int o = 32; o >= 1; o >>= 1) am = fmaxf(am, shx(am, o, lane));
            const float qs = 127.f / fmaxf(am, 1e-30f);
            if (lane == 0) ((float*)(wsp + W::HSM))[r] = am * (1.f / 127.f);
#pragma unroll
            for (int j = 0; j < 4; ++j) *(unsigned*)((signed char*)Hb + (size_t)r * D + j * 256 + lane * 4) = pk4_i8(hq[j * 4] * qs, hq[j * 4 + 1] * qs, hq[j * 4 + 2] * qs, hq[j * 4 + 3] * qs);
            continue;
#endif
#pragma unroll
            for (int j = 0; j < 4; ++j) { const int c = j * 256 + lane * 4; const float4 x4 = *(const float4*)(xr + c), sc = *(const float4*)(md + D + c), sh = *(const float4*)(md + c);
                const float h0 = x4.x * (1.f + sc.x) + sh.x, h1 = x4.y * (1.f + sc.y) + sh.y, h2 = x4.z * (1.f + sc.z) + sh.z, h3 = x4.w * (1.f + sc.w) + sh.w;
                u32x2 w; w.x = pk2(h0, h1); w.y = pk2(h2, h3); *(u32x2*)(Hb + (size_t)r * D + c) = w;
                if (GATE8) *(unsigned*)((unsigned char*)(wsp + W::H8M) + (size_t)r * D + c) = pg8::pk4_fp8(h0 * pg8::S8_H, h1 * pg8::S8_H, h2 * pg8::S8_H, h3 * pg8::S8_H); } }
    PHASE_END

    FwdCtx cx{ws, A.out, lo, hi};
    layer_body<0>(cx, lds, bar, pc); layer_body<1>(cx, lds, bar, pc); layer_body<2>(cx, lds, bar, pc); layer_body<3>(cx, lds, bar, pc);
}
#undef PHASE_BEGIN L_PTRS
#undef PHASE_END
#undef QPOP2
#undef L_PTRS
#undef MK_SA
#undef MK_PA
#undef MK_L2
constexpr int NPHASES = 3 + 4 * 9 + 2 * 3 + 2 * 4 + 4 * (DUP_L4 - 1) + 4 * (DUP_L1 - 1) + 4 * (DUP_L6 - 1) + 4 * (DUP_L3 - 1) + 4 * (DUP_L2 - 1) + 4 * 2 * (DUP_FFN - 1);

template <int MODE> static void sgemm(hipStream_t st, const SG& p, int Mgrid) {
    dim3 grid((p.N + 127) / 128, (Mgrid + 127) / 128);
    hipLaunchKernelGGL((k_sgemm<MODE>), grid, dim3(256), 0, st, p);
}

#ifndef FUSED
#define FUSED 1
#endif
#if FUSED
extern "C" void kernel_launch(void* const* d_in, const int* in_sizes, int n_in, void* d_out, int out_size, void* d_ws, size_t ws_size, hipStream_t stream) {
    if (n_in != 41 || ws_size < W::END || out_size != TL * D) { fprintf(stderr, "kernel_launch: bad args n_in %d ws %zu out %d\n", n_in, ws_size, out_size); return; }
    static int grid = 0;
    if (!grid) {
        int dev = 0, cus = 0, per_cu = 0;
        if (hipGetDevice(&dev) != hipSuccess || hipDeviceGetAttribute(&cus, hipDeviceAttributeMultiprocessorCount, dev) != hipSuccess) { fprintf(stderr, "kernel_launch: device query failed\n"); return; }
        if (hipFuncSetAttribute((const void*)fwd, hipFuncAttributeMaxDynamicSharedMemorySize, LDS_BYTES) != hipSuccess) { fprintf(stderr, "kernel_launch: hipFuncSetAttribute failed\n"); return; }
        if (hipOccupancyMaxActiveBlocksPerMultiprocessor(&per_cu, fwd, NTHR, LDS_BYTES) != hipSuccess || per_cu < 1) { fprintf(stderr, "kernel_launch: occupancy query says %d\n", per_cu); return; }
        grid = cus;
    }
    if (hipMemsetAsync((char*)d_ws + W::CTL, 0, W::CTL_ZERO, stream) != hipSuccess) { fprintf(stderr, "kernel_launch: memset failed\n"); return; }
    FwdArgs a{};
    for (int i = 0; i < 41; ++i) a.in[i] = (const float*)d_in[i];
    a.ws = (unsigned char*)d_ws; a.out = (float*)d_out;
#if FUSED == 1
    a.lo = 0; a.hi = NPHASES;
    hipLaunchKernelGGL(fwd, dim3(grid), dim3(NTHR), LDS_BYTES, stream, a);
#else
    for (int p = 0; p < NPHASES; ++p) { a.lo = p; a.hi = p + 1; hipLaunchKernelGGL(fwd, dim3(grid), dim3(NTHR), LDS_BYTES, stream, a); }
#endif
}
#else
extern "C" void kernel_launch(void* const* d_in, const int* in_sizes, int n_in, void* d_out, int out_size, void* d_ws, size_t ws_size, hipStream_t stream) {
    if (n_in != 41 || ws_size < WS_END) { fprintf(stderr, "kernel_launch: bad args n_in %d ws %zu\n", n_in, ws_size); return; }
    const float* const* in = (const float* const*)d_in;
    char* ws = (char*)d_ws;
    float* COND = (float*)(ws + WS_COND); float* MOD = (float*)(ws + WS_MOD); int* CNT = (int*)(ws + WS_CNT); int* LTOK = (int*)(ws + WS_LTOK); float* LGATE = (float*)(ws + WS_LGATE);
    float* X = (float*)(ws + WS_X); float* O = (float*)(ws + WS_O); float* MG = (float*)(ws + WS_MG); float* TG = (float*)(ws + WS_TG); float* E = (float*)(ws + WS_E);
    float* Y5 = (float*)(ws + WS_Y5); float* Z = (float*)(ws + WS_Z); float* ACT = Z;
    bf16_t* Hb = (bf16_t*)(ws + WS_H); bf16_t* W13 = (bf16_t*)(ws + WS_W13); bf16_t* W2T = (bf16_t*)(ws + WS_W2T); bf16_t* ACTb = (bf16_t*)(ws + WS_Z); bf16_t* Fb = (bf16_t*)(ws + WS_TG);
    int* PLAN = (int*)(ws + WS_CNT); int* TSLOT = (int*)(ws + WS_COND + 64 * 1024); float* TGATE = (float*)(ws + WS_COND + 512 * 1024);
    bf16_t* ACTE = (bf16_t*)(ws + 144 * MiB); bf16_t* HG = (bf16_t*)(ws + 636 * MiB); bf16_t* W13E = (bf16_t*)(ws + 778 * MiB); bf16_t* W2TE = (bf16_t*)(ws + 890 * MiB);
    bf16_t* ZB = (bf16_t*)(ws + 280 * MiB); bf16_t* MB = (bf16_t*)(ws + 280 * MiB); bf16_t* YB = (bf16_t*)(ws + 348 * MiB); bf16_t* OB = (bf16_t*)(ws + 144 * MiB); bf16_t* GB = (bf16_t*)(ws + WS_Z);
    bf16_t* WING = (bf16_t*)(ws + 1088 * MiB); bf16_t* WBR = (bf16_t*)(ws + 1101 * MiB); bf16_t* WOUT = (bf16_t*)(ws + 1103 * MiB);
    bf16_t* EB = (bf16_t*)(ws + 552 * MiB); bf16_t* QM = (bf16_t*)(ws + 620 * MiB); bf16_t* KM = (bf16_t*)(ws + 620 * MiB + (size_t)4 * T * 96 * 2);
    bf16_t* VTN = (bf16_t*)(ws + 484 * MiB); bf16_t* VTM = (bf16_t*)(ws + 501 * MiB); bf16_t* VTD = (bf16_t*)(ws + 518 * MiB); bf16_t* QD = (bf16_t*)(ws + 535 * MiB); bf16_t* KD = (bf16_t*)(ws + 1105 * MiB);
    bf16_t* WEXP = (bf16_t*)(ws + 6 * MiB); bf16_t* WGLU = (bf16_t*)(ws + 7 * MiB); float* LAMV = (float*)(ws + WS_COND + 40 * 1024);
    float4* S5A = (float4*)(ws + 7 * MiB + 256 * 1024); bf16_t* S5B = (bf16_t*)(ws + 7 * MiB + 512 * 1024); bf16_t* S5C = (bf16_t*)(ws + 7 * MiB + 768 * 1024);
    bf16_t* Y5B = (bf16_t*)(ws + 671 * MiB); float2* S5S = (float2*)(ws + 688 * MiB);
    static int grid = 0;
    if (!grid) {
        int dev = 0, cus = 0; hipGetDevice(&dev); hipDeviceGetAttribute(&cus, hipDeviceAttributeMultiprocessorCount, dev);
        hipFuncSetAttribute((const void*)k_conv_ffn, hipFuncAttributeMaxDynamicSharedMemorySize, LDS_BYTES);
        hipFuncSetAttribute((const void*)k_conv_mix, hipFuncAttributeMaxDynamicSharedMemorySize, LDS_BYTES);
        hipFuncSetAttribute((const void*)k_conv_exp, hipFuncAttributeMaxDynamicSharedMemorySize, LDS_BYTES);
        hipFuncSetAttribute((const void*)k_prep, hipFuncAttributeMaxDynamicSharedMemorySize, LDS_BYTES);
        hipFuncSetAttribute((const void*)k_na2, hipFuncAttributeMaxDynamicSharedMemorySize, LDS_BYTES);
        hipFuncSetAttribute((const void*)k_s5_pass1, hipFuncAttributeMaxDynamicSharedMemorySize, LDS_BYTES);
        hipFuncSetAttribute((const void*)k_s5_pass2, hipFuncAttributeMaxDynamicSharedMemorySize, LDS_BYTES);
        hipFuncSetAttribute((const void*)k_gemm<pg8::EpiPair<true>>, hipFuncAttributeMaxDynamicSharedMemorySize, LDS_BYTES);
        hipFuncSetAttribute((const void*)k_attn<1>, hipFuncAttributeMaxDynamicSharedMemorySize, LDS_BYTES);
        hipFuncSetAttribute((const void*)k_attn<2>, hipFuncAttributeMaxDynamicSharedMemorySize, LDS_BYTES);
        hipFuncSetAttribute((const void*)k_gemm_gate, hipFuncAttributeMaxDynamicSharedMemorySize, LDS_BYTES);
        hipFuncSetAttribute((const void*)k_gemm_merge, hipFuncAttributeMaxDynamicSharedMemorySize, LDS_BYTES);
        hipFuncSetAttribute((const void*)k_conv_moe, hipFuncAttributeMaxDynamicSharedMemorySize, LDS_BYTES);
        hipFuncSetAttribute((const void*)k_gemm_moe<pg8::EpiPair<false>>, hipFuncAttributeMaxDynamicSharedMemorySize, LDS_BYTES);
        hipFuncSetAttribute((const void*)k_gemm_moe<pg8::EpiStore>, hipFuncAttributeMaxDynamicSharedMemorySize, LDS_BYTES);
        hipFuncSetAttribute((const void*)k_gemm<pg8::EpiPair<false>>, hipFuncAttributeMaxDynamicSharedMemorySize, LDS_BYTES);
        hipFuncSetAttribute((const void*)k_gemm<pg8::EpiStore>, hipFuncAttributeMaxDynamicSharedMemorySize, LDS_BYTES);
        grid = cus > 0 ? cus : 256;
    }
    unsigned long long* CHKT = (unsigned long long*)(ws + WS_CNT + 65536);
    hipMemsetAsync(CHKT, 0, 2048, stream);
#define CHK(id, ptr, bytes) do { if (SELFCHECK) hipLaunchKernelGGL(k_chk, dim3(1024), dim3(256), 0, stream, (const unsigned*)(ptr), (size_t)(bytes) / 4, CHKT + run * 64 + (id)); } while (0)
#ifndef SELFCHECK
#define SELFCHECK 0
#endif
    for (int run = 0; run < (SELFCHECK ? 2 : 1); ++run) {
    hipLaunchKernelGGL(k_cond, dim3(36), dim3(256), 0, stream, in[1], in[3], COND);
    hipLaunchKernelGGL(k_lamv, dim3(1), dim3(512), 0, stream, in[21], in[22], in[23], in[24], LAMV);
    hipLaunchKernelGGL(k_mod, dim3(24, 4), dim3(256), 0, stream, COND, in[4], in[5], MOD);
    hipLaunchKernelGGL(k_copy_in, dim3((unsigned)((size_t)T * D / 4 / 256)), dim3(256), 0, stream, in[0], in[2], X);
    for (int l = 0; l < DEPTH; ++l) {
        const float* MODl = MOD + (size_t)l * 9 * 6144;
        const float lam_init = 0.8f - 0.6f * expf(-0.3f * (float)l);
        SG p{};
        ConvMix cx{in[6] + (size_t)l * D * INC, in[27] + (size_t)l * D * 4 * D, in[26] + (size_t)l * 4 * 256 * D, in[29] + (size_t)l * D * D, WING, WBR, WOUT};
        hipLaunchKernelGGL(k_conv_mix, dim3(grid), dim3(NTHR), LDS_BYTES, stream, cx);
        { ConvExp ce{in[10] + (size_t)l * 256 * 384, in[11] + (size_t)l * 128 * 512, in[8] + l * 256, in[9] + l * 128, in[20] + (size_t)l * 256 * 512, WEXP, WGLU};
          hipLaunchKernelGGL(k_conv_exp, dim3(grid), dim3(NTHR), LDS_BYTES, stream, ce); }
        { S5Prep sp{in[12] + (size_t)l * 2048, in[13] + (size_t)l * 2048, in[14] + l * 32, in[15] + (size_t)l * 32768, in[16] + (size_t)l * 32768, in[17] + (size_t)l * 32768, in[18] + (size_t)l * 32768, S5A, S5B, S5C};
          hipLaunchKernelGGL(k_s5prep, dim3(8), dim3(256), 0, stream, sp); }
        CHK(l * 16 + 2, S5A, (size_t)32768); CHK(l * 16 + 3, S5B, (size_t)131072); CHK(l * 16 + 4, S5C, (size_t)131072);
        if (l == 0) hipLaunchKernelGGL(k_modh, dim3(T * D / 4 / 256), dim3(256), 0, stream, X, MODl, 0, D, Hb);
        { GemmArgs ga{Hb, WING, ZB, T / 256, ZC / 256, D, D, D, ZC, 0, 0};
          hipLaunchKernelGGL(k_gemm<pg8::EpiStore>, dim3(grid), dim3(NTHR), LDS_BYTES, stream, ga); }
        CHK(l * 16 + 0, Hb, (size_t)T * D * 2); CHK(l * 16 + 1, ZB, (size_t)T * ZC * 2);
        { GemmArgs ga{ZB + O_MQ, WEXP, EB, T / 256, 4, 384, ZC, 384, D, 0, 0};
          hipLaunchKernelGGL(k_gemm<pg8::EpiStore>, dim3(grid), dim3(NTHR), LDS_BYTES, stream, ga); }
        { PrepArgs pa{ZB, EB, QM, KM, QD, KD, VTN, VTM, VTD};
          hipLaunchKernelGGL(k_prep, dim3(grid), dim3(NTHR), LDS_BYTES, stream, pa); }
        CHK(l * 16 + 5, EB, (size_t)T * D * 2); CHK(l * 16 + 5, QM, (size_t)8 * T * 96 * 2); CHK(l * 16 + 5, VTN, (size_t)51 * MiB); CHK(l * 16 + 5, QD, (size_t)17 * MiB); CHK(l * 16 + 5, KD, (size_t)17 * MiB);
        { S5Args sa{ZB, S5A, S5B, S5C, in[19] + l * 256, S5S, Y5B, SELFCHECK ? CHKT + run * 64 + l * 16 + 5 : (unsigned long long*)nullptr};
          CHK(l * 16 + 5, ZB, (size_t)T * ZC * 2); CHK(l * 16 + 5, S5A, (size_t)32768); CHK(l * 16 + 5, S5B, (size_t)131072);
          hipLaunchKernelGGL(k_s5_pass1, dim3(grid), dim3(NTHR), LDS_BYTES, stream, sa);
          CHK(l * 16 + 6, S5S, (size_t)NB * 2 * NCHK * 16 * 64 * 8);
          hipLaunchKernelGGL(k_s5_pass2, dim3(grid), dim3(NTHR), LDS_BYTES, stream, sa); }
        CHK(l * 16 + 7, Y5B, (size_t)17 * MiB);
        { NaArgs na{ZB, VTN, OB, in[7] + (size_t)l * 4 * 15 * 31};
          hipLaunchKernelGGL(k_na2, dim3(grid), dim3(NTHR), LDS_BYTES, stream, na); }
        { AttnArgs aa{QM, KM, VTM, OB, nullptr, nullptr, lam_init, 0};
          hipLaunchKernelGGL(k_attn<1>, dim3(grid), dim3(NTHR), LDS_BYTES, stream, aa); }
        { AttnArgs aa{QD, KD, VTD, OB, LAMV + l * 128, in[25] + l * 64, lam_init, 0};
          hipLaunchKernelGGL(k_attn<2>, dim3(grid), dim3(NTHR), LDS_BYTES, stream, aa); }
        { GemmArgs ga{Y5B, WGLU, OB, T / 256, 2, 256, 256, 256, D, 512, 0};
          hipLaunchKernelGGL(k_gemm<pg8::EpiPair<true>>, dim3(grid), dim3(NTHR), LDS_BYTES, stream, ga); }
        CHK(l * 16 + 9, OB, (size_t)T * D * 2);
        { Gemm2Args ga{Hb, WING + (size_t)ZC * D, GB, in[28] + (size_t)l * 4 * D, nullptr, T / 256, 4 * D / 256, D, D, D, 4 * D};
          hipLaunchKernelGGL(k_gemm_gate, dim3(grid), dim3(NTHR), LDS_BYTES, stream, ga); }
        CHK(l * 16 + 10, GB, (size_t)T * 4 * D * 2);
        { Gemm2Args ga{OB, WBR, MB, nullptr, GB, T / 256, 4, 256, D, 256, D};
          hipLaunchKernelGGL(k_gemm_merge, dim3(grid), dim3(NTHR), LDS_BYTES, stream, ga); }
        CHK(l * 16 + 11, MB, (size_t)T * D * 2);
        { GemmArgs ga{MB, WOUT, YB, T / 256, D / 256, D, D, D, D, 0, 0};
          hipLaunchKernelGGL(k_gemm<pg8::EpiStore>, dim3(grid), dim3(NTHR), LDS_BYTES, stream, ga); }
        CHK(l * 16 + 12, YB, (size_t)T * D * 2);
        hipLaunchKernelGGL(k_lnh<true>, dim3(T / 4), dim3(256), 0, stream, X, (const void*)YB, MODl, 2 * D, in[30] + l * D, in[31] + l * D, (float*)nullptr, Hb, MODl, 3 * D, 4 * D);
        CHK(l * 16 + 13, X, (size_t)T * D * 4);
        const int j = l / 2;
        if ((l & 1) == 0) {
            ConvFfn cf{in[34] + (size_t)j * D * DFF, in[35] + (size_t)j * D * DFF, in[36] + (size_t)j * DFF * D, W13, W2T};
            hipLaunchKernelGGL(k_conv_ffn, dim3(grid), dim3(NTHR), LDS_BYTES, stream, cf);
            GemmArgs g1{Hb, W13, ACTb, T / 256, 2 * DFF / 256, D, D, D, DFF, 0, 0};
            hipLaunchKernelGGL(k_gemm<pg8::EpiPair<false>>, dim3(grid), dim3(NTHR), LDS_BYTES, stream, g1);
            GemmArgs g2{ACTb, W2T, Fb, T / 256, D / 256, DFF, DFF, DFF, D, 0, 0};
            hipLaunchKernelGGL(k_gemm<pg8::EpiStore>, dim3(grid), dim3(NTHR), LDS_BYTES, stream, g2);
        } else {
            hipMemsetAsync(PLAN, 0, 4096, stream);
            ConvMoe cm{in[38] + (size_t)j * NE * D * DFF, in[39] + (size_t)j * NE * D * DFF, in[40] + (size_t)j * NE * DFF * D, W13E, W2TE};
            hipLaunchKernelGGL(k_conv_moe, dim3(grid), dim3(NTHR), LDS_BYTES, stream, cm);
            hipLaunchKernelGGL(k_route2, dim3(T / 4), dim3(256), 0, stream, X, MODl, in[37] + (size_t)j * D * 8, PLAN, LTOK, TSLOT, TGATE);
            hipLaunchKernelGGL(k_moe_plan, dim3(1), dim3(64), 0, stream, PLAN);
            hipLaunchKernelGGL(k_gather, dim3(MAXTILES * 256 / 4), dim3(256), 0, stream, Hb, HG, PLAN, LTOK);
            MoeGemmArgs m1{HG, W13E, ACTE, PLAN, 2 * DFF / 256, D, D, D, DFF, 0, (size_t)2 * DFF * D};
            hipLaunchKernelGGL(k_gemm_moe<pg8::EpiPair<false>>, dim3(grid), dim3(NTHR), LDS_BYTES, stream, m1);
            MoeGemmArgs m2{ACTE, W2TE, HG, PLAN, D / 256, DFF, DFF, DFF, D, 0, (size_t)D * DFF};
            hipLaunchKernelGGL(k_gemm_moe<pg8::EpiStore>, dim3(grid), dim3(NTHR), LDS_BYTES, stream, m2);
        }
        if ((l & 1) == 0) hipLaunchKernelGGL(k_lnh<true>, dim3(T / 4), dim3(256), 0, stream, X, (const void*)Fb, MODl, 5 * D, in[32] + l * D, in[33] + l * D, l == DEPTH - 1 ? (float*)d_out : (float*)nullptr, l == DEPTH - 1 ? (bf16_t*)nullptr : Hb, MODl + 9 * 6144, 0, D);
        else hipLaunchKernelGGL(k_ln_moe, dim3(T / 4), dim3(256), 0, stream, X, HG, PLAN, TSLOT, TGATE, MODl, 5 * D, in[32] + l * D, in[33] + l * D, l == DEPTH - 1 ? (float*)d_out : (float*)nullptr, l == DEPTH - 1 ? (bf16_t*)nullptr : Hb, MODl + 9 * 6144);
        CHK(l * 16 + 14, X, (size_t)T * D * 4);
    }
    }
    if (SELFCHECK) hipLaunchKernelGGL(k_chk_final, dim3(1024), dim3(256), 0, stream, CHKT, 64, (float*)d_out, (size_t)TL * D);
}
#endif
```

```cpp
#include <hip/hip_runtime.h>
#include <cstdint>
#include <cstdio>
#include <type_traits>
#ifndef XBF
#define XBF 1
#endif
#ifndef G8
#define G8 1
#endif

constexpr int D = 1024, NB = 8, SQ = 4096, CL = 256, DEPTH = 4;
constexpr int TL = NB * SQ, TC = NB * CL, T = TL + TC;
constexpr int INC = 2208, EC = 896, DFF = 3584, NE = 8;
constexpr int O_NAQ = 0, O_NAK = 256, O_NAV = 512, O_MQ = 768, O_MKV = 1024, O_MKR = 1152, O_S5 = 1184, O_DQ = 1440, O_DK = 1696, O_DV = 1952;
constexpr float ALPHA = 1.681792830507429f;
constexpr size_t MiB = 1u << 20;
constexpr size_t WS_COND = 0, WS_MOD = 1 * MiB, WS_CNT = 3 * MiB, WS_LTOK = 4 * MiB, WS_LGATE = 6 * MiB, WS_X = 8 * MiB, WS_O = 144 * MiB, WS_MG = 280 * MiB,
                 WS_TG = 416 * MiB, WS_E = 552 * MiB, WS_Y5 = 671 * MiB, WS_Z = 705 * MiB, WS_H = 999 * MiB, WS_W13 = 1067 * MiB, WS_W2T = 1081 * MiB, WS_END = 1122 * MiB;
constexpr int CH = 8704;
#ifndef MERGE_NAIVE
#define MERGE_NAIVE 0
#endif

__device__ __forceinline__ int modrow(int r) { return r < TL ? (r >> 12) : 8; }
__device__ __forceinline__ float sigm(float v) { return 1.f / (1.f + expf(-v)); }

__global__ void k_lamv(const float* q1, const float* k1, const float* q2, const float* k2, float* LAMV) {
    const int i = threadIdx.x, l = i >> 7, w = (i >> 5) & 3, j = i & 31; const float* src = w == 0 ? q1 : (w == 1 ? k1 : (w == 2 ? q2 : k2)); LAMV[i] = src[l * 32 + j];
}
__global__ void k_cond(const float* c, const float* c_ctx, float* COND) {
    int i = blockIdx.x * 256 + threadIdx.x;
    if (i >= 9 * D) return;
    float v = i < 8 * D ? c[i] : c_ctx[i - 8 * D];
    COND[i] = v * sigm(v);
}
__global__ void k_mod(const float* COND, const float* w_ada, const float* b_ada, float* MOD) {
    int n = blockIdx.x * 256 + threadIdx.x, l = blockIdx.y;
    float acc[9];
#pragma unroll
    for (int r = 0; r < 9; ++r) acc[r] = 0.f;
    const float* w = w_ada + (size_t)l * D * 6144 + n;
    for (int k = 0; k < D; ++k) { float wv = w[(size_t)k * 6144];
#pragma unroll
        for (int r = 0; r < 9; ++r) acc[r] += COND[r * D + k] * wv; }
    float bb = b_ada[l * 6144 + n];
#pragma unroll
    for (int r = 0; r < 9; ++r) MOD[((size_t)l * 9 + r) * 6144 + n] = acc[r] + bb;
}
__global__ void k_copy_in(const float* x, const float* ctx, float* X) {
    size_t i = (size_t)blockIdx.x * 256 + threadIdx.x;
    const size_t nl = (size_t)TL * D / 4, nt = (size_t)T * D / 4;
    if (i >= nt) return;
    ((float4*)X)[i] = i < nl ? ((const float4*)x)[i] : ((const float4*)ctx)[i - nl];
}

struct SG { const float* A; const float* B; float* C; const float* bias; const float* aux; const float* mod; const int* gather; const int* cnt; const float* gatew; const int* scat;
            int lda, ldb, ldc, ldaux, M, N, K, sh_off, sc_off, row0, arow0, first; };
template <int MODE> __global__ __launch_bounds__(256) void k_sgemm(SG p) {
    __shared__ float As[8][132];
    __shared__ float Bs[8][132];
    int Mlim = p.M;
    if (p.cnt) { int c = *p.cnt - p.row0; Mlim = c < Mlim ? c : Mlim; }
    const int bm = blockIdx.y * 128, bn = blockIdx.x * 128;
    if (bm >= Mlim) return;
    const int tid = threadIdx.x, ty = tid >> 4, tx = tid & 15;
    float acc[8][8];
#pragma unroll
    for (int i = 0; i < 8; ++i)
#pragma unroll
        for (int j = 0; j < 8; ++j) acc[i][j] = 0.f;
    const int ar = tid >> 1, ak = (tid & 1) * 4;
    int arow = bm + ar; const bool avalid = arow < Mlim;
    int asrc = 0; if (avalid) asrc = p.gather ? p.gather[p.arow0 + arow] : p.arow0 + arow;
    const float* ap = p.A + (size_t)asrc * p.lda + ak;
    const float* modp = nullptr; if (p.mod) modp = p.mod + (size_t)modrow(asrc) * 6144;
    const int bk = tid >> 5, bnn = (tid & 31) * 4;
    const bool bvalid = (bn + bnn) < p.N;
    const float* bp = p.B + (size_t)bk * p.ldb + bn + bnn;
    for (int k0 = 0; k0 < p.K; k0 += 8) {
        float4 av = make_float4(0.f, 0.f, 0.f, 0.f), bv = make_float4(0.f, 0.f, 0.f, 0.f);
        if (avalid) { av = *(const float4*)(ap + k0);
            if (modp) { const float4 sc = *(const float4*)(modp + p.sc_off + k0 + ak), sh = *(const float4*)(modp + p.sh_off + k0 + ak);
                av.x = av.x * (1.f + sc.x) + sh.x; av.y = av.y * (1.f + sc.y) + sh.y; av.z = av.z * (1.f + sc.z) + sh.z; av.w = av.w * (1.f + sc.w) + sh.w; } }
        if (bvalid) bv = *(const float4*)(bp + (size_t)k0 * p.ldb);
        __syncthreads();
        As[ak + 0][ar] = av.x; As[ak + 1][ar] = av.y; As[ak + 2][ar] = av.z; As[ak + 3][ar] = av.w;
        *(float4*)&Bs[bk][bnn] = bv;
        __syncthreads();
#pragma unroll
        for (int k = 0; k < 8; ++k) {
            float a[8], b[8];
            *(float4*)&a[0] = *(const float4*)&As[k][ty * 8]; *(float4*)&a[4] = *(const float4*)&As[k][ty * 8 + 4];
            *(float4*)&b[0] = *(const float4*)&Bs[k][tx * 8]; *(float4*)&b[4] = *(const float4*)&Bs[k][tx * 8 + 4];
#pragma unroll
            for (int i = 0; i < 8; ++i)
#pragma unroll
                for (int j = 0; j < 8; ++j) acc[i][j] += a[i] * b[j];
        }
    }
#pragma unroll
    for (int i = 0; i < 8; ++i) {
        const int r = bm + ty * 8 + i; if (r >= Mlim) continue;
        int tok = 0; float gw = 0.f;
        if (MODE == 5) { tok = p.scat[p.row0 + r]; gw = p.gatew[p.row0 + r]; }
#pragma unroll
        for (int j = 0; j < 8; ++j) {
            const int c = bn + tx * 8 + j; if (c >= p.N) continue;
            float v = acc[i][j];
            float* cp = p.C + (size_t)r * p.ldc + c;
            if (MODE == 0) { if (p.bias) v += p.bias[c]; *cp = v; }
            if (MODE == 1) { *cp = sigm(v + p.bias[c]); }
            if (MODE == 2) { float o = p.first ? 0.f : *cp; *cp = o + p.aux[(size_t)r * p.ldaux + c] * v; }
            if (MODE == 3) { *cp = v * sigm(v); }
            if (MODE == 4) { *cp = *cp * v; }
            if (MODE == 5) { float* fp = p.C + (size_t)tok * p.ldc + c; *fp = *fp + gw * v; }
        }
    }
}

__global__ __launch_bounds__(256) void k_rms(float* Z, const float* gq, const float* gkv) {
    const int r = blockIdx.x * 4 + (threadIdx.x >> 6), lane = threadIdx.x & 63;
    float* z = Z + (size_t)r * INC;
    float4 q = *(float4*)(z + O_MQ + lane * 4); float2 kv = *(float2*)(z + O_MKV + lane * 2);
    float sq = q.x * q.x + q.y * q.y + q.z * q.z + q.w * q.w, sk = kv.x * kv.x + kv.y * kv.y;
#pragma unroll
    for (int o = 1; o < 64; o <<= 1) { sq += __shfl_xor(sq, o); sk += __shfl_xor(sk, o); }
    const float rq = rsqrtf(sq / 256.f + 1e-6f), rk = rsqrtf(sk / 128.f + 1e-6f);
    const float4 g4 = *(const float4*)(gq + lane * 4); const float2 g2 = *(const float2*)(gkv + lane * 2);
    q.x *= rq * g4.x; q.y *= rq * g4.y; q.z *= rq * g4.z; q.w *= rq * g4.w; kv.x *= rk * g2.x; kv.y *= rk * g2.y;
    *(float4*)(z + O_MQ + lane * 4) = q; *(float2*)(z + O_MKV + lane * 2) = kv;
}
__global__ __launch_bounds__(256) void k_rope(float* Z, float* E) {
    const int idx = blockIdx.x * 256 + threadIdx.x;
    if (idx >= TL * 21) return;
    const int r = idx / 21, v = idx % 21;
    float* z;
    if (v == 0) z = Z + (size_t)r * INC + O_MKR;
    else if (v < 9) z = Z + (size_t)r * INC + O_DQ + (v - 1) * 32;
    else if (v < 17) z = Z + (size_t)r * INC + O_DK + (v - 9) * 32;
    else z = E + (size_t)r * EC + (v - 17) * 96 + 64;
    const int t = r & (SQ - 1), prow = t >> 6, pcol = t & 63;
#pragma unroll
    for (int half = 0; half < 2; ++half) { const float pp = (float)(half ? pcol : prow);
#pragma unroll
        for (int i = 0; i < 8; ++i) { const float inv = exp2f(-(float)i * 0.125f * 13.287712379549449f); float sn, cs; sincosf(pp * inv, &sn, &cs);
            const float z1 = z[half * 16 + i], z2 = z[half * 16 + 8 + i];
            z[half * 16 + i] = z1 * cs - z2 * sn; z[half * 16 + 8 + i] = z1 * sn + z2 * cs; } }
}

#define ONLINE(m, l, acc, s, vp) do { const float mn_ = fmaxf(m, s); const float c_ = __expf(m - mn_), p_ = __expf(s - mn_); l = l * c_ + p_; m = mn_; \
    _Pragma("unroll") for (int d_ = 0; d_ < 64; d_ += 4) { const float4 v4_ = *(const float4*)((vp) + d_); acc[d_] = acc[d_] * c_ + p_ * v4_.x; acc[d_ + 1] = acc[d_ + 1] * c_ + p_ * v4_.y; \
        acc[d_ + 2] = acc[d_ + 2] * c_ + p_ * v4_.z; acc[d_ + 3] = acc[d_ + 3] * c_ + p_ * v4_.w; } } while (0)

__global__ __launch_bounds__(256) void k_mla(const float* __restrict__ E, const float* __restrict__ Z, float* __restrict__ O) {
    const int r = blockIdx.x * 256 + threadIdx.x, h = blockIdx.y;
    const bool isctx = r >= TL; const int b = isctx ? (r - TL) / CL : r / SQ;
    float q[96];
#pragma unroll
    for (int i = 0; i < 96; ++i) q[i] = E[(size_t)r * EC + h * 96 + i] * 0.10206207261596575f;
    float m = -1e30f, l = 0.f, acc[64];
#pragma unroll
    for (int i = 0; i < 64; ++i) acc[i] = 0.f;
    const int nk = isctx ? CL : SQ + CL;
    for (int j = 0; j < nk; ++j) {
        const int kr = isctx ? TL + b * CL + j : (j < SQ ? b * SQ + j : TL + b * CL + (j - SQ));
        const float* kn = E + (size_t)kr * EC + 384 + h * 128; const float* kp = Z + (size_t)kr * INC + O_MKR;
        float s = 0.f;
#pragma unroll
        for (int i = 0; i < 64; i += 4) { const float4 k4 = *(const float4*)(kn + i); s += q[i] * k4.x + q[i + 1] * k4.y + q[i + 2] * k4.z + q[i + 3] * k4.w; }
#pragma unroll
        for (int i = 0; i < 32; i += 4) { const float4 k4 = *(const float4*)(kp + i); s += q[64 + i] * k4.x + q[65 + i] * k4.y + q[66 + i] * k4.z + q[67 + i] * k4.w; }
        ONLINE(m, l, acc, s, kn + 64);
    }
    const float il = 1.f / l;
#pragma unroll
    for (int d = 0; d < 64; ++d) O[(size_t)r * D + 256 + h * 64 + d] = acc[d] * il;
}

__global__ __launch_bounds__(256) void k_diff(const float* __restrict__ Z, float* __restrict__ O, const float* lq1, const float* lk1, const float* lq2, const float* lk2, const float* subln, float lam_init) {
    const int r = blockIdx.x * 256 + threadIdx.x, h = blockIdx.y;
    const bool isctx = r >= TL; const int b = isctx ? (r - TL) / CL : r / SQ;
    float s1 = 0.f, s2 = 0.f;
    for (int i = 0; i < 32; ++i) { s1 += lq1[i] * lk1[i]; s2 += lq2[i] * lk2[i]; }
    const float lam = expf(s1) - expf(s2) + lam_init;
    float q1[32], q2[32];
#pragma unroll
    for (int i = 0; i < 32; ++i) { q1[i] = Z[(size_t)r * INC + O_DQ + h * 64 + i] * 0.17677669529663687f; q2[i] = Z[(size_t)r * INC + O_DQ + h * 64 + 32 + i] * 0.17677669529663687f; }
    float m1 = -1e30f, l1 = 0.f, m2 = -1e30f, l2 = 0.f, a1[64], a2[64];
#pragma unroll
    for (int i = 0; i < 64; ++i) { a1[i] = 0.f; a2[i] = 0.f; }
    const int nk = isctx ? CL : SQ + CL;
    for (int j = 0; j < nk; ++j) {
        const int kr = isctx ? TL + b * CL + j : (j < SQ ? b * SQ + j : TL + b * CL + (j - SQ));
        const float* k1 = Z + (size_t)kr * INC + O_DK + h * 64; const float* vp = Z + (size_t)kr * INC + O_DV + h * 64;
        float sa = 0.f, sb = 0.f;
#pragma unroll
        for (int i = 0; i < 32; i += 4) { const float4 ka = *(const float4*)(k1 + i), kb = *(const float4*)(k1 + 32 + i);
            sa += q1[i] * ka.x + q1[i + 1] * ka.y + q1[i + 2] * ka.z + q1[i + 3] * ka.w; sb += q2[i] * kb.x + q2[i + 1] * kb.y + q2[i + 2] * kb.z + q2[i + 3] * kb.w; }
        ONLINE(m1, l1, a1, sa, vp);
        ONLINE(m2, l2, a2, sb, vp);
    }
    const float i1 = 1.f / l1, i2 = lam / l2; float ss = 0.f;
#pragma unroll
    for (int d = 0; d < 64; ++d) { a1[d] = a1[d] * i1 - a2[d] * i2; ss += a1[d] * a1[d]; }
    const float rr = rsqrtf(ss / 64.f + 1e-6f) * (1.f - lam_init);
#pragma unroll
    for (int d = 0; d < 64; ++d) O[(size_t)r * D + 768 + h * 64 + d] = a1[d] * rr * subln[d];
}

__global__ __launch_bounds__(256) void k_na(const float* __restrict__ Z, float* __restrict__ O, const float* __restrict__ rpb) {
    const int r = blockIdx.x * 256 + threadIdx.x, h = blockIdx.y;
    const bool isctx = r >= TL; const int b = isctx ? (r - TL) / CL : r / SQ;
    float q[64];
#pragma unroll
    for (int i = 0; i < 64; ++i) q[i] = Z[(size_t)r * INC + O_NAQ + h * 64 + i] * 0.125f;
    float m = -1e30f, l = 0.f, acc[64];
#pragma unroll
    for (int i = 0; i < 64; ++i) acc[i] = 0.f;
    if (!isctx) {
        const int t = r & (SQ - 1), gr = t >> 6, gc = t & 63;
        const int r0 = min(max(gr - 4, 0), 56), cs = min(max(gc - 8, 0), 48);
        for (int i = 0; i < 8; ++i) for (int j = 0; j < 16; ++j) {
            const int kt = b * SQ + (r0 + i) * 64 + cs + j;
            const float* kp = Z + (size_t)kt * INC + O_NAK + h * 64; const float* vp = Z + (size_t)kt * INC + O_NAV + h * 64;
            float s = rpb[(h * 15 + (r0 + i - gr + 7)) * 31 + (cs + j - gc + 15)];
#pragma unroll
            for (int d = 0; d < 64; d += 4) { const float4 k4 = *(const float4*)(kp + d); s += q[d] * k4.x + q[d + 1] * k4.y + q[d + 2] * k4.z + q[d + 3] * k4.w; }
            ONLINE(m, l, acc, s, vp);
        }
    }
    for (int j = 0; j < CL; ++j) {
        const int kt = TL + b * CL + j;
        const float* kp = Z + (size_t)kt * INC + O_NAK + h * 64; const float* vp = Z + (size_t)kt * INC + O_NAV + h * 64;
        float s = 0.f;
#pragma unroll
        for (int d = 0; d < 64; d += 4) { const float4 k4 = *(const float4*)(kp + d); s += q[d] * k4.x + q[d + 1] * k4.y + q[d + 2] * k4.z + q[d + 3] * k4.w; }
        ONLINE(m, l, acc, s, vp);
    }
    const float il = 1.f / l;
#pragma unroll
    for (int d = 0; d < 64; ++d) O[(size_t)r * D + h * 64 + d] = acc[d] * il;
}

__global__ __launch_bounds__(64) void k_s5(int dir, const float* __restrict__ Z, float* Y5, const float* lam_re, const float* lam_im, const float* log_dt,
                                           const float* b_re, const float* b_im, const float* c_re, const float* c_im, const float* s5d) {
    const int b = blockIdx.x >> 4, g = blockIdx.x & 15, p = threadIdx.x;
    const int gi = dir * 16 + g;
    const double lre = lam_re[gi * 64 + p], lim = lam_im[gi * 64 + p], dt = exp((double)log_dt[gi]);
    const double er = exp(lre * dt); double ang = lim * dt; ang -= 6.283185307179586476925 * rint(ang / 6.283185307179586476925);
    float sn, cs; sincosf((float)ang, &sn, &cs);
    const double ar = er * cs, ai = er * sn;
    const double nr = ar - 1.0, ni = ai, den = lre * lre + lim * lim;
    const float fr = (float)((nr * lre + ni * lim) / den), fi = (float)((ni * lre - nr * lim) / den);
    float bbr[16], bbi[16], cr[16], ci[16], dsk[16];
#pragma unroll
    for (int c = 0; c < 16; ++c) { const float br = b_re[(gi * 64 + p) * 16 + c], bi = b_im[(gi * 64 + p) * 16 + c];
        bbr[c] = fr * br - fi * bi; bbi[c] = fr * bi + fi * br; cr[c] = c_re[(gi * 16 + c) * 64 + p]; ci[c] = c_im[(gi * 16 + c) * 64 + p]; dsk[c] = s5d[g * 16 + c]; }
    double hr = 0.0, hi = 0.0;
    for (int s = 0; s < SQ + CL; ++s) {
        int row;
        if (dir == 0) row = s < CL ? TL + b * CL + s : b * SQ + (s - CL);
        else row = s < CL ? TL + b * CL + (CL - 1 - s) : b * SQ + (SQ - 1 - (s - CL));
        const float* u = Z + (size_t)row * INC + O_S5 + g * 16;
        float uu[16];
#pragma unroll
        for (int c = 0; c < 16; c += 4) *(float4*)&uu[c] = *(const float4*)(u + c);
        float bur = 0.f, bui = 0.f;
#pragma unroll
        for (int c = 0; c < 16; ++c) { bur += bbr[c] * uu[c]; bui += bbi[c] * uu[c]; }
        const double nh = ar * hr - ai * hi + (double)bur; hi = ar * hi + ai * hr + (double)bui; hr = nh;
        const float hrf = (float)hr, hif = (float)hi;
        float v[16];
#pragma unroll
        for (int c = 0; c < 16; ++c) { v[c] = cr[c] * hrf - ci[c] * hif;
#pragma unroll
            for (int o = 1; o < 64; o <<= 1) v[c] += __shfl_xor(v[c], o); }
        if (p == 0) { float* y = Y5 + (size_t)row * 256 + g * 16;
#pragma unroll
            for (int c = 0; c < 16; ++c) y[c] = (dir == 0 ? dsk[c] * uu[c] : y[c]) + v[c]; }
    }
}
__global__ void k_glu(const float* G5, float* O) {
    const int i = blockIdx.x * 256 + threadIdx.x; const int r = i >> 8, c = i & 255;
    O[(size_t)r * D + 512 + c] = G5[(size_t)r * 512 + c] * sigm(G5[(size_t)r * 512 + 256 + c]);
}
__global__ __launch_bounds__(256) void k_ln(float* X, const float* Y, const float* MODl, int goff, const float* g, const float* bta, float* out) {
    const int r = blockIdx.x * 4 + (threadIdx.x >> 6), lane = threadIdx.x & 63;
    const float* md = MODl + (size_t)modrow(r) * 6144 + goff;
    float v[16]; float s = 0.f;
#pragma unroll
    for (int j = 0; j < 4; ++j) { const int c = j * 256 + lane * 4; const float4 x4 = *(const float4*)(X + (size_t)r * D + c), y4 = *(const float4*)(Y + (size_t)r * D + c), m4 = *(const float4*)(md + c);
        v[j * 4] = ALPHA * x4.x + m4.x * y4.x; v[j * 4 + 1] = ALPHA * x4.y + m4.y * y4.y; v[j * 4 + 2] = ALPHA * x4.z + m4.z * y4.z; v[j * 4 + 3] = ALPHA * x4.w + m4.w * y4.w;
        s += v[j * 4] + v[j * 4 + 1] + v[j * 4 + 2] + v[j * 4 + 3]; }
#pragma unroll
    for (int o = 1; o < 64; o <<= 1) s += __shfl_xor(s, o);
    const float mean = s / D; float q = 0.f;
#pragma unroll
    for (int j = 0; j < 16; ++j) { v[j] -= mean; q += v[j] * v[j]; }
#pragma unroll
    for (int o = 1; o < 64; o <<= 1) q += __shfl_xor(q, o);
    const float rstd = rsqrtf(q / D + 1e-5f);
#pragma unroll
    for (int j = 0; j < 4; ++j) { const int c = j * 256 + lane * 4; const float4 g4 = *(const float4*)(g + c), b4 = *(const float4*)(bta + c);
        float4 o4; o4.x = v[j * 4] * rstd * g4.x + b4.x; o4.y = v[j * 4 + 1] * rstd * g4.y + b4.y; o4.z = v[j * 4 + 2] * rstd * g4.z + b4.z; o4.w = v[j * 4 + 3] * rstd * g4.w + b4.w;
        *(float4*)(X + (size_t)r * D + c) = o4; if (out && r < TL) *(float4*)(out + (size_t)r * D + c) = o4; }
}
__global__ __launch_bounds__(256) void k_route(const float* X, const float* MODl, const float* wr, int* cnt, int* ltok, float* lgate) {
    const int r = blockIdx.x * 4 + (threadIdx.x >> 6), lane = threadIdx.x & 63;
    const float* md = MODl + (size_t)modrow(r) * 6144;
    float lg[8];
#pragma unroll
    for (int e = 0; e < 8; ++e) lg[e] = 0.f;
    for (int j = 0; j < 16; ++j) { const int k = j * 64 + lane; const float hv = X[(size_t)r * D + k] * (1.f + md[4 * D + k]) + md[3 * D + k];
        const float4 w0 = *(const float4*)(wr + k * 8), w1 = *(const float4*)(wr + k * 8 + 4);
        lg[0] += hv * w0.x; lg[1] += hv * w0.y; lg[2] += hv * w0.z; lg[3] += hv * w0.w; lg[4] += hv * w1.x; lg[5] += hv * w1.y; lg[6] += hv * w1.z; lg[7] += hv * w1.w; }
#pragma unroll
    for (int e = 0; e < 8; ++e)
#pragma unroll
        for (int o = 1; o < 64; o <<= 1) lg[e] += __shfl_xor(lg[e], o);
    if (lane == 0) {
        int e1 = 0; float v1 = lg[0];
#pragma unroll
        for (int e = 1; e < 8; ++e) if (lg[e] > v1) { v1 = lg[e]; e1 = e; }
        int e2 = -1; float v2 = -3e38f;
#pragma unroll
        for (int e = 0; e < 8; ++e) if (e != e1 && lg[e] > v2) { v2 = lg[e]; e2 = e; }
        const float p2 = expf(v2 - v1), g1 = 1.f / (1.f + p2), g2 = p2 / (1.f + p2);
        const int s1 = atomicAdd(cnt + e1, 1); ltok[e1 * T + s1] = r; lgate[e1 * T + s1] = g1;
        const int s2 = atomicAdd(cnt + e2, 1); ltok[e2 * T + s2] = r; lgate[e2 * T + s2] = g2;
    }
}


#define LAS __attribute__((address_space(3)))
__device__ __forceinline__ int otid() { int w = __builtin_amdgcn_readfirstlane((int)threadIdx.x); asm volatile("" : "+s"(w));
    int t = (w & ~63) + (int)__builtin_amdgcn_mbcnt_hi(~0u, __builtin_amdgcn_mbcnt_lo(~0u, 0u)); asm volatile("" : "+v"(t)); return t; }
typedef unsigned short bf16_t;
typedef short bf16x8 __attribute__((ext_vector_type(8)));
typedef float f32x4 __attribute__((ext_vector_type(4)));
typedef float f32x2 __attribute__((ext_vector_type(2)));
typedef unsigned u32x4 __attribute__((ext_vector_type(4)));
typedef unsigned u32x2 __attribute__((ext_vector_type(2)));
#ifndef LNPF
#define LNPF 1
#endif
#ifndef PFL2
#define PFL2 0
#endif
#ifdef KREP
#define KSC (1.f / KREP)
#else
#define KSC 1.f
#endif
namespace pg8 {
constexpr int BM = 256, BK = 64, HALF = 128, HTB = HALF * BK * 2, STAGE_BYTES = 8 * HTB, NXCD = 8, WGM = 4;
__host__ __device__ __forceinline__ int lds_byte(int r, int c) { const int st = (r >> 4) * 2 + (c >> 5), rr = r & 15, cc = c & 31, ob = rr * 64 + cc * 2; return st * 1024 + (ob ^ (((ob >> 9) & 1) << 5)); }
__host__ __device__ __forceinline__ void stage_rc(int b, int& R, int& C) { const int st = b / 1024, sb = b % 1024, swz = sb ^ (((sb >> 9) & 1) << 5); R = (st >> 1) * 16 + swz / 64; C = (st & 1) * 32 + (swz % 64) / 2; }
__host__ __device__ __forceinline__ int perm32(int rho) { const int n = rho >> 4, i = rho & 15; return 8 * (i >> 2) + 4 * n + (i & 3); }
typedef __bf16 bf16x2_t __attribute__((ext_vector_type(2)));
__device__ __forceinline__ unsigned cvt_pk_bf16(float lo, float hi) { const f32x2 v = {lo, hi}; return __builtin_bit_cast(unsigned, __builtin_convertvector(v, bf16x2_t)); }
typedef int v8i_t __attribute__((ext_vector_type(8)));
typedef int v4i_t __attribute__((ext_vector_type(4)));
__device__ __forceinline__ v8i_t cat8(bf16x8 lo, bf16x8 hi) { return __builtin_shufflevector(__builtin_bit_cast(v4i_t, lo), __builtin_bit_cast(v4i_t, hi), 0, 1, 2, 3, 4, 5, 6, 7); }
__device__ __forceinline__ float clamp8(float v) { return fminf(fmaxf(v, -448.f), 448.f); }
__device__ __forceinline__ unsigned pk4_fp8(float a, float b, float c, float d) { int w = 0; w = __builtin_amdgcn_cvt_pk_fp8_f32(clamp8(a), clamp8(b), w, false); w = __builtin_amdgcn_cvt_pk_fp8_f32(clamp8(c), clamp8(d), w, true); return (unsigned)w; }
constexpr float S8_H = 4.f, S8_W13 = 64.f, S8_ACT = 2.f, S8_W2 = 256.f;
struct Unit { const char* A; const char* B; int pm, pn, x0, x1; };
struct StaticOrder {
    int nM, nN, nwg, G, c; const char* A; const char* B; size_t tA, tB;
    __device__ void init(int nM_, int nN_, int G_, int c_, const void* A_, int lda, const void* B_, int ldb) { nM = nM_; nN = nN_; nwg = nM * nN; G = G_; c = c_; A = (const char*)A_; B = (const char*)B_; tA = (size_t)BM * lda * 2; tB = (size_t)BM * ldb * 2; }
    __device__ bool next(int i, Unit& u) const {
        const long L = (long)i * G + c; if (L >= nwg) return false;
        int wgid = (int)L; { const int q = nwg / NXCD, r = nwg % NXCD, xcd = wgid % NXCD, off = wgid / NXCD; wgid = (xcd < r ? xcd * (q + 1) : r * (q + 1) + (xcd - r) * q) + off; }
        const int nig = WGM * nN, gid = wgid / nig, fm = gid * WGM, gsz = (nM - fm) < WGM ? (nM - fm) : WGM;
        u.pm = fm + ((wgid % nig) % gsz); u.pn = (wgid % nig) / gsz; u.x0 = 0; u.x1 = 0;
        u.A = A + (size_t)u.pm * tA; u.B = B + (size_t)u.pn * tB; return true;
    }
};
template <class Epi, class Sched, bool F8 = false, bool I8 = false>
__device__ __forceinline__ void gemm_phase(LAS unsigned char* lds, const int K, const int lda, const int ldb, const Sched& S, const Epi& E) {
    const int tid = otid(), wid = __builtin_amdgcn_readfirstlane(tid >> 6), lane = tid & 63, wr = wid >> 2, wc = wid & 3, fr = lane & 15, fq = lane >> 4;
    const int nt = K / BK;
    constexpr bool PF = PFL2 && (I8 || F8);
    unsigned voffA[2], voffB[2];
#pragma unroll
    for (int i = 0; i < 2; ++i) { int R, C; stage_rc(tid * 16 + i * 8192, R, C); const int Rb = Epi::PERM ? ((R & ~31) + perm32(R & 31)) : R;
        voffA[i] = (unsigned)(R * lda + C) * 2u; voffB[i] = (unsigned)(Rb * ldb + C) * 2u; }
    const size_t kstep = (size_t)(BK * 2);
    const size_t hA = (size_t)HALF * lda * 2, hB = (size_t)HALF * ldb * 2;
    const unsigned ldsw = (unsigned)wid * 1024u;
    const int aoff = lds_byte(wr * 64 + fr, fq * 8), boff = lds_byte(wc * 32 + fr, fq * 8);
#define PG8_SA(b, h) (((b) * 2 + (h)) * HTB)
#define PG8_SB(b, h) ((4 + (b) * 2 + (h)) * HTB)
#define PG8_STAGE(bufoff, gbase, voff) do { _Pragma("unroll") for (int _i = 0; _i < 2; ++_i) \
        __builtin_amdgcn_global_load_lds((const unsigned*)((const char*)(gbase) + (voff)[_i]), (LAS unsigned*)(lds + (bufoff) + ldsw + _i * 8192), 16, 0, 0); } while (0)
#define PG8_LDA(dst, b, h) do { _Pragma("unroll") for (int m = 0; m < 4; ++m) { if constexpr (F8) dst##8[m] = cat8(*(const LAS bf16x8*)(lds + PG8_SA(b, h) + aoff + m * 2048), *(const LAS bf16x8*)(lds + PG8_SA(b, h) + aoff + m * 2048 + 1024)); \
        else { _Pragma("unroll") for (int k = 0; k < 2; ++k) dst[m][k] = *(const LAS bf16x8*)(lds + PG8_SA(b, h) + aoff + m * 2048 + k * 1024); } } } while (0)
#define PG8_LDB(dst, b, h) do { _Pragma("unroll") for (int n = 0; n < 2; ++n) { if constexpr (F8) dst##8[n] = cat8(*(const LAS bf16x8*)(lds + PG8_SB(b, h) + boff + n * 2048), *(const LAS bf16x8*)(lds + PG8_SB(b, h) + boff + n * 2048 + 1024)); \
        else { _Pragma("unroll") for (int k = 0; k < 2; ++k) dst[n][k] = *(const LAS bf16x8*)(lds + PG8_SB(b, h) + boff + n * 2048 + k * 1024); } } } while (0)
#define PG8_MMA(ai, bj, At, Bt) do { __builtin_amdgcn_s_setprio(1); _Pragma("unroll") for (int m = 0; m < 4; ++m) _Pragma("unroll") for (int n = 0; n < 2; ++n) { \
        if constexpr (F8) asm volatile("v_mfma_f32_16x16x128_f8f6f4 %0, %1, %2, %0" : "+v"(acc[ai][bj][m][n]) : "v"(Bt##8[n]), "v"(At##8[m]));   \
        else if constexpr (I8) { _Pragma("unroll") for (int k = 0; k < 2; ++k) acc[ai][bj][m][n] = __builtin_bit_cast(f32x4, __builtin_amdgcn_mfma_i32_16x16x64_i8(__builtin_bit_cast(v4i_t, Bt[n][k]), __builtin_bit_cast(v4i_t, At[m][k]), __builtin_bit_cast(v4i_t, acc[ai][bj][m][n]), 0, 0, 0)); } \
        else { _Pragma("unroll") for (int k = 0; k < 2; ++k) acc[ai][bj][m][n] = __builtin_amdgcn_mfma_f32_16x16x32_bf16(Bt[n][k], At[m][k], acc[ai][bj][m][n], 0, 0, 0); } } \
        __builtin_amdgcn_s_setprio(0); } while (0)
#define PG8_WAIT_V(n) asm volatile("s_waitcnt vmcnt(" #n ")" ::: "memory")
#define PG8_WAIT_L(n) asm volatile("s_waitcnt lgkmcnt(" #n ")" ::: "memory")
#define PG8_PREFETCH() do { const int prow_ = (wid & 3) * 64 + (int)__builtin_amdgcn_mbcnt_hi(~0u, __builtin_amdgcn_mbcnt_lo(~0u, 0u));     \
        const char* pb_ = (wid & 4) ? nB + (size_t)prow_ * ldb * 2 : nA + (size_t)prow_ * lda * 2; \
        _Pragma("unroll") for (int c_ = 0; c_ < 6; ++c_) { const int cc_ = (2 + c_ < nt) ? 2 + c_ : nt - 1; \
            __builtin_amdgcn_global_load_lds((const unsigned*)(pb_ + (size_t)cc_ * 128), (LAS unsigned*)(lds + 131072 + wid * 256), 4, 0, 0); } } while (0)
#define PG8_WAIT_V8P do { if (pfi) asm volatile("s_waitcnt vmcnt(14)" ::: "memory"); else asm volatile("s_waitcnt vmcnt(8)" ::: "memory"); } while (0)
#define PG8_BAR __builtin_amdgcn_s_barrier()
#define PG8_SCHED __builtin_amdgcn_sched_barrier(0)
    Unit cur, nxt; int ui = 0;
    if (!S.next(0, cur)) return;
    f32x4 acc[2][2][4][2];
#pragma unroll
    for (int a = 0; a < 2; ++a)
#pragma unroll
        for (int b = 0; b < 2; ++b)
#pragma unroll
            for (int m = 0; m < 4; ++m)
#pragma unroll
                for (int n = 0; n < 2; ++n) acc[a][b][m][n] = (f32x4){0.f, 0.f, 0.f, 0.f};
    bf16x8 At[4][2], B0[2][2], B1[2][2]; v8i_t At8[4], B08[2], B18[2]; (void)At; (void)B0; (void)B1; (void)At8; (void)B08; (void)B18;
    const char* cA = cur.A; const char* cB = cur.B;
    PG8_STAGE(PG8_SB(0, 0), cB, voffB); PG8_STAGE(PG8_SB(0, 1), cB + hB, voffB); PG8_STAGE(PG8_SA(0, 0), cA, voffA); PG8_STAGE(PG8_SA(0, 1), cA + hA, voffA);
    if (wr == 1) PG8_BAR;
    PG8_WAIT_V(2); PG8_BAR;
    PG8_STAGE(PG8_SB(1, 0), cB + kstep, voffB); PG8_STAGE(PG8_SA(1, 0), cA + kstep, voffA); PG8_STAGE(PG8_SB(1, 1), cB + hB + kstep, voffB);
    PG8_WAIT_V(6); PG8_BAR;
    for (;;) {
        const bool has_next = S.next(ui + 1, nxt);
        const char* nA = has_next ? nxt.A : cA; const char* nB = has_next ? nxt.B : cB;
#ifdef KREP
#pragma unroll 1
        for (int kr = 0; kr < (I8 ? KREP : 1); ++kr) { const char* eA = (kr == (I8 ? KREP : 1) - 1) ? nA : cA; const char* eB = (kr == (I8 ? KREP : 1) - 1) ? nB : cB;
#else
        { const char* eA = nA; const char* eB = nB;
#endif
#pragma unroll 1
        for (int t = 0; t < nt; t += 2) {
            const bool last = (t == nt - 2);
            const bool pfi = PF && last && has_next;
            const char* a1 = cA + (size_t)(t + 1) * kstep;
            const char* a2 = last ? eA : cA + (size_t)(t + 2) * kstep; const char* b2 = last ? eB : cB + (size_t)(t + 2) * kstep;
            const char* a3 = a2 + kstep; const char* b3 = b2 + kstep;
            PG8_LDB(B0, 0, 0); PG8_LDB(B1, 0, 1); PG8_SCHED; PG8_LDA(At, 0, 0); PG8_STAGE(PG8_SA(1, 1), a1 + hA, voffA);
            PG8_WAIT_V(8); PG8_WAIT_L(0); PG8_BAR; PG8_MMA(0, 0, At, B0); PG8_MMA(0, 1, At, B1); PG8_BAR; PG8_SCHED;
            PG8_LDA(At, 0, 1); if (pfi) PG8_PREFETCH(); PG8_STAGE(PG8_SB(0, 0), b2, voffB); PG8_STAGE(PG8_SB(0, 1), b2 + hB, voffB); PG8_STAGE(PG8_SA(0, 0), a2, voffA);
            PG8_WAIT_V8P; PG8_WAIT_L(0); PG8_BAR; PG8_MMA(1, 0, At, B0); PG8_MMA(1, 1, At, B1); PG8_BAR; PG8_SCHED;
            PG8_LDB(B0, 1, 0); PG8_LDB(B1, 1, 1); PG8_SCHED; PG8_LDA(At, 1, 0); PG8_STAGE(PG8_SA(0, 1), a2 + hA, voffA);
            PG8_WAIT_V8P; PG8_WAIT_L(0); PG8_BAR; PG8_MMA(0, 0, At, B0); PG8_MMA(0, 1, At, B1); PG8_BAR; PG8_SCHED;
            PG8_LDA(At, 1, 1); PG8_STAGE(PG8_SB(1, 0), b3, voffB); PG8_STAGE(PG8_SB(1, 1), b3 + hB, voffB); PG8_STAGE(PG8_SA(1, 0), a3, voffA);
            PG8_WAIT_V(8); PG8_WAIT_L(0); PG8_BAR; PG8_MMA(1, 0, At, B0); PG8_MMA(1, 1, At, B1); PG8_BAR; PG8_SCHED;
        }
        }
        if (wr == 0) PG8_BAR;
        if constexpr (F8) asm volatile("s_nop 15\n\ts_nop 15" ::: "memory");
        { int le_ = (int)__builtin_amdgcn_mbcnt_hi(~0u, __builtin_amdgcn_mbcnt_lo(~0u, 0u)); asm volatile("" : "+v"(le_));
          E(acc, cur, wr, wc, le_ & 15, le_ >> 4); }
#ifdef DUP_EPI
        if constexpr (I8) { asm volatile("" ::: "memory"); E(acc, cur, wr, wc, fr, fq); }
#endif
        if (!has_next) break;
#pragma unroll
        for (int a = 0; a < 2; ++a)
#pragma unroll
            for (int b = 0; b < 2; ++b)
#pragma unroll
                for (int m = 0; m < 4; ++m)
#pragma unroll
                    for (int n = 0; n < 2; ++n) acc[a][b][m][n] = (f32x4){0.f, 0.f, 0.f, 0.f};
        cur = nxt; cA = nA; cB = nB; ++ui;
        if (wr == 1) PG8_BAR;
    }
    PG8_WAIT_V(0);
    PG8_BAR;
#undef PG8_SA
#undef PG8_SB
#undef PG8_STAGE
#undef PG8_LDA
#undef PG8_LDB
#undef PG8_MMA
#undef PG8_WAIT_V
#undef PG8_PREFETCH
#undef PG8_WAIT_V8P
#undef PG8_WAIT_L
#undef PG8_BAR
#undef PG8_SCHED
}
struct EpiStoreS {
    static constexpr bool PERM = true;
    bf16_t* O; int ldc; float scale;
    __device__ __forceinline__ void operator()(const f32x4 (&acc)[2][2][4][2], const Unit& u, int wr, int wc, int fr, int fq) const {
        const int row0 = u.pm * BM + wr * 64 + fr, col0 = u.pn * BM + wc * 32 + 8 * fq;
#pragma unroll
        for (int ai = 0; ai < 2; ++ai)
#pragma unroll
            for (int m = 0; m < 4; ++m) { bf16_t* rowp = O + (size_t)(row0 + ai * HALF + m * 16) * ldc + col0;
#pragma unroll
                for (int bj = 0; bj < 2; ++bj) { const f32x4 v0 = acc[ai][bj][m][0] * scale, v1 = acc[ai][bj][m][1] * scale;
                    u32x4 w; w.x = cvt_pk_bf16(v0[0], v0[1]); w.y = cvt_pk_bf16(v0[2], v0[3]); w.z = cvt_pk_bf16(v1[0], v1[1]); w.w = cvt_pk_bf16(v1[2], v1[3]);
                    *(u32x4*)(rowp + bj * HALF) = w; } }
    }
};
struct EpiStore {
    static constexpr bool PERM = true;
    bf16_t* O; int ldc;
    __device__ __forceinline__ void operator()(const f32x4 (&acc)[2][2][4][2], const Unit& u, int wr, int wc, int fr, int fq) const {
        const int row0 = u.pm * BM + wr * 64 + fr, col0 = u.pn * BM + wc * 32 + 8 * fq;
#pragma unroll
        for (int ai = 0; ai < 2; ++ai)
#pragma unroll
            for (int m = 0; m < 4; ++m) { bf16_t* rowp = O + (size_t)(row0 + ai * HALF + m * 16) * ldc + col0;
#pragma unroll
                for (int bj = 0; bj < 2; ++bj) { const f32x4 v0 = acc[ai][bj][m][0], v1 = acc[ai][bj][m][1];
                    u32x4 w; w.x = cvt_pk_bf16(v0[0], v0[1]); w.y = cvt_pk_bf16(v0[2], v0[3]); w.z = cvt_pk_bf16(v1[0], v1[1]); w.w = cvt_pk_bf16(v1[2], v1[3]);
                    *(u32x4*)(rowp + bj * HALF) = w; } }
    }
};
__device__ __forceinline__ float fsig(float v) { return __builtin_amdgcn_rcpf(1.f + __builtin_amdgcn_exp2f(-1.4426950408889634f * v)); }
template <bool GLU> struct EpiPair {
    static constexpr bool PERM = true;
    bf16_t* O; int ldc; int col_off;
    __device__ __forceinline__ void operator()(const f32x4 (&acc)[2][2][4][2], const Unit& u, int wr, int wc, int fr, int fq) const {
        const int row0 = u.pm * BM + wr * 64 + fr, col0 = col_off + u.pn * 128 + wc * 16 + 4 * fq;
#pragma unroll
        for (int ai = 0; ai < 2; ++ai)
#pragma unroll
            for (int m = 0; m < 4; ++m) { bf16_t* rowp = O + (size_t)(row0 + ai * HALF + m * 16) * ldc + col0;
#pragma unroll
                for (int bj = 0; bj < 2; ++bj) { const f32x4 v0 = acc[ai][bj][m][0], v1 = acc[ai][bj][m][1];
                    float o0, o1, o2, o3;
                    if (GLU) { o0 = v0[0] * fsig(v0[1]); o1 = v0[2] * fsig(v0[3]); o2 = v1[0] * fsig(v1[1]); o3 = v1[2] * fsig(v1[3]); }
                    else { o0 = v0[0] * fsig(v0[0]) * v0[1]; o1 = v0[2] * fsig(v0[2]) * v0[3]; o2 = v1[0] * fsig(v1[0]) * v1[1]; o3 = v1[2] * fsig(v1[2]) * v1[3]; }
                    u32x2 w; w.x = cvt_pk_bf16(o0, o1); w.y = cvt_pk_bf16(o2, o3);
                    *(u32x2*)(rowp + bj * 64) = w; } }
    }
};
struct EpiSwiglu8 {
    static constexpr bool PERM = true;
    unsigned char* O; int ldc; float isc, osc;
    __device__ __forceinline__ void operator()(const f32x4 (&acc)[2][2][4][2], const Unit& u, int wr, int wc, int fr, int fq) const {
        const int row0 = u.pm * BM + wr * 64 + fr, col0 = u.pn * 128 + wc * 16 + 4 * fq;
#pragma unroll
        for (int ai = 0; ai < 2; ++ai)
#pragma unroll
            for (int m = 0; m < 4; ++m) { unsigned char* rowp = O + (size_t)(row0 + ai * HALF + m * 16) * ldc + col0;
#pragma unroll
                for (int bj = 0; bj < 2; ++bj) { const f32x4 v0 = acc[ai][bj][m][0] * isc, v1 = acc[ai][bj][m][1] * isc;
                    const float o0 = v0[0] * fsig(v0[0]) * v0[1] * osc, o1 = v0[2] * fsig(v0[2]) * v0[3] * osc, o2 = v1[0] * fsig(v1[0]) * v1[1] * osc, o3 = v1[2] * fsig(v1[2]) * v1[3] * osc;
                    *(unsigned*)(rowp + bj * 64) = pk4_fp8(o0, o1, o2, o3); } }
    }
};
template <bool OUT8> struct EpiSwigluQ {
    static constexpr bool PERM = true;
    bf16_t* O; int ldc; const float* hs; const float* ws; float osc;
    __device__ __forceinline__ void operator()(const f32x4 (&acc)[2][2][4][2], const Unit& u, int wr, int wc, int fr, int fq) const {
        const int row0 = u.pm * BM + wr * 64 + fr, col0 = u.pn * 128 + wc * 16 + 4 * fq;
        const float* wsp_ = ws + u.x0 * (2 * 3584) + u.pn * BM + wc * 32 + 8 * fq;
        constexpr float NL = -1.4426950408889634f;
        const float ob = OUT8 ? osc : 1.f;
        f32x2 sw[2][2][2];
#pragma unroll
        for (int bj = 0; bj < 2; ++bj)
#pragma unroll
            for (int n = 0; n < 2; ++n) { const float4 w = *(const float4*)(wsp_ + bj * HALF + 4 * n); sw[bj][n][0] = (f32x2){w.x, w.y * ob}; sw[bj][n][1] = (f32x2){w.z, w.w * ob}; }
        float hrv[2][4];
#pragma unroll
        for (int ai = 0; ai < 2; ++ai)
#pragma unroll
            for (int m = 0; m < 4; ++m) hrv[ai][m] = hs[row0 + ai * HALF + m * 16] * KSC;
#pragma unroll
        for (int ai = 0; ai < 2; ++ai)
#pragma unroll
            for (int m = 0; m < 4; ++m) { const int row = row0 + ai * HALF + m * 16; bf16_t* rowp = O + (size_t)row * ldc + col0; const float hr = hrv[ai][m]; const f32x2 hr2 = {hr, hr};
#pragma unroll
                for (int bj = 0; bj < 2; ++bj) { float o[4];
#pragma unroll
                    for (int n = 0; n < 2; ++n) { const v4i_t iv = __builtin_bit_cast(v4i_t, acc[ai][bj][m][n]);
                        const f32x2 p0 = (f32x2){(float)iv[0], (float)iv[1]} * (sw[bj][n][0] * hr2), p1 = (f32x2){(float)iv[2], (float)iv[3]} * (sw[bj][n][1] * hr2);
                        o[2 * n] = (p0.x * p0.y) * __builtin_amdgcn_rcpf(1.f + __builtin_amdgcn_exp2f(NL * p0.x));
                        o[2 * n + 1] = (p1.x * p1.y) * __builtin_amdgcn_rcpf(1.f + __builtin_amdgcn_exp2f(NL * p1.x)); }
                    if constexpr (OUT8) { *(unsigned*)((unsigned char*)O + (size_t)row * ldc + col0 + bj * 64) = pk4_fp8(o[0], o[1], o[2], o[3]); continue; }
                    u32x2 w; w.x = cvt_pk_bf16(o[0], o[1]); w.y = cvt_pk_bf16(o[2], o[3]);
                    *(u32x2*)(rowp + bj * 64) = w; } }
    }
};
struct EpiStoreQ {
    static constexpr bool PERM = true;
    bf16_t* O; int ldc; const float* hs; const float* ws;
    __device__ __forceinline__ void operator()(const f32x4 (&acc)[2][2][4][2], const Unit& u, int wr, int wc, int fr, int fq) const {
        const int row0 = u.pm * BM + wr * 64 + fr, col0 = u.pn * BM + wc * 32 + 8 * fq;
        float hrv[2][4];
#pragma unroll
        for (int ai = 0; ai < 2; ++ai)
#pragma unroll
            for (int m = 0; m < 4; ++m) hrv[ai][m] = hs[row0 + ai * HALF + m * 16] * KSC;
        float4 wq[2][2];
#pragma unroll
        for (int bj = 0; bj < 2; ++bj) { wq[bj][0] = *(const float4*)(ws + col0 + bj * HALF); wq[bj][1] = *(const float4*)(ws + col0 + bj * HALF + 4); }
#pragma unroll
        for (int ai = 0; ai < 2; ++ai)
#pragma unroll
            for (int m = 0; m < 4; ++m) { const int row = row0 + ai * HALF + m * 16; bf16_t* rowp = O + (size_t)row * ldc + col0; const float hr = hrv[ai][m];
#pragma unroll
                for (int bj = 0; bj < 2; ++bj) { const v4i_t i0 = __builtin_bit_cast(v4i_t, acc[ai][bj][m][0]), i1 = __builtin_bit_cast(v4i_t, acc[ai][bj][m][1]);
                    const float4 w0 = wq[bj][0], w1 = wq[bj][1];
                    u32x4 w; w.x = cvt_pk_bf16((float)i0[0] * (hr * w0.x), (float)i0[1] * (hr * w0.y)); w.y = cvt_pk_bf16((float)i0[2] * (hr * w0.z), (float)i0[3] * (hr * w0.w));
                    w.z = cvt_pk_bf16((float)i1[0] * (hr * w1.x), (float)i1[1] * (hr * w1.y)); w.w = cvt_pk_bf16((float)i1[2] * (hr * w1.z), (float)i1[3] * (hr * w1.w));
                    *(u32x4*)(rowp + bj * HALF) = w; } }
    }
};
struct EpiGateQ {
    static constexpr bool PERM = true;
    unsigned char* O; int ldc; const float* bias; const float* hs; const float* ws;
    __device__ __forceinline__ void operator()(const f32x4 (&acc)[2][2][4][2], const Unit& u, int wr, int wc, int fr, int fq) const {
        const int row0 = u.pm * BM + wr * 64 + fr, col0 = u.pn * BM + wc * 32 + 8 * fq;
        constexpr float NL = -1.4426950408889634f, K255 = 1.f / 255.f;
        f32x2 sw[2][2][2], bw[2][2][2];
#pragma unroll
        for (int bj = 0; bj < 2; ++bj)
#pragma unroll
            for (int n = 0; n < 2; ++n) { const float4 w = *(const float4*)(ws + col0 + bj * HALF + 4 * n), b = *(const float4*)(bias + col0 + bj * HALF + 4 * n);
                sw[bj][n][0] = (f32x2){w.x * NL, w.y * NL}; sw[bj][n][1] = (f32x2){w.z * NL, w.w * NL}; bw[bj][n][0] = (f32x2){b.x * NL, b.y * NL}; bw[bj][n][1] = (f32x2){b.z * NL, b.w * NL}; }
        float hrv[2][4];
#pragma unroll
        for (int ai = 0; ai < 2; ++ai)
#pragma unroll
            for (int m = 0; m < 4; ++m) hrv[ai][m] = hs[row0 + ai * HALF + m * 16] * KSC;
#pragma unroll
        for (int ai = 0; ai < 2; ++ai)
#pragma unroll
            for (int m = 0; m < 4; ++m) { const int row = row0 + ai * HALF + m * 16; const float hr = hrv[ai][m]; const f32x2 hr2 = {hr, hr}, k2 = {K255, K255};
                unsigned a4[4];
#pragma unroll
                for (int bj = 0; bj < 2; ++bj) { unsigned a[2];
#pragma unroll
                    for (int n = 0; n < 2; ++n) { const v4i_t iv = __builtin_bit_cast(v4i_t, acc[ai][bj][m][n]);
                        const f32x2 z0 = (f32x2){(float)iv[0], (float)iv[1]} * (sw[bj][n][0] * hr2) + bw[bj][n][0], z1 = (f32x2){(float)iv[2], (float)iv[3]} * (sw[bj][n][1] * hr2) + bw[bj][n][1];
                        const f32x2 x0 = (f32x2){__builtin_amdgcn_exp2f(z0.x), __builtin_amdgcn_exp2f(z0.y)} * k2 + k2, x1 = (f32x2){__builtin_amdgcn_exp2f(z1.x), __builtin_amdgcn_exp2f(z1.y)} * k2 + k2;
                        unsigned t = 0;
                        t = __builtin_amdgcn_cvt_pk_u8_f32(__builtin_amdgcn_rcpf(x0.x), 0, t); t = __builtin_amdgcn_cvt_pk_u8_f32(__builtin_amdgcn_rcpf(x0.y), 1, t);
                        t = __builtin_amdgcn_cvt_pk_u8_f32(__builtin_amdgcn_rcpf(x1.x), 2, t); t = __builtin_amdgcn_cvt_pk_u8_f32(__builtin_amdgcn_rcpf(x1.y), 3, t); a[n] = t; }
                    a4[bj * 2] = a[0]; a4[bj * 2 + 1] = a[1]; }
                *(u32x4*)(O + ((size_t)u.pm * 16 + u.pn) * 65536 + (size_t)((((wr * 4 + wc) * 2 + ai) * 4 + m) * 1024 + (fr + 16 * fq) * 16)) = (u32x4){a4[0], a4[1], a4[2], a4[3]}; }
    }
};
}

constexpr int NWAVES = 8, NTHR = 512;
constexpr int LDS_BYTES = 147456;
__device__ __forceinline__ unsigned f2bf(float f) { unsigned u = __builtin_bit_cast(unsigned, f); return (u + 0x7fffu + ((u >> 16) & 1u)) >> 16; }
__device__ __forceinline__ unsigned pk2(float lo, float hi) { return f2bf(lo) | (f2bf(hi) << 16); }
__device__ __forceinline__ float bf2f(unsigned short b) { return __builtin_bit_cast(float, (unsigned)b << 16); }
#define LDS_WAIT() asm volatile("s_waitcnt lgkmcnt(0)" ::: "memory")
__device__ __forceinline__ void transpose_item(const float* W, int ldw, int nblk, bf16_t* WT, int ldo, int row_off, int row_mul, int k_off, const float* kscale, LAS float* scr, int item, int lane) {
    const int kb = item / nblk, nb = item % nblk, k0 = 64 * kb, n0 = 32 * nb;
#pragma unroll 8
    for (int i = 0; i < 32; ++i) { const int kk = 2 * i + (lane >> 5); float v = W[(size_t)(k0 + kk) * ldw + n0 + (lane & 31)]; if (kscale) v *= kscale[k0 + kk]; scr[kk * 33 + (lane & 31)] = v; }
    LDS_WAIT(); asm volatile("" ::: "memory");
    const int c = lane & 7;
#pragma unroll
    for (int j = 0; j < 4; ++j) { const int n = (lane >> 3) + 8 * j; const LAS float* s = scr + (8 * c) * 33 + n;
        u32x4 o; o.x = pk2(s[0 * 33], s[1 * 33]); o.y = pk2(s[2 * 33], s[3 * 33]); o.z = pk2(s[4 * 33], s[5 * 33]); o.w = pk2(s[6 * 33], s[7 * 33]);
        *(u32x4*)(WT + (size_t)(row_off + (n0 + n) * row_mul) * ldo + k_off + k0 + 8 * c) = o; }
    LDS_WAIT(); asm volatile("" ::: "memory");
}
__device__ __forceinline__ void transpose_item8(const float* W, int ldw, int nblk, unsigned char* WT, int ldo, int row_off, int row_mul, float scale, LAS float* scr, int item, int lane) {
    const int kb = item / nblk, nb = item % nblk, k0 = 64 * kb, n0 = 32 * nb;
#pragma unroll 8
    for (int i = 0; i < 32; ++i) { const int kk = 2 * i + (lane >> 5); scr[kk * 33 + (lane & 31)] = W[(size_t)(k0 + kk) * ldw + n0 + (lane & 31)] * scale; }
    LDS_WAIT(); asm volatile("" ::: "memory");
    const int c = lane & 7;
#pragma unroll
    for (int j = 0; j < 4; ++j) { const int n = (lane >> 3) + 8 * j; const LAS float* sp = scr + (8 * c) * 33 + n;
        u32x2 o; o.x = pg8::pk4_fp8(sp[0 * 33], sp[1 * 33], sp[2 * 33], sp[3 * 33]); o.y = pg8::pk4_fp8(sp[4 * 33], sp[5 * 33], sp[6 * 33], sp[7 * 33]);
        *(u32x2*)(WT + (size_t)(row_off + (n0 + n) * row_mul) * ldo + k0 + 8 * c) = o; }
    LDS_WAIT(); asm volatile("" ::: "memory");
}
__device__ __forceinline__ unsigned pk4_i8(float a, float b, float c, float d) {
    const int ia = (int)__builtin_rintf(a), ib = (int)__builtin_rintf(b), ic = (int)__builtin_rintf(c), id = (int)__builtin_rintf(d);
    return (unsigned)(ia & 255) | ((unsigned)(ib & 255) << 8) | ((unsigned)(ic & 255) << 16) | ((unsigned)id << 24); }
__device__ __forceinline__ float shx_(float v, int o, int lane) { return __int_as_float(__builtin_amdgcn_ds_bpermute((lane ^ o) << 2, __float_as_int(v))); }
__device__ __forceinline__ void transpose_item_q(const float* W, int K, int ldw, int n0, signed char* WT, int ldo, int row_off, int row_mul, float* wscale, LAS float* scr, int lane) {
    const float* wp = W + (size_t)(lane >> 5) * ldw + n0 + (lane & 31);
    float am = 0.f;
#pragma unroll 16
    for (int i = 0; i < K / 2; ++i) am = fmaxf(am, fabsf(wp[(size_t)(2 * i) * ldw]));
    am = fmaxf(am, shx_(am, 32, lane));
    const float qs = 127.f / fmaxf(am, 1e-30f);
    if (lane < 32) wscale[row_off + (n0 + lane) * row_mul] = am * (1.f / 127.f);
#pragma unroll 1
    for (int kb = 0; kb < K / 64; ++kb) { const int k0 = 64 * kb;
#pragma unroll 8
        for (int i = 0; i < 32; ++i) { const int kk = 2 * i + (lane >> 5); scr[kk * 33 + (lane & 31)] = wp[(size_t)(k0 + 2 * i) * ldw] * qs; }
        LDS_WAIT(); asm volatile("" ::: "memory");
        const int c = lane & 7;
#pragma unroll
        for (int j = 0; j < 4; ++j) { const int n = (lane >> 3) + 8 * j; const LAS float* sp = scr + (8 * c) * 33 + n;
            u32x2 o; o.x = pk4_i8(sp[0 * 33], sp[1 * 33], sp[2 * 33], sp[3 * 33]); o.y = pk4_i8(sp[4 * 33], sp[5 * 33], sp[6 * 33], sp[7 * 33]);
            *(u32x2*)(WT + (size_t)(row_off + (n0 + n) * row_mul) * ldo + k0 + 8 * c) = o; }
        LDS_WAIT(); asm volatile("" ::: "memory"); }
}
__device__ __forceinline__ void colgroup_q_block(const float* W, int ldw, int n0, signed char* WT, int ldo, int row_off, int row_mul, float* wscale, LAS unsigned char* lds) {
    const int tid_ = otid(); const int wave = __builtin_amdgcn_readfirstlane(tid_ >> 6), lane = tid_ & 63;
    LAS float* scr = (LAS float*)(lds + wave * 16384); LAS float* red = (LAS float*)(lds + 12288);
    const float* wp = W + (size_t)(128 * wave + (lane >> 5)) * ldw + n0 + (lane & 31);
    float v[64]; float am = 0.f;
#pragma unroll
    for (int i = 0; i < 64; ++i) v[i] = wp[(size_t)(2 * i) * ldw];
#pragma unroll
    for (int i = 0; i < 64; ++i) am = fmaxf(am, fabsf(v[i]));
    am = fmaxf(am, shx_(am, 32, lane));
    if (lane < 32) red[wave * 4096 + lane] = am;
    __syncthreads();
#pragma unroll
    for (int w = 0; w < 8; ++w) am = fmaxf(am, red[w * 4096 + (lane & 31)]);
    const float qs = 127.f / fmaxf(am, 1e-30f);
    if (wave == 0 && lane < 32) wscale[row_off + (n0 + lane) * row_mul] = am * (1.f / 127.f);
#pragma unroll
    for (int kt = 0; kt < 2; ++kt) { const int k0 = 128 * wave + 64 * kt;
#pragma unroll
        for (int i = 0; i < 32; ++i) scr[(2 * i + (lane >> 5)) * 33 + (lane & 31)] = v[32 * kt + i] * qs;
        LDS_WAIT(); asm volatile("" ::: "memory");
        const int c = lane & 7;
#pragma unroll
        for (int j = 0; j < 4; ++j) { const int n = (lane >> 3) + 8 * j; const LAS float* sp = scr + (8 * c) * 33 + n;
            u32x2 o; o.x = pk4_i8(sp[0 * 33], sp[1 * 33], sp[2 * 33], sp[3 * 33]); o.y = pk4_i8(sp[4 * 33], sp[5 * 33], sp[6 * 33], sp[7 * 33]);
            *(u32x2*)(WT + (size_t)(row_off + (n0 + n) * row_mul) * ldo + k0 + 8 * c) = o; }
        LDS_WAIT(); asm volatile("" ::: "memory"); }
    __syncthreads();
}
__device__ __forceinline__ void conv_matrix8(const float* W, int K, int N, int ldw, unsigned char* WT, int ldo, int row_off, int row_mul, float scale, LAS unsigned char* lds, int& cursor) {
    const int tid_ = otid(); const int wave = __builtin_amdgcn_readfirstlane(tid_ >> 6), lane = tid_ & 63;
    LAS float* scr = (LAS float*)(lds + wave * 16384);
    const int gw = blockIdx.x * NWAVES + wave, NGW = gridDim.x * NWAVES;
    const int nblk = N / 32, nitems = (K / 64) * nblk;
    for (int it = (gw + NGW - (cursor % NGW)) % NGW; it < nitems; it += NGW) transpose_item8(W, ldw, nblk, WT, ldo, row_off, row_mul, scale, scr, it, lane);
    cursor += nitems;
}
__device__ __forceinline__ void conv_matrix(const float* W, int K, int N, int ldw, bf16_t* WT, int ldo, int row_off, int row_mul, int k_off, const float* kscale, LAS unsigned char* lds, int& cursor) {
    const int tid_ = otid(); const int wave = __builtin_amdgcn_readfirstlane(tid_ >> 6), lane = tid_ & 63;
    LAS float* scr = (LAS float*)(lds + wave * 16384);
    const int gw = blockIdx.x * NWAVES + wave, NGW = gridDim.x * NWAVES;
    const int nblk = N / 32, nitems = (K / 64) * nblk;
    for (int it = (gw + NGW - (cursor % NGW)) % NGW; it < nitems; it += NGW) transpose_item(W, ldw, nblk, WT, ldo, row_off, row_mul, k_off, kscale, scr, it, lane);
    cursor += nitems;
}

struct ConvFfn { const float* w1; const float* w3; const float* w2; bf16_t* W13; bf16_t* W2t; };
__global__ __launch_bounds__(NTHR, 2) void k_conv_ffn(ConvFfn a) {
    extern __shared__ __attribute__((aligned(16))) unsigned char lds_raw[];
    LAS unsigned char* lds = (LAS unsigned char*)lds_raw;
    int cursor = 0;
    conv_matrix(a.w1, D, DFF, DFF, a.W13, D, 0, 2, 0, nullptr, lds, cursor);
    conv_matrix(a.w3, D, DFF, DFF, a.W13, D, 1, 2, 0, nullptr, lds, cursor);
    conv_matrix(a.w2, DFF, D, D, a.W2t, DFF, 0, 1, 0, nullptr, lds, cursor);
}
struct GemmArgs { const bf16_t* A; const bf16_t* B; bf16_t* O; int nM, nN, K, lda, ldb, ldc, col_off, pad; };
template <class Epi> __global__ __launch_bounds__(NTHR, 2) void k_gemm(GemmArgs a) {
    extern __shared__ __attribute__((aligned(16))) unsigned char lds_raw[];
    LAS unsigned char* lds = (LAS unsigned char*)lds_raw;
    pg8::StaticOrder S; S.init(a.nM, a.nN, (int)gridDim.x, (int)blockIdx.x, a.A, a.lda, a.B, a.ldb);
    Epi E; E.O = a.O; E.ldc = a.ldc; if constexpr (!std::is_same<Epi, pg8::EpiStore>::value) E.col_off = a.col_off;
    pg8::gemm_phase<Epi, pg8::StaticOrder>(lds, a.K, a.lda, a.ldb, S, E);
}
template <bool YBF> __global__ __launch_bounds__(256) void k_lnh(float* X, const void* Yv, const float* MODl, int goff, const float* g, const float* bta, float* out, bf16_t* H, const float* MODh, int hsh, int hsc) {
    const int r = blockIdx.x * 4 + (threadIdx.x >> 6), lane = threadIdx.x & 63;
    const float* md = MODl + (size_t)modrow(r) * 6144 + goff;
    float v[16]; float s = 0.f;
#pragma unroll
    for (int j = 0; j < 4; ++j) { const int c = j * 256 + lane * 4; const float4 x4 = *(const float4*)(X + (size_t)r * D + c), m4 = *(const float4*)(md + c);
        float y0, y1, y2, y3;
        if (YBF) { const u32x2 yw = *(const u32x2*)((const bf16_t*)Yv + (size_t)r * D + c);
            y0 = __builtin_bit_cast(float, yw.x << 16); y1 = __builtin_bit_cast(float, yw.x & 0xffff0000u); y2 = __builtin_bit_cast(float, yw.y << 16); y3 = __builtin_bit_cast(float, yw.y & 0xffff0000u); }
        else { const float4 y4 = *(const float4*)((const float*)Yv + (size_t)r * D + c); y0 = y4.x; y1 = y4.y; y2 = y4.z; y3 = y4.w; }
        v[j * 4] = ALPHA * x4.x + m4.x * y0; v[j * 4 + 1] = ALPHA * x4.y + m4.y * y1; v[j * 4 + 2] = ALPHA * x4.z + m4.z * y2; v[j * 4 + 3] = ALPHA * x4.w + m4.w * y3;
        s += v[j * 4] + v[j * 4 + 1] + v[j * 4 + 2] + v[j * 4 + 3]; }
#pragma unroll
    for (int o = 1; o < 64; o <<= 1) s += __shfl_xor(s, o);
    const float mean = s / D; float q = 0.f;
#pragma unroll
    for (int j = 0; j < 16; ++j) { v[j] -= mean; q += v[j] * v[j]; }
#pragma unroll
    for (int o = 1; o < 64; o <<= 1) q += __shfl_xor(q, o);
    const float rstd = rsqrtf(q / D + 1e-5f);
    const float* mh = MODh ? MODh + (size_t)modrow(r) * 6144 : nullptr;
#pragma unroll
    for (int j = 0; j < 4; ++j) { const int c = j * 256 + lane * 4; const float4 g4 = *(const float4*)(g + c), b4 = *(const float4*)(bta + c);
        float4 o4; o4.x = v[j * 4] * rstd * g4.x + b4.x; o4.y = v[j * 4 + 1] * rstd * g4.y + b4.y; o4.z = v[j * 4 + 2] * rstd * g4.z + b4.z; o4.w = v[j * 4 + 3] * rstd * g4.w + b4.w;
        *(float4*)(X + (size_t)r * D + c) = o4; if (out && r < TL) *(float4*)(out + (size_t)r * D + c) = o4;
        if (H) { const float4 sc = *(const float4*)(mh + hsc + c), sh = *(const float4*)(mh + hsh + c);
            u32x2 w; w.x = pk2(o4.x * (1.f + sc.x) + sh.x, o4.y * (1.f + sc.y) + sh.y); w.y = pk2(o4.z * (1.f + sc.z) + sh.z, o4.w * (1.f + sc.w) + sh.w);
            *(u32x2*)(H + (size_t)r * D + c) = w; } }
}


constexpr int MAXTILES = 288;
__global__ __launch_bounds__(256) void k_route2(const float* X, const float* MODl, const float* wr, int* plan, int* ltok, int* tslot, float* tgate) {
    const int r = blockIdx.x * 4 + (threadIdx.x >> 6), lane = threadIdx.x & 63;
    const float* md = MODl + (size_t)modrow(r) * 6144;
    float lg[8];
#pragma unroll
    for (int e = 0; e < 8; ++e) lg[e] = 0.f;
    for (int j = 0; j < 16; ++j) { const int k = j * 64 + lane; const float hv = X[(size_t)r * D + k] * (1.f + md[4 * D + k]) + md[3 * D + k];
        const float4 w0 = *(const float4*)(wr + k * 8), w1 = *(const float4*)(wr + k * 8 + 4);
        lg[0] += hv * w0.x; lg[1] += hv * w0.y; lg[2] += hv * w0.z; lg[3] += hv * w0.w; lg[4] += hv * w1.x; lg[5] += hv * w1.y; lg[6] += hv * w1.z; lg[7] += hv * w1.w; }
#pragma unroll
    for (int e = 0; e < 8; ++e)
#pragma unroll
        for (int o = 1; o < 64; o <<= 1) lg[e] += __shfl_xor(lg[e], o);
    if (lane == 0) {
        int e1 = 0; float v1 = lg[0];
#pragma unroll
        for (int e = 1; e < 8; ++e) if (lg[e] > v1) { v1 = lg[e]; e1 = e; }
        int e2 = -1; float v2 = -3e38f;
#pragma unroll
        for (int e = 0; e < 8; ++e) if (e != e1 && lg[e] > v2) { v2 = lg[e]; e2 = e; }
        const float p2 = expf(v2 - v1), g1 = 1.f / (1.f + p2), g2 = p2 / (1.f + p2);
        const int s1 = atomicAdd(plan + e1, 1); ltok[e1 * T + s1] = r; tslot[r * 2] = e1 * T + s1; tgate[r * 2] = g1;
        const int s2 = atomicAdd(plan + e2, 1); ltok[e2 * T + s2] = r; tslot[r * 2 + 1] = e2 * T + s2; tgate[r * 2 + 1] = g2;
    }
}
__global__ void k_moe_plan(int* plan) {
    if (threadIdx.x == 0) { int start = 0;
        for (int e = 0; e < 8; ++e) { const int nt = (plan[e] + 255) >> 8; plan[8 + e] = start * 256; for (int t = 0; t < nt; ++t) plan[32 + start + t] = e; start += nt; }
        plan[16] = start; }
}
__global__ __launch_bounds__(256) void k_gather(const bf16_t* H, bf16_t* Hg, const int* plan, const int* ltok) {
    const int pr = blockIdx.x * 4 + (threadIdx.x >> 6), lane = threadIdx.x & 63;
    if (pr >= plan[16] * 256) return;
    const int e = plan[32 + (pr >> 8)], slot = pr - plan[8 + e];
    u32x4 v0 = (u32x4){0u, 0u, 0u, 0u}, v1 = v0;
    if (slot < plan[e]) { const int tok = ltok[e * T + slot]; const u32x4* src = (const u32x4*)(H + (size_t)tok * D); v0 = src[lane]; v1 = src[64 + lane]; }
    u32x4* dst = (u32x4*)(Hg + (size_t)pr * D); dst[lane] = v0; dst[64 + lane] = v1;
}
namespace pg8 {
struct MoeOrder {
    int nM, nN, nwg, G, c; const int* tileE; const char* A; const char* B; size_t tA, tB, tBe;
    __device__ void init(const int* plan, int nN_, int G_, int c_, const void* A_, int lda, const void* B_, int ldb, size_t expert_elems) {
        nM = plan[16]; nN = nN_; nwg = nM * nN; G = G_; c = c_; tileE = plan + 32; A = (const char*)A_; B = (const char*)B_; tA = (size_t)BM * lda * 2; tB = (size_t)BM * ldb * 2; tBe = expert_elems * 2; }
    __device__ bool next(int i, Unit& u) const {
        const long L = (long)i * G + c; if (L >= nwg) return false;
        int wgid = (int)L; { const int q = nwg / NXCD, r = nwg % NXCD, xcd = wgid % NXCD, off = wgid / NXCD; wgid = (xcd < r ? xcd * (q + 1) : r * (q + 1) + (xcd - r) * q) + off; }
        const int nig = WGM * nN, gid = wgid / nig, fm = gid * WGM, gsz = (nM - fm) < WGM ? (nM - fm) : WGM;
        u.pm = fm + ((wgid % nig) % gsz); u.pn = (wgid % nig) / gsz; u.x0 = tileE[u.pm]; u.x1 = 0;
        u.A = A + (size_t)u.pm * tA; u.B = B + (size_t)u.x0 * tBe + (size_t)u.pn * tB; return true;
    }
};
}
struct MoeGemmArgs { const bf16_t* A; const bf16_t* B; bf16_t* O; const int* plan; int nN, K, lda, ldb, ldc, pad; size_t expert_elems; };
template <class Epi> __global__ __launch_bounds__(NTHR, 2) void k_gemm_moe(MoeGemmArgs a) {
    extern __shared__ __attribute__((aligned(16))) unsigned char lds_raw[];
    LAS unsigned char* lds = (LAS unsigned char*)lds_raw;
    pg8::MoeOrder S; S.init(a.plan, a.nN, (int)gridDim.x, (int)blockIdx.x, a.A, a.lda, a.B, a.ldb, a.expert_elems);
    Epi E; E.O = a.O; E.ldc = a.ldc; if constexpr (!std::is_same<Epi, pg8::EpiStore>::value) E.col_off = 0;
    pg8::gemm_phase<Epi, pg8::MoeOrder>(lds, a.K, a.lda, a.ldb, S, E);
}
struct ConvMoe { const float* w1; const float* w3; const float* w2; bf16_t* W13; bf16_t* W2t; };
__global__ __launch_bounds__(NTHR, 2) void k_conv_moe(ConvMoe a) {
    extern __shared__ __attribute__((aligned(16))) unsigned char lds_raw[];
    LAS unsigned char* lds = (LAS unsigned char*)lds_raw;
    int cursor = 0;
    for (int e = 0; e < NE; ++e) {
        conv_matrix(a.w1 + (size_t)e * D * DFF, D, DFF, DFF, a.W13 + (size_t)e * 2 * DFF * D, D, 0, 2, 0, nullptr, lds, cursor);
        conv_matrix(a.w3 + (size_t)e * D * DFF, D, DFF, DFF, a.W13 + (size_t)e * 2 * DFF * D, D, 1, 2, 0, nullptr, lds, cursor);
        conv_matrix(a.w2 + (size_t)e * DFF * D, DFF, D, D, a.W2t + (size_t)e * D * DFF, DFF, 0, 1, 0, nullptr, lds, cursor);
    }
}
__global__ __launch_bounds__(256) void k_ln_moe(float* X, const bf16_t* Y2, const int* plan, const int* tslot, const float* tgate, const float* MODl, int goff, const float* g, const float* bta, float* out, bf16_t* H, const float* MODh) {
    const int r = blockIdx.x * 4 + (threadIdx.x >> 6), lane = threadIdx.x & 63;
    const float* md = MODl + (size_t)modrow(r) * 6144 + goff;
    const int t0 = tslot[r * 2], t1 = tslot[r * 2 + 1]; const float g0 = tgate[r * 2], g1 = tgate[r * 2 + 1];
    const int e0 = t0 / T, e1 = t1 / T; const size_t p0 = (size_t)(plan[8 + e0] + (t0 - e0 * T)), p1 = (size_t)(plan[8 + e1] + (t1 - e1 * T));
    float v[16]; float s = 0.f;
#pragma unroll
    for (int j = 0; j < 4; ++j) { const int c = j * 256 + lane * 4; const float4 x4 = *(const float4*)(X + (size_t)r * D + c), m4 = *(const float4*)(md + c);
        const u32x2 ya = *(const u32x2*)(Y2 + p0 * D + c), yb = *(const u32x2*)(Y2 + p1 * D + c);
        const float y0 = g0 * __builtin_bit_cast(float, ya.x << 16) + g1 * __builtin_bit_cast(float, yb.x << 16), y1 = g0 * __builtin_bit_cast(float, ya.x & 0xffff0000u) + g1 * __builtin_bit_cast(float, yb.x & 0xffff0000u);
        const float y2 = g0 * __builtin_bit_cast(float, ya.y << 16) + g1 * __builtin_bit_cast(float, yb.y << 16), y3 = g0 * __builtin_bit_cast(float, ya.y & 0xffff0000u) + g1 * __builtin_bit_cast(float, yb.y & 0xffff0000u);
        v[j * 4] = ALPHA * x4.x + m4.x * y0; v[j * 4 + 1] = ALPHA * x4.y + m4.y * y1; v[j * 4 + 2] = ALPHA * x4.z + m4.z * y2; v[j * 4 + 3] = ALPHA * x4.w + m4.w * y3;
        s += v[j * 4] + v[j * 4 + 1] + v[j * 4 + 2] + v[j * 4 + 3]; }
#pragma unroll
    for (int o = 1; o < 64; o <<= 1) s += __shfl_xor(s, o);
    const float mean = s / D; float q = 0.f;
#pragma unroll
    for (int j = 0; j < 16; ++j) { v[j] -= mean; q += v[j] * v[j]; }
#pragma unroll
    for (int o = 1; o < 64; o <<= 1) q += __shfl_xor(q, o);
    const float rstd = rsqrtf(q / D + 1e-5f);
#pragma unroll
    for (int j = 0; j < 4; ++j) { const int c = j * 256 + lane * 4; const float4 g4 = *(const float4*)(g + c), b4 = *(const float4*)(bta + c);
        float4 o4; o4.x = v[j * 4] * rstd * g4.x + b4.x; o4.y = v[j * 4 + 1] * rstd * g4.y + b4.y; o4.z = v[j * 4 + 2] * rstd * g4.z + b4.z; o4.w = v[j * 4 + 3] * rstd * g4.w + b4.w;
        *(float4*)(X + (size_t)r * D + c) = o4; if (out && r < TL) *(float4*)(out + (size_t)r * D + c) = o4;
        if (H) { const float* mh = MODh + (size_t)modrow(r) * 6144; const float4 sc = *(const float4*)(mh + D + c), sh = *(const float4*)(mh + c);
            u32x2 w; w.x = pk2(o4.x * (1.f + sc.x) + sh.x, o4.y * (1.f + sc.y) + sh.y); w.y = pk2(o4.z * (1.f + sc.z) + sh.z, o4.w * (1.f + sc.w) + sh.w);
            *(u32x2*)(H + (size_t)r * D + c) = w; } }
}


constexpr int ZC = 2304;
constexpr int NWG = ZC + 4 * D;
namespace pg8 {
struct EpiGate {
    static constexpr bool PERM = true;
    bf16_t* O; int ldc; const float* bias; float isc = 1.f; bool u8 = false;
    __device__ __forceinline__ void operator()(const f32x4 (&acc)[2][2][4][2], const Unit& u, int wr, int wc, int fr, int fq) const {
        const int row0 = u.pm * BM + wr * 64 + fr, col0 = u.pn * BM + wc * 32 + 8 * fq;
        f32x4 bv[2][2];
#pragma unroll
        for (int bj = 0; bj < 2; ++bj)
#pragma unroll
            for (int n = 0; n < 2; ++n) bv[bj][n] = *(const f32x4*)(bias + col0 + bj * HALF + 4 * n);
#pragma unroll
        for (int ai = 0; ai < 2; ++ai)
#pragma unroll
            for (int m = 0; m < 4; ++m) { bf16_t* rowp = O + (size_t)(row0 + ai * HALF + m * 16) * ldc + col0;
#pragma unroll
                for (int bj = 0; bj < 2; ++bj) { const f32x4 v0 = acc[ai][bj][m][0] * isc + bv[bj][0], v1 = acc[ai][bj][m][1] * isc + bv[bj][1];
                    if (u8) { unsigned a0 = 0, a1 = 0;
                        a0 = __builtin_amdgcn_cvt_pk_u8_f32(fsig(v0[0]) * 255.f, 0, a0); a0 = __builtin_amdgcn_cvt_pk_u8_f32(fsig(v0[1]) * 255.f, 1, a0); a0 = __builtin_amdgcn_cvt_pk_u8_f32(fsig(v0[2]) * 255.f, 2, a0); a0 = __builtin_amdgcn_cvt_pk_u8_f32(fsig(v0[3]) * 255.f, 3, a0);
                        a1 = __builtin_amdgcn_cvt_pk_u8_f32(fsig(v1[0]) * 255.f, 0, a1); a1 = __builtin_amdgcn_cvt_pk_u8_f32(fsig(v1[1]) * 255.f, 1, a1); a1 = __builtin_amdgcn_cvt_pk_u8_f32(fsig(v1[2]) * 255.f, 2, a1); a1 = __builtin_amdgcn_cvt_pk_u8_f32(fsig(v1[3]) * 255.f, 3, a1);
                        *(u32x2*)((unsigned char*)O + (size_t)(row0 + ai * HALF + m * 16) * ldc + col0 + bj * HALF) = (u32x2){a0, a1}; continue; }
                    u32x4 w; w.x = cvt_pk_bf16(fsig(v0[0]), fsig(v0[1])); w.y = cvt_pk_bf16(fsig(v0[2]), fsig(v0[3])); w.z = cvt_pk_bf16(fsig(v1[0]), fsig(v1[1])); w.w = cvt_pk_bf16(fsig(v1[2]), fsig(v1[3]));
                    *(u32x4*)(rowp + bj * HALF) = w; } }
    }
};
struct MergeOrder {
    StaticOrder so; const char* A; const char* B; size_t tA;
    __device__ void init(int nM, int G_, int c_, const void* A_, const void* B_) { so.init(nM, 4, G_, c_, A_, D, B_, 256); A = (const char*)A_; B = (const char*)B_; tA = (size_t)BM * D * 2; }
    __device__ bool next(int j, Unit& u) const {
        if (!so.next(j >> 2, u)) return false;
        const int i = j & 3; u.x0 = i;
        u.A = A + (size_t)u.pm * tA + (size_t)i * 256 * 2;
        u.B = B + ((size_t)i * D + (size_t)u.pn * BM) * 256 * 2;
        return true;
    }
};
__device__ __forceinline__ float bflo(unsigned w) { return __builtin_bit_cast(float, w << 16); }
__device__ __forceinline__ float bfhi(unsigned w) { return __builtin_bit_cast(float, w & 0xffff0000u); }
struct EpiMerge {
    static constexpr bool PERM = true;
    bf16_t* M; const bf16_t* G; bf16_t* P;
    __device__ __forceinline__ void operator()(const f32x4 (&acc)[2][2][4][2], const Unit& u, int wr, int wc, int fr, int fq) const {
        const int i = u.x0;
        const unsigned char* G8p = (const unsigned char*)G + ((size_t)u.pm * BM + (wr * 64 + fr)) * (4 * D) + (size_t)i * D + (size_t)u.pn * BM + wc * 32 + 8 * fq;
        const bf16_t* Gt = G + ((size_t)u.pm * BM * (4 * D) + (size_t)i * D + (size_t)u.pn * BM) + (size_t)((wr * 64 + fr) * (4 * D) + wc * 32 + 8 * fq);
        bf16_t* Mt = M + ((size_t)u.pm * BM * D + (size_t)u.pn * BM) + (size_t)((wr * 64 + fr) * D + wc * 32 + 8 * fq);
        unsigned char* Pt = (unsigned char*)P + ((size_t)u.pm * 4 + u.pn) * 131072 + (size_t)(((wr * 4 + wc) * 16) * 1024 + (fr + 16 * fq) * 16);
        u32x4 g[2][4][2], p[4][2], w[4][2];
#pragma unroll
        for (int ai = 0; ai < 2; ++ai)
#pragma unroll
            for (int m = 0; m < 4; ++m)
#pragma unroll
                for (int bj = 0; bj < 2; ++bj) { if (G8) { if (bj == 0) { const u32x4 gq = *(const u32x4*)((const unsigned char*)G + ((size_t)u.pm * 16 + (size_t)i * 4 + u.pn) * 65536 + (size_t)((((wr * 4 + wc) * 2 + ai) * 4 + m) * 1024 + (fr + 16 * fq) * 16));
                        g[ai][m][0] = (u32x4){gq.x, gq.y, 0u, 0u}; g[ai][m][1] = (u32x4){gq.z, gq.w, 0u, 0u}; } }
                    else g[ai][m][bj] = *(const u32x4*)(Gt + (size_t)(ai * HALF + m * 16) * (4 * D) + bj * HALF); }
#pragma unroll
        for (int m = 0; m < 4; ++m)
#pragma unroll
            for (int bj = 0; bj < 2; ++bj) { p[m][bj] = (u32x4){0u, 0u, 0u, 0u}; if (i) p[m][bj] = *(const u32x4*)(Pt + ((0 * 4 + m) * 2 + bj) * 1024); }
#pragma unroll
        for (int ai = 0; ai < 2; ++ai) {
#pragma unroll
            for (int m = 0; m < 4; ++m)
#pragma unroll
                for (int bj = 0; bj < 2; ++bj) { const f32x4 v0 = acc[ai][bj][m][0], v1 = acc[ai][bj][m][1]; const u32x4 gg = g[ai][m][bj], pp = p[m][bj]; u32x4 o;
                    if (G8) { constexpr float k = 1.f / 255.f;
                        o.x = cvt_pk_bf16(bflo(pp.x) + (float)(gg.x & 255u) * k * v0[0], bfhi(pp.x) + (float)((gg.x >> 8) & 255u) * k * v0[1]); o.y = cvt_pk_bf16(bflo(pp.y) + (float)((gg.x >> 16) & 255u) * k * v0[2], bfhi(pp.y) + (float)(gg.x >> 24) * k * v0[3]);
                        o.z = cvt_pk_bf16(bflo(pp.z) + (float)(gg.y & 255u) * k * v1[0], bfhi(pp.z) + (float)((gg.y >> 8) & 255u) * k * v1[1]); o.w = cvt_pk_bf16(bflo(pp.w) + (float)((gg.y >> 16) & 255u) * k * v1[2], bfhi(pp.w) + (float)(gg.y >> 24) * k * v1[3]); }
                    else { o.x = cvt_pk_bf16(bflo(pp.x) + bflo(gg.x) * v0[0], bfhi(pp.x) + bfhi(gg.x) * v0[1]); o.y = cvt_pk_bf16(bflo(pp.y) + bflo(gg.y) * v0[2], bfhi(pp.y) + bfhi(gg.y) * v0[3]);
                        o.z = cvt_pk_bf16(bflo(pp.z) + bflo(gg.z) * v1[0], bfhi(pp.z) + bfhi(gg.z) * v1[1]); o.w = cvt_pk_bf16(bflo(pp.w) + bflo(gg.w) * v1[2], bfhi(pp.w) + bfhi(gg.w) * v1[3]); }
                    w[m][bj] = o; }
            if (ai == 0) {
#pragma unroll
                for (int m = 0; m < 4; ++m)
#pragma unroll
                    for (int bj = 0; bj < 2; ++bj) { p[m][bj] = (u32x4){0u, 0u, 0u, 0u}; if (i) p[m][bj] = *(const u32x4*)(Pt + ((1 * 4 + m) * 2 + bj) * 1024); } }
#pragma unroll
            for (int m = 0; m < 4; ++m)
#pragma unroll
                for (int bj = 0; bj < 2; ++bj) { if (i < 3) *(u32x4*)(Pt + ((ai * 4 + m) * 2 + bj) * 1024) = w[m][bj]; else *(u32x4*)(Mt + (size_t)(ai * HALF + m * 16) * D + bj * HALF) = w[m][bj]; }
        }
    }
};
}
struct ConvMix { const float* w_in; const float* w_gate; const float* w_branch; const float* w_out; bf16_t* WinG; bf16_t* Wbr; bf16_t* Wout; };
__global__ __launch_bounds__(NTHR, 2) void k_conv_mix(ConvMix a) {
    extern __shared__ __attribute__((aligned(16))) unsigned char lds_raw[];
    LAS unsigned char* lds = (LAS unsigned char*)lds_raw;
    int cursor = 0;
    conv_matrix(a.w_in, D, INC, INC, a.WinG, D, 0, 1, 0, nullptr, lds, cursor);
    conv_matrix(a.w_gate, D, 4 * D, 4 * D, a.WinG, D, ZC, 1, 0, nullptr, lds, cursor);
    for (int i = 0; i < 4; ++i) conv_matrix(a.w_branch + (size_t)i * 256 * D, 256, D, D, a.Wbr, 256, i * D, 1, 0, nullptr, lds, cursor);
    conv_matrix(a.w_out, D, D, D, a.Wout, D, 0, 1, 0, nullptr, lds, cursor);
    for (int i = blockIdx.x * NTHR + threadIdx.x; i < (ZC - INC) * D / 8; i += gridDim.x * NTHR) ((u32x4*)(a.WinG + (size_t)INC * D))[i] = (u32x4){0u, 0u, 0u, 0u};
}
struct Gemm2Args { const bf16_t* A; const bf16_t* B; bf16_t* O; const float* bias; const bf16_t* G; int nM, nN, K, lda, ldb, ldc; };
__global__ __launch_bounds__(NTHR, 2) void k_gemm_gate(Gemm2Args a) {
    extern __shared__ __attribute__((aligned(16))) unsigned char lds_raw[];
    LAS unsigned char* lds = (LAS unsigned char*)lds_raw;
    pg8::StaticOrder S; S.init(a.nM, a.nN, (int)gridDim.x, (int)blockIdx.x, a.A, a.lda, a.B, a.ldb);
    pg8::EpiGate E; E.O = a.O; E.ldc = a.ldc; E.bias = a.bias;
    pg8::gemm_phase<pg8::EpiGate, pg8::StaticOrder>(lds, a.K, a.lda, a.ldb, S, E);
}
__global__ __launch_bounds__(NTHR, 2) void k_gemm_merge(Gemm2Args a) {
    extern __shared__ __attribute__((aligned(16))) unsigned char lds_raw[];
    LAS unsigned char* lds = (LAS unsigned char*)lds_raw;
    pg8::MergeOrder S; S.init(a.nM, (int)gridDim.x, (int)blockIdx.x, a.A, a.B);
    pg8::EpiMerge E; E.M = a.O; E.G = a.G;
    pg8::gemm_phase<pg8::EpiMerge, pg8::MergeOrder>(lds, 256, D, 256, S, E);
}
__global__ void k_modh(const float* X, const float* MODl, int sh, int sc, bf16_t* H) {
    const size_t i = ((size_t)blockIdx.x * 256 + threadIdx.x) * 4; const int r = (int)(i >> 10), c = (int)(i & 1023);
    const float* md = MODl + (size_t)modrow(r) * 6144; const float4 x = *(const float4*)(X + i), s4 = *(const float4*)(md + sc + c), h4 = *(const float4*)(md + sh + c);
    u32x2 w; w.x = pk2(x.x * (1.f + s4.x) + h4.x, x.y * (1.f + s4.y) + h4.y); w.y = pk2(x.z * (1.f + s4.z) + h4.z, x.w * (1.f + s4.w) + h4.w);
    *(u32x2*)(H + i) = w;
}
__global__ void k_z_expand(const bf16_t* Zb, float* Z) {
    const size_t i = (size_t)blockIdx.x * 256 + threadIdx.x; if (i >= (size_t)T * INC) return; const size_t r = i / INC, c = i % INC;
    Z[i] = bf2f(Zb[r * ZC + c]);
}
__global__ void k_o_compress(const float* O, bf16_t* Ob) {
    const size_t i = ((size_t)blockIdx.x * 256 + threadIdx.x) * 4; const float4 v = *(const float4*)(O + i);
    u32x2 w; w.x = pk2(v.x, v.y); w.y = pk2(v.z, v.w); *(u32x2*)(Ob + i) = w;
}


constexpr int KB = SQ + CL;
constexpr float C_MLA = 0.10206207261596575f * 1.4426950408889634f, C_DIFF = 0.17677669529663687f * 1.4426950408889634f, C_NA = 0.125f * 1.4426950408889634f;
typedef float f32x16 __attribute__((ext_vector_type(16)));
using pg8::bflo; using pg8::bfhi;
__device__ __forceinline__ float shx(float v, int o, int lane) { return __int_as_float(__builtin_amdgcn_ds_bpermute((lane ^ o) << 2, __float_as_int(v))); }
__device__ __forceinline__ float wave_sum(float v, int lane) {
#pragma unroll
    for (int o = 1; o < 64; o <<= 1) v += shx(v, o, lane);
    return v;
}
__device__ __forceinline__ void zero_rect(bf16_t* W, int ldo, int r0, int r1, int k0, int k1) {
    const int kw = (k1 - k0) / 8, n = (r1 - r0) * kw;
    for (int i = blockIdx.x * NTHR + otid(); i < n; i += gridDim.x * NTHR) { const int r = r0 + i / kw, k = k0 + (i % kw) * 8; *(u32x4*)(W + (size_t)r * ldo + k) = (u32x4){0u, 0u, 0u, 0u}; }
}
struct ConvExp { const float* w_uq; const float* w_ukv; const float* gq; const float* gkv; const float* w_glu; bf16_t* Wexp; bf16_t* Wglu; };
__global__ __launch_bounds__(NTHR, 2) void k_conv_exp(ConvExp a) {
    extern __shared__ __attribute__((aligned(16))) unsigned char lds_raw[];
    LAS unsigned char* lds = (LAS unsigned char*)lds_raw;
    int cursor = 0;
    conv_matrix(a.w_uq, 256, 384, 384, a.Wexp, 384, 0, 1, 0, a.gq, lds, cursor);
    conv_matrix(a.w_ukv, 128, 512, 512, a.Wexp, 384, 384, 1, 256, a.gkv, lds, cursor);
    zero_rect(a.Wexp, 384, 0, 384, 256, 384); zero_rect(a.Wexp, 384, 384, 896, 0, 256); zero_rect(a.Wexp, 384, 896, 1024, 0, 384);
    conv_matrix(a.w_glu, 256, 256, 512, a.Wglu, 256, 0, 2, 0, nullptr, lds, cursor);
    conv_matrix(a.w_glu + 256, 256, 256, 512, a.Wglu, 256, 1, 2, 0, nullptr, lds, cursor);
}
struct PrepArgs { const bf16_t* ZB; const bf16_t* EB; bf16_t* QM; bf16_t* KM; bf16_t* QD; bf16_t* KD; bf16_t* VTN; bf16_t* VTM; bf16_t* VTD; };
__device__ __forceinline__ void prep_row(const PrepArgs& a, int r, int lane) {
    const bf16_t* z = a.ZB + (size_t)r * ZC; const bf16_t* e = a.EB + (size_t)r * D;
    float sq, sk;
    { const u32x2 w = *(const u32x2*)(z + O_MQ + 4 * lane); const float a0 = bflo(w.x), a1 = bfhi(w.x), a2 = bflo(w.y), a3 = bfhi(w.y); sq = a0 * a0 + a1 * a1 + a2 * a2 + a3 * a3;
      const unsigned v = *(const unsigned*)(z + O_MKV + 2 * lane); const float b0 = bflo(v), b1 = bfhi(v); sk = b0 * b0 + b1 * b1; }
    sq = wave_sum(sq, lane); sk = wave_sum(sk, lane);
    const float rq = rsqrtf(sq * (1.f / 256.f) + 1e-6f), rk = rsqrtf(sk * (1.f / 128.f) + 1e-6f);
    const bool lat = r < TL; const int t = r & (SQ - 1), j = lane & 31;
    float sn = 0.f, cs = 1.f;
    if (lat) { const float pos = (float)((j & 16) ? (t & 63) : (t >> 6)); const float inv = exp2f(-(float)(j & 7) * 0.125f * 13.287712379549449f); sincosf(pos * inv, &sn, &cs); }
#define ROPE(v) ({ const float v_ = (v); const float p_ = shx(v_, 8, lane); (j & 8) ? (p_ * sn + v_ * cs) : (v_ * cs - p_ * sn); })
#pragma unroll
    for (int h = 0; h < 4; ++h) {
        a.QM[((size_t)h * T + r) * 96 + lane] = (bf16_t)f2bf(bf2f(e[h * 96 + lane]) * rq * C_MLA);
        a.KM[((size_t)h * T + r) * 96 + lane] = (bf16_t)f2bf(bf2f(e[384 + h * 128 + lane]) * rk);
    }
#pragma unroll
    for (int p = 0; p < 2; ++p) { const int hh = 2 * p + (lane >> 5); const float v = ROPE(bf2f(e[hh * 96 + 64 + j]) * rq); a.QM[((size_t)hh * T + r) * 96 + 64 + j] = (bf16_t)f2bf(v * C_MLA); }
    { const float v = ROPE(bf2f(z[O_MKR + j])); const bf16_t o = (bf16_t)f2bf(v); const int h0 = (lane >> 5) * 2;
      a.KM[((size_t)h0 * T + r) * 96 + 64 + j] = o; a.KM[((size_t)(h0 + 1) * T + r) * 96 + 64 + j] = o; }
#pragma unroll
    for (int p = 0; p < 4; ++p) { const int vec = 2 * p + (lane >> 5);
        const float vq = ROPE(bf2f(z[O_DQ + vec * 32 + j])); a.QD[((size_t)vec * T + r) * 32 + j] = (bf16_t)f2bf(vq * C_DIFF);
        const float vk = ROPE(bf2f(z[O_DK + vec * 32 + j])); a.KD[((size_t)vec * T + r) * 32 + j] = (bf16_t)f2bf(vk); }
#undef ROPE
}
__device__ __forceinline__ void prep_vt_tile(const PrepArgs& a, int ti, LAS unsigned char* lds) {
    const int tid = otid(), wave = tid >> 6, lane = tid & 63;
    const int r0 = ti * 64; const bool lat = r0 < TL;
    const int b = lat ? (r0 >> 12) : ((r0 - TL) >> 8), slot0 = lat ? (r0 & (SQ - 1)) : (SQ + ((r0 - TL) & (CL - 1)));
    LAS bf16_t* tile = (LAS bf16_t*)lds;
    for (int src = 0; src < 3; ++src) {
        bf16_t* dst = src == 0 ? a.VTN : (src == 1 ? a.VTM : a.VTD);
        for (int i = 0; i < 8; ++i) { const int tok = wave * 8 + i, r = r0 + tok;
            float v0, v1, v2, v3;
            if (src == 1) { const bf16_t* z = a.ZB + (size_t)r * ZC; const unsigned kv = *(const unsigned*)(z + O_MKV + 2 * lane); const float b0 = bflo(kv), b1 = bfhi(kv);
                const float rk = rsqrtf(wave_sum(b0 * b0 + b1 * b1, lane) * (1.f / 128.f) + 1e-6f);
                const int c = 4 * lane, h = c >> 6, d = c & 63; const u32x2 w = *(const u32x2*)(a.EB + (size_t)r * D + 384 + h * 128 + 64 + d);
                v0 = bflo(w.x) * rk; v1 = bfhi(w.x) * rk; v2 = bflo(w.y) * rk; v3 = bfhi(w.y) * rk; }
            else { const u32x2 w = *(const u32x2*)(a.ZB + (size_t)r * ZC + (src == 0 ? O_NAV : O_DV) + 4 * lane); v0 = bflo(w.x); v1 = bfhi(w.x); v2 = bflo(w.y); v3 = bfhi(w.y); }
            tile[(4 * lane + 0) * 72 + tok] = (bf16_t)f2bf(v0); tile[(4 * lane + 1) * 72 + tok] = (bf16_t)f2bf(v1); tile[(4 * lane + 2) * 72 + tok] = (bf16_t)f2bf(v2); tile[(4 * lane + 3) * 72 + tok] = (bf16_t)f2bf(v3); }
        __syncthreads();
        for (int i = tid; i < 1024; i += NTHR) { const int row = i >> 2, g = i & 3; const LAS u32x2* p = (const LAS u32x2*)(tile + row * 72 + g * 16);
            const u32x2 q0 = p[0], q1 = p[1], q2 = p[2], q3 = p[3];
            bf16_t* o = dst + ((size_t)(b * 4 + (row >> 6)) * 64 + (row & 63)) * KB + slot0 + g * 16;
            *(u32x4*)o = (u32x4){q0.x, q0.y, q2.x, q2.y}; *(u32x4*)(o + 8) = (u32x4){q1.x, q1.y, q3.x, q3.y}; }
        __syncthreads();
    }
}
template <int NT> __device__ __forceinline__ void prep_rows_fast(const PrepArgs& a, const float* rope_tab, int r0, int rstride, int nrows, int lane) {
    const int hq = lane >> 4, d0 = 4 * (lane & 15), vi = lane >> 3, j0 = 4 * (lane & 7);
    const bool second = (lane & 2) != 0, colhalf = (lane & 4) != 0;
    u32x2 zq[NT], eq[NT], ek[NT], rp[NT][3]; unsigned zkv[NT]; f32x4 cs[NT], sn[NT]; int rr[NT]; bool ok[NT];
#pragma unroll
    for (int t = 0; t < NT; ++t) { rr[t] = r0 + t * rstride; ok[t] = rr[t] < nrows; const int r = ok[t] ? rr[t] : 0;
        const bf16_t* z = a.ZB + (size_t)r * ZC; const bf16_t* e = a.EB + (size_t)r * D;
        zq[t] = *(const u32x2*)(z + O_MQ + 4 * lane); zkv[t] = *(const unsigned*)(z + O_MKV + 2 * lane);
        eq[t] = *(const u32x2*)(e + hq * 96 + d0); ek[t] = *(const u32x2*)(e + 384 + hq * 128 + d0);
        rp[t][0] = vi < 4 ? *(const u32x2*)(e + vi * 96 + 64 + j0) : *(const u32x2*)(z + O_DQ + (vi - 4) * 32 + j0);
        rp[t][1] = vi < 4 ? *(const u32x2*)(z + O_DQ + (vi + 4) * 32 + j0) : *(const u32x2*)(z + O_DK + (vi - 4) * 32 + j0);
        rp[t][2] = vi < 4 ? *(const u32x2*)(z + O_DK + (vi + 4) * 32 + j0) : *(const u32x2*)(z + O_MKR + j0);
        const bool lat = r < TL; const int tk = r & (SQ - 1), pos = colhalf ? (tk & 63) : (tk >> 6);
        cs[t] = (f32x4){1.f, 1.f, 1.f, 1.f}; sn[t] = (f32x4){0.f, 0.f, 0.f, 0.f};
        if (lat) { cs[t] = *(const f32x4*)(rope_tab + pos * 16 + 4 * (lane & 1)); sn[t] = *(const f32x4*)(rope_tab + pos * 16 + 8 + 4 * (lane & 1)); } }
#pragma unroll
    for (int t = 0; t < NT; ++t) { const int r = rr[t];
        float sq, sk;
        { const float a0 = bflo(zq[t].x), a1 = bfhi(zq[t].x), a2 = bflo(zq[t].y), a3 = bfhi(zq[t].y); sq = a0 * a0 + a1 * a1 + a2 * a2 + a3 * a3; const float b0 = bflo(zkv[t]), b1 = bfhi(zkv[t]); sk = b0 * b0 + b1 * b1; }
#pragma unroll
        for (int o = 1; o < 64; o <<= 1) { sq += shx(sq, o, lane); sk += shx(sk, o, lane); }
        const float rq = rsqrtf(sq * (1.f / 256.f) + 1e-6f), rk = rsqrtf(sk * (1.f / 128.f) + 1e-6f);
        if (ok[t]) {
            { const float f = rq * C_MLA; u32x2 w; w.x = pk2(bflo(eq[t].x) * f, bfhi(eq[t].x) * f); w.y = pk2(bflo(eq[t].y) * f, bfhi(eq[t].y) * f); *(u32x2*)(a.QM + ((size_t)hq * T + r) * 96 + d0) = w; }
            { u32x2 w; w.x = pk2(bflo(ek[t].x) * rk, bfhi(ek[t].x) * rk); w.y = pk2(bflo(ek[t].y) * rk, bfhi(ek[t].y) * rk); *(u32x2*)(a.KM + ((size_t)hq * T + r) * 96 + d0) = w; } }
#pragma unroll
        for (int p = 0; p < 3; ++p) {
            f32x4 v = (f32x4){bflo(rp[t][p].x), bfhi(rp[t][p].x), bflo(rp[t][p].y), bfhi(rp[t][p].y)};
            f32x4 pr; pr[0] = shx(v[0], 2, lane); pr[1] = shx(v[1], 2, lane); pr[2] = shx(v[2], 2, lane); pr[3] = shx(v[3], 2, lane);
            f32x4 o = second ? pr * sn[t] + v * cs[t] : v * cs[t] - pr * sn[t];
            float f = 1.f; bf16_t* dst;
            if (p == 0) { if (vi < 4) { f = rq * C_MLA; dst = a.QM + ((size_t)vi * T + r) * 96 + 64 + j0; } else { f = C_DIFF; dst = a.QD + ((size_t)(vi - 4) * T + r) * 32 + j0; } }
            else if (p == 1) { if (vi < 4) { f = C_DIFF; dst = a.QD + ((size_t)(vi + 4) * T + r) * 32 + j0; } else dst = a.KD + ((size_t)(vi - 4) * T + r) * 32 + j0; }
            else { if (vi < 4) dst = a.KD + ((size_t)(vi + 4) * T + r) * 32 + j0; else dst = a.KM + ((size_t)(vi - 4) * T + r) * 96 + 64 + j0; }
            if (ok[t]) { u32x2 w; w.x = pk2(o[0] * f, o[1] * f); w.y = pk2(o[2] * f, o[3] * f); *(u32x2*)dst = w; } }
    }
}
__device__ __forceinline__ void prep_vt_tile_fast(const PrepArgs& a, int ti, LAS unsigned char* lds) {
    const int tid = otid(), wave = tid >> 6, lane = tid & 63;
    const int r0 = ti * 64; const bool lat = r0 < TL;
    const int b = lat ? (r0 >> 12) : ((r0 - TL) >> 8), slot0 = lat ? (r0 & (SQ - 1)) : (SQ + ((r0 - TL) & (CL - 1)));
    LAS bf16_t* tile = (LAS bf16_t*)lds;
    u32x2 vv[3][8]; unsigned kv[8];
    { const int c = 4 * lane, h = c >> 6, d = c & 63;
#pragma unroll
      for (int i = 0; i < 8; ++i) { const int r = r0 + wave * 8 + i; const bf16_t* z = a.ZB + (size_t)r * ZC;
          vv[0][i] = *(const u32x2*)(z + O_NAV + 4 * lane); vv[2][i] = *(const u32x2*)(z + O_DV + 4 * lane); vv[1][i] = *(const u32x2*)(a.EB + (size_t)r * D + 384 + h * 128 + 64 + d); kv[i] = *(const unsigned*)(z + O_MKV + 2 * lane); } }
#pragma unroll
    for (int src = 0; src < 3; ++src) {
        bf16_t* dst = src == 0 ? a.VTN : (src == 1 ? a.VTM : a.VTD);
#pragma unroll
        for (int i = 0; i < 8; ++i) { const int tok = wave * 8 + i; u32x2 w = vv[src][i];
            if (src == 1) { const float b0 = bflo(kv[i]), b1 = bfhi(kv[i]); const float rk = rsqrtf(wave_sum(b0 * b0 + b1 * b1, lane) * (1.f / 128.f) + 1e-6f);
                w.x = pk2(bflo(w.x) * rk, bfhi(w.x) * rk); w.y = pk2(bflo(w.y) * rk, bfhi(w.y) * rk); }
            tile[(4 * lane + 0) * 72 + tok] = (bf16_t)(w.x & 0xffffu); tile[(4 * lane + 1) * 72 + tok] = (bf16_t)(w.x >> 16); tile[(4 * lane + 2) * 72 + tok] = (bf16_t)(w.y & 0xffffu); tile[(4 * lane + 3) * 72 + tok] = (bf16_t)(w.y >> 16); }
        __syncthreads();
        for (int i = tid; i < 1024; i += NTHR) { const int row = i >> 2, g = i & 3; const LAS u32x2* p = (const LAS u32x2*)(tile + row * 72 + g * 16);
            const u32x2 q0 = p[0], q1 = p[1], q2 = p[2], q3 = p[3];
            bf16_t* o = dst + ((size_t)(b * 4 + (row >> 6)) * 64 + (row & 63)) * KB + slot0 + g * 16;
            *(u32x4*)o = (u32x4){q0.x, q0.y, q2.x, q2.y}; *(u32x4*)(o + 8) = (u32x4){q1.x, q1.y, q3.x, q3.y}; }
        __syncthreads();
    }
}
__global__ __launch_bounds__(NTHR, 2) void k_prep(PrepArgs a) {
    extern __shared__ __attribute__((aligned(16))) unsigned char lds_raw[];
    LAS unsigned char* lds = (LAS unsigned char*)lds_raw;
    const int wave = threadIdx.x >> 6, lane = threadIdx.x & 63;
    for (int r = blockIdx.x * NWAVES + wave; r < T; r += gridDim.x * NWAVES) prep_row(a, r, lane);
    for (int ti = blockIdx.x; ti < T / 64; ti += gridDim.x) prep_vt_tile(a, ti, lds);
}

#define MFMA32(a, b, c) __builtin_amdgcn_mfma_f32_32x32x16_bf16((a), (b), (c), 0, 0, 0)
__device__ __forceinline__ float xhalf_max(float v) { auto rr = __builtin_amdgcn_permlane32_swap(__float_as_uint(v), __float_as_uint(v), false, false); return fmaxf(__uint_as_float(rr[0]), __uint_as_float(rr[1])); }
__device__ __forceinline__ float xhalf_sum(float v) { auto rr = __builtin_amdgcn_permlane32_swap(__float_as_uint(v), __float_as_uint(v), false, false); return __uint_as_float(rr[0]) + __uint_as_float(rr[1]); }
__device__ __forceinline__ void softmax_step(f32x16& s0, f32x16& s1, float& m, float& l, f32x16& o0, f32x16& o1, bf16x8 (&pf)[4]) {
    float ta = __builtin_fmaxf(__builtin_fmaxf(s0[0], s1[0]), s0[1]), tb = __builtin_fmaxf(__builtin_fmaxf(s1[1], s0[2]), s1[2]);
#pragma unroll
    for (int r = 3; r < 15; r += 2) { ta = __builtin_fmaxf(__builtin_fmaxf(ta, s0[r]), s1[r]); tb = __builtin_fmaxf(__builtin_fmaxf(tb, s0[r + 1]), s1[r + 1]); }
    float tm = __builtin_fmaxf(__builtin_fmaxf(ta, tb), __builtin_fmaxf(s0[15], s1[15]));
    tm = xhalf_max(tm);
    const float mn = fmaxf(m, tm);
    if (__any(mn > m)) { const float sc = __builtin_amdgcn_exp2f(m - mn); l *= sc;
#pragma unroll
        for (int r = 0; r < 16; ++r) { o0[r] *= sc; o1[r] *= sc; } }
    m = mn;
    const f32x2 nm = (f32x2){-mn, -mn};
    f32x2 ls2 = (f32x2){0.f, 0.f};
#pragma unroll
    for (int r = 0; r < 16; ++r) { const f32x2 d = (f32x2){s0[r], s1[r]} + nm; const f32x2 e = (f32x2){__builtin_amdgcn_exp2f(d.x), __builtin_amdgcn_exp2f(d.y)}; s0[r] = e.x; s1[r] = e.y; ls2 += e; }
    l += ls2.x + ls2.y;
#pragma unroll
    for (int s = 0; s < 2; ++s) {
        u32x4 w; w.x = pg8::cvt_pk_bf16(s0[8 * s], s0[8 * s + 1]); w.y = pg8::cvt_pk_bf16(s0[8 * s + 2], s0[8 * s + 3]); w.z = pg8::cvt_pk_bf16(s0[8 * s + 4], s0[8 * s + 5]); w.w = pg8::cvt_pk_bf16(s0[8 * s + 6], s0[8 * s + 7]);
        pf[s] = __builtin_bit_cast(bf16x8, w);
        u32x4 x; x.x = pg8::cvt_pk_bf16(s1[8 * s], s1[8 * s + 1]); x.y = pg8::cvt_pk_bf16(s1[8 * s + 2], s1[8 * s + 3]); x.z = pg8::cvt_pk_bf16(s1[8 * s + 4], s1[8 * s + 5]); x.w = pg8::cvt_pk_bf16(s1[8 * s + 6], s1[8 * s + 7]);
        pf[2 + s] = __builtin_bit_cast(bf16x8, x);
    }
}
struct AttnArgs { const bf16_t* Q; const bf16_t* K; const bf16_t* VT; bf16_t* O; const float* lamv; const float* subln; float lam_init; int pad; };
template <int NS> __device__ __forceinline__ void attn_unit(const AttnArgs& a, int b, int h, int qb, LAS unsigned char* lds, float lam) {
    constexpr int DQ = NS == 1 ? 96 : 64, KS = DQ * 2 + 16, VS = 144, KBYTES = 64 * KS, BUF = KBYTES + 64 * VS;
    constexpr int KCH = DQ / 8, NKC = 64 * KCH, NCH = NKC + 512, CPT = (NCH + NTHR - 1) / NTHR;
    const int tid = otid(), wave = __builtin_amdgcn_readfirstlane(tid >> 6), lane = tid & 63, r32 = lane & 31, hi = lane >> 5;
    const bool ctxq = qb == 16;
    const int qrow = (ctxq ? TL + b * CL : b * SQ + qb * 256) + wave * 32 + r32;
    const int jt0 = ctxq ? 64 : 0, ntile = ctxq ? 4 : 68;
    bf16x8 qf[NS == 1 ? 6 : 4];
    if (NS == 1) {
#pragma unroll
        for (int ks = 0; ks < 6; ++ks) qf[ks] = *(const bf16x8*)(a.Q + ((size_t)h * T + qrow) * 96 + 16 * ks + 8 * hi);
    } else {
#pragma unroll
        for (int c = 0; c < 2; ++c)
#pragma unroll
            for (int ks = 0; ks < 2; ++ks) qf[c * 2 + ks] = *(const bf16x8*)(a.Q + ((size_t)(h * 2 + c) * T + qrow) * 32 + 16 * ks + 8 * hi);
    }
    u32x4 stg[CPT];
    auto gload = [&](int jt) {
        const int krow0 = (jt < 64) ? b * SQ + jt * 64 : TL + b * CL + (jt - 64) * 64;
#pragma unroll
        for (int i = 0; i < CPT; ++i) { const int c = tid + i * NTHR;
            if (c < NKC) { const int key = c / KCH, kc = c % KCH;
                const bf16_t* src = NS == 1 ? a.K + ((size_t)h * T + krow0 + key) * 96 + kc * 8 : a.K + ((size_t)(h * 2 + (kc >> 2)) * T + krow0 + key) * 32 + (kc & 3) * 8;
                stg[i] = *(const u32x4*)src; }
            else if (c < NCH) { const int v = c - NKC, d = v >> 3, vc = v & 7; stg[i] = *(const u32x4*)(a.VT + ((size_t)(b * 4 + h) * 64 + d) * KB + jt * 64 + vc * 8); } }
    };
    auto lstore = [&](int buf) {
#pragma unroll
        for (int i = 0; i < CPT; ++i) { const int c = tid + i * NTHR;
            if (c < NKC) { const int key = c / KCH, kc = c % KCH; *(LAS u32x4*)(lds + buf * BUF + key * KS + kc * 16) = stg[i]; }
            else if (c < NCH) { const int v = c - NKC, d = v >> 3, vc = v & 7; *(LAS u32x4*)(lds + buf * BUF + KBYTES + d * VS + vc * 16) = stg[i]; } }
    };
    float m[NS], l[NS]; f32x16 o[NS][2];
#pragma unroll
    for (int n = 0; n < NS; ++n) { m[n] = -1e30f; l[n] = 0.f;
#pragma unroll
        for (int r = 0; r < 16; ++r) { o[n][0][r] = 0.f; o[n][1][r] = 0.f; } }
    const bool lag = wave >= 4;
    bf16x8 pf[NS][4];
    bf16x8 vfr[NS == 1 ? 2 : 1][NS == 1 ? 4 : 1];
    auto pv = [&](int buf) { const LAS unsigned char* vb = lds + buf * BUF + KBYTES + r32 * VS + hi * 16;
#pragma unroll
        for (int db = 0; db < 2; ++db)
#pragma unroll
            for (int t = 0; t < 4; ++t) { bf16x8 vf; if (NS == 1) vf = vfr[NS == 1 ? db : 0][NS == 1 ? t : 0]; else vf = *(const LAS bf16x8*)(vb + db * 32 * VS + t * 32);
#pragma unroll
                for (int n = 0; n < NS; ++n) o[n][db] = MFMA32(vf, pf[n][t], o[n][db]); } };
    gload(jt0); lstore(0); __syncthreads();
    int cur = 0, prv = 2;
    constexpr int NKF = NS == 1 ? 6 : 4;
    for (int it = 0; it < ntile; ++it) {
        const int nxt = cur == 2 ? 0 : cur + 1;
        if (it + 1 < ntile) gload(jt0 + it + 1);
        if (lag && it > 0) pv(prv);
        bf16x8 kfr[2][NKF];
        { const LAS unsigned char* kb = lds + cur * BUF + r32 * KS + hi * 16;
#pragma unroll
          for (int ks = 0; ks < NKF; ++ks) { kfr[0][ks] = *(const LAS bf16x8*)(kb + ks * 32); kfr[1][ks] = *(const LAS bf16x8*)(kb + 32 * KS + ks * 32); } }
        asm volatile("" ::: "memory");
        f32x16 s0, s1;
#pragma unroll
        for (int r = 0; r < 16; ++r) { s0[r] = 0.f; s1[r] = 0.f; }
        constexpr int NK = NS == 1 ? 6 : 2;
#pragma unroll
        for (int ks = 0; ks < NK; ++ks) { s0 = MFMA32(kfr[0][ks], qf[ks], s0); s1 = MFMA32(kfr[1][ks], qf[ks], s1); }
        if (NS == 1) { const LAS unsigned char* vb = lds + cur * BUF + KBYTES + r32 * VS + hi * 16;
#pragma unroll
          for (int db = 0; db < 2; ++db)
#pragma unroll
              for (int t = 0; t < 4; ++t) vfr[NS == 1 ? db : 0][NS == 1 ? t : 0] = *(const LAS bf16x8*)(vb + db * 32 * VS + t * 32);
          asm volatile("" ::: "memory"); }
        softmax_step(s0, s1, m[0], l[0], o[0][0], o[0][1], pf[0]);
        if (NS == 2) {
#pragma unroll
            for (int r = 0; r < 16; ++r) { s0[r] = 0.f; s1[r] = 0.f; }
#pragma unroll
            for (int ks = 0; ks < 2; ++ks) { s0 = MFMA32(kfr[0][2 + ks], qf[2 + ks], s0); s1 = MFMA32(kfr[1][2 + ks], qf[2 + ks], s1); }
            softmax_step(s0, s1, m[NS - 1], l[NS - 1], o[NS - 1][0], o[NS - 1][1], pf[NS - 1]);
        }
        if (!lag) pv(cur);
        if (it + 1 < ntile) lstore(nxt);
        __syncthreads();
        prv = cur; cur = nxt;
    }
    if (lag) pv(prv);
    float inv[NS];
#pragma unroll
    for (int n = 0; n < NS; ++n) inv[n] = 1.f / xhalf_sum(l[n]);
    bf16_t* orow = a.O + (size_t)qrow * D + (NS == 1 ? 256 : 768) + h * 64;
    if (NS == 1) {
#pragma unroll
        for (int db = 0; db < 2; ++db)
#pragma unroll
            for (int g = 0; g < 4; ++g) { u32x2 w; w.x = pg8::cvt_pk_bf16(o[0][db][4 * g] * inv[0], o[0][db][4 * g + 1] * inv[0]); w.y = pg8::cvt_pk_bf16(o[0][db][4 * g + 2] * inv[0], o[0][db][4 * g + 3] * inv[0]);
                *(u32x2*)(orow + 32 * db + 8 * g + 4 * hi) = w; }
    } else {
        const float i1 = inv[0], i2 = lam * inv[NS - 1]; float ss = 0.f;
#pragma unroll
        for (int db = 0; db < 2; ++db)
#pragma unroll
            for (int r = 0; r < 16; ++r) { const float v = o[0][db][r] * i1 - o[NS - 1][db][r] * i2; o[0][db][r] = v; ss += v * v; }
        ss = xhalf_sum(ss);
        const float rr = rsqrtf(ss * (1.f / 64.f) + 1e-6f) * (1.f - a.lam_init);
#pragma unroll
        for (int db = 0; db < 2; ++db)
#pragma unroll
            for (int g = 0; g < 4; ++g) { const int d0 = 32 * db + 8 * g + 4 * hi; const f32x4 sl = *(const f32x4*)(a.subln + d0);
                u32x2 w; w.x = pg8::cvt_pk_bf16(o[0][db][4 * g] * rr * sl[0], o[0][db][4 * g + 1] * rr * sl[1]); w.y = pg8::cvt_pk_bf16(o[0][db][4 * g + 2] * rr * sl[2], o[0][db][4 * g + 3] * rr * sl[3]);
                *(u32x2*)(orow + d0) = w; }
    }
    __syncthreads();
}
template <int NS> __global__ __launch_bounds__(NTHR, 2) void k_attn(AttnArgs a) {
    extern __shared__ __attribute__((aligned(16))) unsigned char lds_raw[];
    LAS unsigned char* lds = (LAS unsigned char*)lds_raw;
    float lam = 0.f;
    if (NS == 2) { float s1 = 0.f, s2 = 0.f; for (int i = 0; i < 32; ++i) { s1 += a.lamv[i] * a.lamv[32 + i]; s2 += a.lamv[64 + i] * a.lamv[96 + i]; } lam = expf(s1) - expf(s2) + a.lam_init; }
    for (int u = blockIdx.x; u < NB * 4 * 17; u += gridDim.x) { const int qb = u % 17, bh = u / 17; attn_unit<NS>(a, bh >> 2, bh & 3, qb, lds, lam); }
}


#define MFMA16(a, b, c) __builtin_amdgcn_mfma_f32_16x16x32_bf16((a), (b), (c), 0, 0, 0)
constexpr int NCHK = KB / 64;
struct S5Prep { const float* lam_re; const float* lam_im; const float* log_dt; const float* b_re; const float* b_im; const float* c_re; const float* c_im; float4* S5A; bf16_t* S5B; bf16_t* S5C; };
__global__ void k_s5prep(S5Prep a) {
    const int i = blockIdx.x * 256 + threadIdx.x; const int gi = i >> 6, p = i & 63;
    const double lre = a.lam_re[i], lim = a.lam_im[i], dt = exp((double)a.log_dt[gi]);
    const double x = lre * dt; double y = lim * dt; y -= 6.283185307179586476925 * rint(y / 6.283185307179586476925);
    float sy, cy; sincosf((float)y, &sy, &cy); const float sh = sinf((float)(0.5 * y));
    const double em1 = x * (1.0 + x * 0.5 * (1.0 + x * (1.0 / 3.0) * (1.0 + x * 0.25 * (1.0 + x * 0.2 * (1.0 + x * (1.0 / 6.0))))));
    const double nr = em1 * (double)cy - 2.0 * (double)sh * (double)sh, ni = (1.0 + em1) * (double)sy;
    const double ar = 1.0 + nr, ai = ni;
    double pr = ar, pi = ai;
#pragma unroll
    for (int k = 0; k < 6; ++k) { const double t = pr * pr - pi * pi; pi = 2.0 * pr * pi; pr = t; }
    a.S5A[i] = make_float4((float)ar, (float)ai, (float)pr, (float)pi);
    const double den = lre * lre + lim * lim; const float fr = (float)((nr * lre + ni * lim) / den), fi = (float)((ni * lre - nr * lim) / den);
    for (int c = 0; c < 16; ++c) { const float br = a.b_re[i * 16 + c], bi = a.b_im[i * 16 + c];
        a.S5B[((size_t)gi * 128 + p) * 16 + c] = (bf16_t)f2bf(fr * br - fi * bi); a.S5B[((size_t)gi * 128 + 64 + p) * 16 + c] = (bf16_t)f2bf(fr * bi + fi * br);
        a.S5C[((size_t)gi * 16 + c) * 128 + p] = (bf16_t)f2bf(a.c_re[(gi * 16 + c) * 64 + p]); a.S5C[((size_t)gi * 16 + c) * 128 + 64 + p] = (bf16_t)f2bf(-a.c_im[(gi * 16 + c) * 64 + p]); }
}
struct S5Args { const bf16_t* ZB; const float4* S5A; const bf16_t* S5B; const bf16_t* S5C; const float* dskip; float2* S; bf16_t* Y5; unsigned long long* dbg; };
__device__ __forceinline__ int s5_chunk_row0(int b, int tc) { return tc < 4 ? TL + b * CL + tc * 64 : b * SQ + (tc - 4) * 64; }
__device__ __forceinline__ int s5_tc_of(int dir, int j) { return dir == 0 ? j : (j < 4 ? 3 - j : 71 - j); }
template <bool WRITE_H> __device__ __forceinline__ void s5_subblock(const bf16_t* ZB, int row0, int g, int dir, const bf16x8 (&bfr)[8], float ar, float ai, float& hr, float& hi, LAS float* tile, int lane) {
    const int n16 = lane & 15, kq = lane >> 4;
    bf16x8 af = (bf16x8){0, 0, 0, 0, 0, 0, 0, 0};
    if (kq < 2) af = *(const bf16x8*)(ZB + (size_t)(row0 + n16) * ZC + O_S5 + g * 16 + 8 * kq);
    f32x4 accs[8];
#pragma unroll
    for (int nb = 0; nb < 8; ++nb) { accs[nb] = (f32x4){0.f, 0.f, 0.f, 0.f}; accs[nb] = MFMA16(af, bfr[nb], accs[nb]); }
    __builtin_amdgcn_sched_barrier(0); asm volatile("s_nop 15\n\ts_nop 15" :: "v"(af) : "memory"); __builtin_amdgcn_sched_barrier(0);
#pragma unroll
    for (int nb = 0; nb < 8; ++nb)
#pragma unroll
        for (int i = 0; i < 4; ++i) tile[(4 * kq + i) * 132 + 16 * nb + n16] = accs[nb][i];
#pragma unroll
    for (int ii = 0; ii < 16; ++ii) { const int i = dir == 0 ? ii : 15 - ii;
        const float br = tile[i * 132 + lane], bi = tile[i * 132 + 64 + lane];
        const float nr = ar * hr - ai * hi + br, ni = ar * hi + ai * hr + bi; hr = nr; hi = ni;
        if (WRITE_H) { tile[i * 132 + lane] = hr; tile[i * 132 + 64 + lane] = hi; } }
}
__device__ __forceinline__ void s5_load_b(const S5Args& a, int gi, int lane, bf16x8 (&bfr)[8]) {
    const int n16 = lane & 15, kq = lane >> 4;
#pragma unroll
    for (int nb = 0; nb < 8; ++nb) { bfr[nb] = (bf16x8){0, 0, 0, 0, 0, 0, 0, 0}; if (kq < 2) bfr[nb] = *(const bf16x8*)(a.S5B + ((size_t)gi * 128 + 16 * nb + n16) * 16 + 8 * kq); }
}
__device__ __forceinline__ void s5_pass1_item(const S5Args& a, int b, int dir, int j, int g, LAS float* tile, int lane) {
    const int gi = dir * 16 + g; const float4 ap = a.S5A[gi * 64 + lane];
    bf16x8 bfr[8]; s5_load_b(a, gi, lane, bfr);
    const int row0 = s5_chunk_row0(b, s5_tc_of(dir, j));
    float hr = 0.f, hi = 0.f;
    if (a.dbg) { unsigned long long cs = 0; const int n16 = lane & 15, kq = lane >> 4;
        for (int tsb = 0; tsb < 4; ++tsb) if (kq < 2) { const size_t off = (size_t)(row0 + 16 * tsb + n16) * ZC + O_S5 + g * 16 + 8 * kq; const u32x4 w = *(const u32x4*)(a.ZB + off);
            cs += ((unsigned long long)w.x + 3ull * w.y + 5ull * w.z + 7ull * w.w) * (unsigned long long)((off & 4095) + 1); }
        cs += (unsigned long long)__float_as_uint(ap.x) * 11ull + (unsigned long long)__float_as_uint(ap.y) * 13ull;
        for (int nb = 0; nb < 8; ++nb) { const u32x4 w = __builtin_bit_cast(u32x4, bfr[nb]); cs += ((unsigned long long)w.x + 3ull * w.y + 5ull * w.z + 7ull * w.w) * (unsigned long long)(nb + 1); }
        for (int o = 1; o < 64; o <<= 1) cs += __shfl_xor(cs, o);
        if (lane == 0) atomicAdd(a.dbg, cs); }
#pragma unroll 1
    for (int sbi = 0; sbi < 4; ++sbi) { const int tsb = dir == 0 ? sbi : 3 - sbi; s5_subblock<false>(a.ZB, row0 + 16 * tsb, g, dir, bfr, ap.x, ap.y, hr, hi, tile, lane); }
    a.S[((size_t)((b * 2 + dir) * NCHK + j) * 16 + g) * 64 + lane] = make_float2(hr, hi);
    if (a.dbg) { const size_t idx = ((size_t)((b * 2 + dir) * NCHK + j) * 16 + g) * 64 + lane; unsigned long long cs = ((unsigned long long)__float_as_uint(hr) + 3ull * __float_as_uint(hi)) * (unsigned long long)((idx & 1023) + 1);
        for (int o = 1; o < 64; o <<= 1) cs += __shfl_xor(cs, o);
        if (lane == 0) atomicAdd(a.dbg, cs); }
}
__device__ __forceinline__ void s5_pass2_item(const S5Args& a, int b, int tc, int g, LAS float* tile, int lane) {
    const int n16 = lane & 15, kq = lane >> 4;
    const int row0 = s5_chunk_row0(b, tc);
    f32x4 yacc[4];
#pragma unroll
    for (int t = 0; t < 4; ++t) yacc[t] = (f32x4){0.f, 0.f, 0.f, 0.f};
#pragma unroll 1
    for (int dir = 0; dir < 2; ++dir) {
        const int gi = dir * 16 + g; const float4 ap = a.S5A[gi * 64 + lane];
        const int j = dir == 0 ? tc : (tc < 4 ? 3 - tc : 71 - tc);
        float hr = 0.f, hi = 0.f;
        const float2* sp = a.S + ((size_t)((b * 2 + dir) * NCHK) * 16 + g) * 64 + lane;
#pragma unroll 4
        for (int jj = 0; jj < j; ++jj) { const float2 sv = sp[(size_t)jj * 16 * 64]; const float nr = ap.z * hr - ap.w * hi + sv.x, ni = ap.z * hi + ap.w * hr + sv.y; hr = nr; hi = ni; }
        bf16x8 bfr[8]; s5_load_b(a, gi, lane, bfr);
        bf16x8 cf[4];
#pragma unroll
        for (int ks = 0; ks < 4; ++ks) cf[ks] = *(const bf16x8*)(a.S5C + ((size_t)gi * 16 + n16) * 128 + 32 * ks + 8 * kq);
#pragma unroll
        for (int sbi = 0; sbi < 4; ++sbi) { const int tsb = dir == 0 ? sbi : 3 - sbi;
            s5_subblock<true>(a.ZB, row0 + 16 * tsb, g, dir, bfr, ap.x, ap.y, hr, hi, tile, lane);
#pragma unroll
            for (int ks = 0; ks < 4; ++ks) { const LAS float* hp = tile + n16 * 132 + 32 * ks + 8 * kq; const f32x4 h0 = *(const LAS f32x4*)hp, h1 = *(const LAS f32x4*)(hp + 4);
                u32x4 w; w.x = pg8::cvt_pk_bf16(h0[0], h0[1]); w.y = pg8::cvt_pk_bf16(h0[2], h0[3]); w.z = pg8::cvt_pk_bf16(h1[0], h1[1]); w.w = pg8::cvt_pk_bf16(h1[2], h1[3]);
                if (tsb == 0) yacc[0] = MFMA16(__builtin_bit_cast(bf16x8, w), cf[ks], yacc[0]); else if (tsb == 1) yacc[1] = MFMA16(__builtin_bit_cast(bf16x8, w), cf[ks], yacc[1]);
                else if (tsb == 2) yacc[2] = MFMA16(__builtin_bit_cast(bf16x8, w), cf[ks], yacc[2]); else yacc[3] = MFMA16(__builtin_bit_cast(bf16x8, w), cf[ks], yacc[3]); } }
    }
    const float dsk = a.dskip[g * 16 + n16];
#pragma unroll
    for (int t = 0; t < 4; ++t)
#pragma unroll
        for (int i = 0; i < 4; ++i) { const size_t row = (size_t)(row0 + 16 * t + 4 * kq + i); const float u = bf2f(a.ZB[row * ZC + O_S5 + g * 16 + n16]);
            a.Y5[row * 256 + g * 16 + n16] = (bf16_t)f2bf(yacc[t][i] + dsk * u); }
}
__global__ __launch_bounds__(NTHR, 2) void k_s5_pass1(S5Args a) {
    extern __shared__ __attribute__((aligned(16))) unsigned char lds_raw[];
    const int wave = threadIdx.x >> 6, lane = threadIdx.x & 63; LAS float* tile = (LAS float*)((LAS unsigned char*)lds_raw + wave * 8448);
    for (int it = blockIdx.x; it < NB * 2 * NCHK * 2; it += gridDim.x) { const int gh = it & 1, j = (it >> 1) % NCHK, bd = (it >> 1) / NCHK; s5_pass1_item(a, bd >> 1, bd & 1, j, gh * 8 + wave, tile, lane); }
}
__global__ __launch_bounds__(NTHR, 2) void k_s5_pass2(S5Args a) {
    extern __shared__ __attribute__((aligned(16))) unsigned char lds_raw[];
    const int wave = threadIdx.x >> 6, lane = threadIdx.x & 63; LAS float* tile = (LAS float*)((LAS unsigned char*)lds_raw + wave * 8448);
    for (int it = blockIdx.x; it < NB * NCHK * 2; it += gridDim.x) { const int gh = it & 1, tc = (it >> 1) % NCHK, b = (it >> 1) / NCHK; s5_pass2_item(a, b, tc, gh * 8 + wave, tile, lane); }
}


struct NaArgs { const bf16_t* ZB; const bf16_t* VTN; bf16_t* O; const float* rpb; };
__device__ __forceinline__ void na_wave(const NaArgs& a, int item, const LAS float* bias, int wave, int lane) {
    const int r32 = lane & 31, hi = lane >> 5;
    const bool ctxq = item >= 512; const int bh = ctxq ? item - 512 : item >> 4, b = bh >> 2, h = bh & 3;
    int gr = 0, c0 = 0, qrow;
    if (ctxq) qrow = TL + b * CL + wave * 32 + r32; else { gr = (item & 15) * 4 + (wave >> 1); c0 = (wave & 1) * 32; qrow = b * SQ + gr * 64 + c0 + r32; }
    bf16x8 qf[4];
#pragma unroll
    for (int ks = 0; ks < 4; ++ks) qf[ks] = *(const bf16x8*)(a.ZB + (size_t)qrow * ZC + O_NAQ + h * 64 + 16 * ks + 8 * hi);
    float m = -1e30f, l = 0.f; f32x16 o0, o1;
#pragma unroll
    for (int r = 0; r < 16; ++r) { o0[r] = 0.f; o1[r] = 0.f; }
    const bf16_t* vt = a.VTN + ((size_t)(b * 4 + h) * 64 + r32) * KB + 8 * hi;
    const int c = c0 + r32, cs = min(max(c - 8, 0), 48), r0 = min(max(gr - 4, 0), 56);
    const int ntile = ctxq ? 4 : 12;
    bf16x8 kf[8], vf[8];
    auto ktok = [&](int t) { const bool local = !ctxq && t < 8; return local ? b * SQ + (r0 + t) * 64 : TL + b * CL + (ctxq ? t : t - 8) * 64; };
    { const bf16_t* kp = a.ZB + (size_t)(ktok(0) + r32) * ZC + O_NAK + h * 64 + 8 * hi;
#pragma unroll
      for (int ks = 0; ks < 4; ++ks) { kf[ks] = *(const bf16x8*)(kp + 16 * ks); kf[4 + ks] = *(const bf16x8*)(kp + (size_t)32 * ZC + 16 * ks); } }
#pragma unroll 1
    for (int t = 0; t < ntile; ++t) {
        const bool local = !ctxq && t < 8;
        const int slot0 = local ? (r0 + t) * 64 : SQ + (ctxq ? t : t - 8) * 64;
#pragma unroll
        for (int q = 0; q < 4; ++q) { vf[q] = *(const bf16x8*)(vt + slot0 + 16 * q); vf[4 + q] = *(const bf16x8*)(vt + (size_t)32 * KB + slot0 + 16 * q); }
        f32x16 s0, s1;
#pragma unroll
        for (int r = 0; r < 16; ++r) { s0[r] = 0.f; s1[r] = 0.f; }
#pragma unroll
        for (int ks = 0; ks < 4; ++ks) { s0 = MFMA32(kf[ks], qf[ks], s0); s1 = MFMA32(kf[4 + ks], qf[ks], s1); }
        if (t + 1 < ntile) { const bf16_t* kp = a.ZB + (size_t)(ktok(t + 1) + r32) * ZC + O_NAK + h * 64 + 8 * hi;
#pragma unroll
            for (int ks = 0; ks < 4; ++ks) { kf[ks] = *(const bf16x8*)(kp + 16 * ks); kf[4 + ks] = *(const bf16x8*)(kp + (size_t)32 * ZC + 16 * ks); } }
        if (local) { const LAS float* brow = bias + (h * 15 + (r0 + t - gr + 7)) * 32;
#pragma unroll
            for (int r = 0; r < 16; ++r) { const int kk = (r & 3) + 8 * (r >> 2) + 4 * hi;
                { const int kc = kk, off = kc - cs; s0[r] = (off >= 0 && off < 16) ? s0[r] * C_NA + brow[kc - c + 15] : -1e30f; }
                { const int kc = 32 + kk, off = kc - cs; s1[r] = (off >= 0 && off < 16) ? s1[r] * C_NA + brow[kc - c + 15] : -1e30f; } }
        } else {
#pragma unroll
            for (int r = 0; r < 16; ++r) { s0[r] *= C_NA; s1[r] *= C_NA; } }
        bf16x8 pf[4];
        softmax_step(s0, s1, m, l, o0, o1, pf);
#pragma unroll
        for (int q = 0; q < 4; ++q) { o0 = MFMA32(vf[q], pf[q], o0); o1 = MFMA32(vf[4 + q], pf[q], o1); }
    }
    const float inv = 1.f / xhalf_sum(l);
    bf16_t* orow = a.O + (size_t)qrow * D + h * 64;
#pragma unroll
    for (int g = 0; g < 4; ++g) {
        u32x2 w; w.x = pg8::cvt_pk_bf16(o0[4 * g] * inv, o0[4 * g + 1] * inv); w.y = pg8::cvt_pk_bf16(o0[4 * g + 2] * inv, o0[4 * g + 3] * inv); *(u32x2*)(orow + 8 * g + 4 * hi) = w;
        u32x2 x; x.x = pg8::cvt_pk_bf16(o1[4 * g] * inv, o1[4 * g + 1] * inv); x.y = pg8::cvt_pk_bf16(o1[4 * g + 2] * inv, o1[4 * g + 3] * inv); *(u32x2*)(orow + 32 + 8 * g + 4 * hi) = x; }
}
__device__ __forceinline__ void na_load_bias(const float* rpb, LAS float* bias) {
    for (int i = otid(); i < 4 * 15 * 32; i += NTHR) { const int j = i & 31, hr = i >> 5; bias[i] = j < 31 ? rpb[hr * 31 + j] * 1.4426950408889634f : 0.f; }
    __syncthreads();
}
__global__ __launch_bounds__(NTHR, 2) void k_na2(NaArgs a) {
    extern __shared__ __attribute__((aligned(16))) unsigned char lds_raw[];
    LAS float* bias = (LAS float*)lds_raw;
    na_load_bias(a.rpb, bias);
    const int wave = threadIdx.x >> 6, lane = threadIdx.x & 63;
    for (int item = blockIdx.x; item < 544; item += gridDim.x) na_wave(a, item, bias, wave, lane);
}


#ifdef F8PROBE
__global__ __launch_bounds__(NTHR, 2) void k_gemm8_probe(GemmArgs a) {
    extern __shared__ __attribute__((aligned(16))) unsigned char lds_raw[];
    LAS unsigned char* lds = (LAS unsigned char*)lds_raw;
    pg8::StaticOrder S; S.init(a.nM, a.nN, (int)gridDim.x, (int)blockIdx.x, a.A, a.lda, a.B, a.ldb);
    pg8::EpiStoreS E; E.O = a.O; E.ldc = a.ldc; E.scale = 0.5f;
    pg8::gemm_phase<pg8::EpiStoreS, pg8::StaticOrder, true>(lds, a.K, a.lda, a.ldb, S, E);
}
#endif
__global__ void k_chk(const unsigned* p, size_t nwords, unsigned long long* slot) {
    unsigned long long s = 0;
    for (size_t i = (size_t)blockIdx.x * 256 + threadIdx.x; i < nwords; i += (size_t)gridDim.x * 256) s += (unsigned long long)p[i] * (unsigned long long)((i & 1023) + 1);
#pragma unroll
    for (int o = 1; o < 64; o <<= 1) s += __shfl_xor(s, o);
    if ((threadIdx.x & 63) == 0) atomicAdd(slot, s);
}
__global__ void k_chk_final(const unsigned long long* tab, int n, float* out, size_t nout) {
    int first = -1;
    for (int i = 0; i < n; ++i) if (tab[i] != tab[64 + i]) { first = i; break; }
    if (first < 0) return;
    const float c = sqrtf((float)(first + 1));
    for (size_t i = (size_t)blockIdx.x * 256 + threadIdx.x; i < nout; i += (size_t)gridDim.x * 256) out[i] = c;
}

#define XB_TMO      128
#define XB_XCNT(j)  (256  + 64 * (j))
#define XB_XSUB(j)  (1280 + 64 * (j))
#define XB_XGEN(j)  (2304 + 64 * (j))
#define XB_TOP      3328
#define XB_TOPGEN   3392
#define XCD_BAR_WORDS 3456
#define XB_SPIN_CAP (1u << 18)

__device__ __forceinline__ unsigned xb_ld(unsigned* p)              { return __hip_atomic_load(p, __ATOMIC_RELAXED, __HIP_MEMORY_SCOPE_AGENT); }
__device__ __forceinline__ unsigned xb_add(unsigned* p, unsigned v) { return __hip_atomic_fetch_add(p, v, __ATOMIC_RELAXED, __HIP_MEMORY_SCOPE_AGENT); }
__device__ __forceinline__ unsigned xb_xcc_id() { return (unsigned)__builtin_amdgcn_s_getreg((3 << 11) | 20) & 0xFu; }
#define XB_SPIN(cond, bar) do { unsigned _sp = 0; while (cond) { __builtin_amdgcn_s_sleep(1); \
    if ((++_sp & 255u) == 0u) { if (xb_ld(&(bar)[XB_TMO])) break; if (_sp > XB_SPIN_CAP) { atomicAdd(&(bar)[XB_TMO], 1u); break; } } } } while (0)

struct XcdBarrier {
    unsigned* bar; unsigned x;
    volatile LAS unsigned* st;
};

__device__ __forceinline__ XcdBarrier xcd_barrier_post(unsigned* bar, volatile LAS unsigned* st) {
    XcdBarrier b; b.bar = bar; b.x = xb_xcc_id(); b.st = st;
    if (threadIdx.x == 0) (void)xb_add(&bar[XB_XCNT(b.x)], 1u);
    return b;
}
__device__ __forceinline__ void xcd_barrier_complete(unsigned* bar, unsigned x, unsigned& nloc, unsigned& nx) {
    const unsigned G = gridDim.x * gridDim.y * gridDim.z;
    unsigned sum, cnt, mine, sp = 0u;
    for (;;) {
        sum = 0u; cnt = 0u; mine = 0u;
#pragma unroll
        for (unsigned j = 0; j < 16; ++j) { const unsigned c = xb_ld(&bar[XB_XCNT(j)]); sum += c; cnt += (c > 0u) ? 1u : 0u; mine = (j == x) ? c : mine; }
        if (sum == G) break;
        __builtin_amdgcn_s_sleep(1);
        if ((++sp & 255u) == 0u) { if (xb_ld(&bar[XB_TMO])) break; if (sp > XB_SPIN_CAP) { atomicAdd(&bar[XB_TMO], 1u); break; } }
    }
    nloc = mine > 0u ? mine : 1u; nx = cnt > 0u ? cnt : 1u;
}

__device__ __forceinline__ void xcd_barrier(const XcdBarrier& b) {
    asm volatile("s_waitcnt vmcnt(0)" ::: "memory");
    __syncthreads();
    if (threadIdx.x == 0) {
        unsigned* bar = b.bar;
        __builtin_amdgcn_s_waitcnt(0);
        unsigned nloc = b.st[0], nx = b.st[1];
        if (nloc == 0u) { xcd_barrier_complete(bar, b.x, nloc, nx); b.st[0] = nloc; b.st[1] = nx; }
        const unsigned old = xb_add(&bar[XB_XSUB(b.x)], 1u);
        const unsigned gen = old / nloc;
        if (old + 1u == (gen + 1u) * nloc) {
            __builtin_amdgcn_fence(__ATOMIC_RELEASE, "agent");
            asm volatile("s_waitcnt vmcnt(0)" ::: "memory");
            const unsigned og = xb_add(&bar[XB_TOP], 1u);
            const unsigned tg = og / nx;
            if (og + 1u == (tg + 1u) * nx) xb_add(&bar[XB_TOPGEN], 1u);
            else XB_SPIN(xb_ld(&bar[XB_TOPGEN]) == tg, bar);
            __builtin_amdgcn_fence(__ATOMIC_ACQUIRE, "agent");
            xb_add(&bar[XB_XGEN(b.x)], 1u);
            asm volatile("s_waitcnt vmcnt(0)" ::: "memory");
        } else {
            XB_SPIN(xb_ld(&bar[XB_XGEN(b.x)]) == gen, bar);
            __builtin_amdgcn_fence(__ATOMIC_ACQUIRE, "agent");
            asm volatile("s_waitcnt vmcnt(0)" ::: "memory");
        }
    }
    __syncthreads();
}


namespace W {
constexpr size_t CTL = 0, CTL_ZERO = 64 * 1024;
constexpr size_t PLAN = 16384, QCTR = 32768;
constexpr size_t LAMV = 128 * 1024, ROPE = 132 * 1024, WS13 = 192 * 1024  , HSM = 256 * 1024  , WSIN = 448 * 1024  , MOD = 1 * MiB, TSLOT = 2 * MiB, TGATE = 2 * MiB + 512 * 1024, LTOK = 3 * MiB, S5TAB = 5 * MiB, MODP = 8 * MiB, HGS = MODP  , WS13M = MODP + 1 * MiB  ;
constexpr size_t X = 16 * MiB, H = 152 * MiB, WB = 221 * MiB, BIG = 408 * MiB, R2 = 901 * MiB, END = 1097 * MiB;
constexpr size_t WING = WB, WBR = WB + 13 * MiB, WOUT = WB + 15 * MiB, WEXP = WB + 17 * MiB, WGLU = WB + 18 * MiB, WF13 = WB + 19 * MiB, WF2 = WF13 + 112 * MiB;
constexpr size_t Z = BIG, G = BIG + 153 * MiB, E = BIG + 425 * MiB, ACT = BIG;
constexpr size_t QM = R2, KM = R2 + (size_t)4 * T * 96 * 2, QD = R2 + 51 * MiB, KD = R2 + 68 * MiB, VTN = R2 + 85 * MiB, VTM = R2 + 102 * MiB, VTD = R2 + 119 * MiB, S5S = R2 + 136 * MiB, Y5B = R2 + 145 * MiB;
constexpr size_t HG = R2, FB = R2, H8M = R2 + 162 * MiB;
constexpr size_t WG8 = WING + (size_t)ZC * D * 2;
constexpr size_t OB = H, MB = E, YB = Z;
static_assert(WF2 + 56 * MiB <= BIG && G + 272 * MiB <= E && E + 68 * MiB <= R2 && Y5B + 17 * MiB <= END && ACT + 490 * MiB <= R2 && HG + 140 * MiB <= END, "d_ws map");
}
#ifndef DUP_L4
#define DUP_L4 1
#endif
#ifndef DUP_L1
#define DUP_L1 1
#endif
#ifndef DUP_L6
#define DUP_L6 1
#endif
#ifndef DUP_L3
#define DUP_L3 1
#endif
#ifndef DUP_L2
#define DUP_L2 1
#endif
#ifndef DUP_SUB
#define DUP_SUB -1
#endif
#ifndef GATE8
#define GATE8 1
#endif
#ifndef MOEQ
#define MOEQ 1
#endif
#ifndef FFN2_8
#define FFN2_8 1
#endif
#ifndef GQ
#define GQ 1
#endif
#ifndef FFNQ
#define FFNQ 1
#endif
#ifndef FFN8
#define FFN8 1
#endif
#ifndef DUP_FFN
#define DUP_FFN 1
#endif
constexpr int LDS_UP = 131072;
struct FwdArgs { const float* in[41]; unsigned char* ws; float* out; int lo, hi; };
namespace pg8 {
struct EpiZG {
    static constexpr bool PERM = true;
    bf16_t* Zo; bf16_t* Go; const float* bias;
    __device__ __forceinline__ void operator()(const f32x4 (&acc)[2][2][4][2], const Unit& u, int wr, int wc, int fr, int fq) const {
        if (u.pn < ZC / BM) { EpiStore e; e.O = Zo; e.ldc = ZC; e(acc, u, wr, wc, fr, fq); }
        else { Unit v = u; v.pn = u.pn - ZC / BM; EpiGate e; e.O = Go; e.ldc = 4 * D; e.bias = bias; e(acc, v, wr, wc, fr, fq); }
    }
};
struct MoeOrderL {
    int nM, nN, nwg, G, c; const LAS int* tileE; const char* A; const char* B; size_t tA, tB, tBe;
    __device__ void init(const LAS int* plan, int nN_, int G_, int c_, const void* A_, int lda, const void* B_, int ldb, size_t expert_elems) {
        nM = plan[16]; nN = nN_; nwg = nM * nN; G = G_; c = c_; tileE = plan + 32; A = (const char*)A_; B = (const char*)B_; tA = (size_t)BM * lda * 2; tB = (size_t)BM * ldb * 2; tBe = expert_elems * 2; }
    __device__ bool next(int i, Unit& u) const {
        const long L = (long)i * G + c; if (L >= nwg) return false;
        int wgid = (int)L; { const int q = nwg / NXCD, r = nwg % NXCD, xcd = wgid % NXCD, off = wgid / NXCD; wgid = (xcd < r ? xcd * (q + 1) : r * (q + 1) + (xcd - r) * q) + off; }
        const int nig = WGM * nN, gid = wgid / nig, fm = gid * WGM, gsz = (nM - fm) < WGM ? (nM - fm) : WGM;
        u.pm = fm + ((wgid % nig) % gsz); u.pn = (wgid % nig) / gsz; u.x0 = tileE[u.pm]; u.x1 = 0;
        u.A = A + (size_t)u.pm * tA; u.B = B + (size_t)u.x0 * tBe + (size_t)u.pn * tB; return true;
    }
};
}
struct LnArgs { const float* xin; const float* cin; float* X; const bf16_t* Y; const float* mod_gate; const float* g; const float* bta; float* out; bf16_t* H; unsigned char* H8; const float* mod_h; int hsh, hsc;
                const float* wr; int* plan; int* ltok; int* tslot; float* tgate; int nrows; signed char* HQ; float* hscale; };
template <bool MOE, bool ROUTE> __device__ __forceinline__ void ln_rows(const LnArgs& a, const LAS int* planL) {
    const int tid_ = otid(); const int wave = tid_ >> 6, lane = tid_ & 63;
    for (int r = blockIdx.x * NWAVES + wave; r < a.nrows; r += gridDim.x * NWAVES) {
        const int mr = modrow(r);
        const float* xr = a.xin ? (r < TL ? a.xin + (size_t)r * D : a.cin + (size_t)(r - TL) * D) : a.X + (size_t)r * D;
        const float* md = a.mod_gate + (size_t)mr * 6144;
        size_t p0 = 0, p1 = 0; float g0 = 0.f, g1 = 0.f;
        if (MOE) { const int t0 = a.tslot[r * 2], t1 = a.tslot[r * 2 + 1]; g0 = a.tgate[r * 2]; g1 = a.tgate[r * 2 + 1]; const int e0 = t0 / T, e1 = t1 / T;
            p0 = (size_t)(planL[8 + e0] + (t0 - e0 * T)); p1 = (size_t)(planL[8 + e1] + (t1 - e1 * T)); }
        float v[16]; float s = 0.f;
#pragma unroll
        for (int j = 0; j < 4; ++j) { const int c = j * 256 + lane * 4; const float4 m4 = *(const float4*)(md + c); float4 x4;
            if (XBF && !a.xin) { const u32x2 xw = *(const u32x2*)((const bf16_t*)a.X + (size_t)r * D + c); x4 = make_float4(bflo(xw.x), bfhi(xw.x), bflo(xw.y), bfhi(xw.y)); } else x4 = *(const float4*)(xr + c);
            float y0, y1, y2, y3;
            if (MOE) { const u32x2 ya = *(const u32x2*)(a.Y + p0 * D + c), yb = *(const u32x2*)(a.Y + p1 * D + c);
                y0 = g0 * bflo(ya.x) + g1 * bflo(yb.x); y1 = g0 * bfhi(ya.x) + g1 * bfhi(yb.x); y2 = g0 * bflo(ya.y) + g1 * bflo(yb.y); y3 = g0 * bfhi(ya.y) + g1 * bfhi(yb.y); }
            else { const u32x2 yw = *(const u32x2*)(a.Y + (size_t)r * D + c); y0 = bflo(yw.x); y1 = bfhi(yw.x); y2 = bflo(yw.y); y3 = bfhi(yw.y); }
            v[j * 4] = ALPHA * x4.x + m4.x * y0; v[j * 4 + 1] = ALPHA * x4.y + m4.y * y1; v[j * 4 + 2] = ALPHA * x4.z + m4.z * y2; v[j * 4 + 3] = ALPHA * x4.w + m4.w * y3;
            s += v[j * 4] + v[j * 4 + 1] + v[j * 4 + 2] + v[j * 4 + 3]; }
#if LNPF
        if constexpr (!ROUTE) { const int rn = r + gridDim.x * NWAVES;
          if (rn < a.nrows) { const char* px; int nx;
              if (a.xin) { px = (const char*)(rn < TL ? a.xin + (size_t)rn * D : a.cin + (size_t)(rn - TL) * D); nx = 32; }
              else if (XBF) { px = (const char*)((const bf16_t*)a.X + (size_t)rn * D); nx = 16; } else { px = (const char*)(a.X + (size_t)rn * D); nx = 32; }
              const char* pt = lane < nx ? px + lane * 128 : ((!MOE && lane < nx + 16) ? (const char*)(a.Y + (size_t)rn * D) + (lane - nx) * 128 : nullptr);
              if (pt) __builtin_amdgcn_global_load_lds((const unsigned*)pt, (LAS unsigned*)((LAS unsigned char*)planL - 8192 + __builtin_amdgcn_readfirstlane(wave) * 256), 4, 0, 0); } }
#endif
        s = wave_sum(s, lane);
        const float mean = s * (1.f / D); float q = 0.f;
#pragma unroll
        for (int j = 0; j < 16; ++j) { v[j] -= mean; q += v[j] * v[j]; }
        q = wave_sum(q, lane);
        const float rstd = rsqrtf(q * (1.f / D) + 1e-5f);
        float lg[8]; float hq[16]; float am = 0.f; (void)hq;
#pragma unroll
        for (int e = 0; e < 8; ++e) lg[e] = 0.f;
#pragma unroll
        for (int j = 0; j < 4; ++j) { const int c = j * 256 + lane * 4; const float4 g4 = *(const float4*)(a.g + c), b4 = *(const float4*)(a.bta + c);
            float o[4]; o[0] = v[j * 4] * rstd * g4.x + b4.x; o[1] = v[j * 4 + 1] * rstd * g4.y + b4.y; o[2] = v[j * 4 + 2] * rstd * g4.z + b4.z; o[3] = v[j * 4 + 3] * rstd * g4.w + b4.w;
            if (XBF) { if (!a.out) { u32x2 xw; xw.x = pk2(o[0], o[1]); xw.y = pk2(o[2], o[3]); *(u32x2*)((bf16_t*)a.X + (size_t)r * D + c) = xw; } }
            else *(float4*)(a.X + (size_t)r * D + c) = make_float4(o[0], o[1], o[2], o[3]);
            if (a.out && r < TL) *(float4*)(a.out + (size_t)r * D + c) = make_float4(o[0], o[1], o[2], o[3]);
            if (a.H || a.H8 || a.HQ) { const float* mh = a.mod_h + (size_t)mr * 6144; const float4 sc = *(const float4*)(mh + a.hsc + c), sh = *(const float4*)(mh + a.hsh + c);
                float hv[4]; hv[0] = o[0] * (1.f + sc.x) + sh.x; hv[1] = o[1] * (1.f + sc.y) + sh.y; hv[2] = o[2] * (1.f + sc.z) + sh.z; hv[3] = o[3] * (1.f + sc.w) + sh.w;
                if (a.HQ) {
#pragma unroll
                    for (int i = 0; i < 4; ++i) { hq[j * 4 + i] = hv[i]; am = fmaxf(am, fabsf(hv[i])); } }
                if (a.H8) *(unsigned*)(a.H8 + (size_t)r * D + c) = pg8::pk4_fp8(hv[0] * pg8::S8_H, hv[1] * pg8::S8_H, hv[2] * pg8::S8_H, hv[3] * pg8::S8_H);
                if (a.H) { u32x2 w; w.x = pk2(hv[0], hv[1]); w.y = pk2(hv[2], hv[3]); *(u32x2*)(a.H + (size_t)r * D + c) = w; }
                if (ROUTE) {
#pragma unroll
                    for (int i = 0; i < 4; ++i) { const float4 w0 = *(const float4*)(a.wr + (c + i) * 8), w1 = *(const float4*)(a.wr + (c + i) * 8 + 4);
                        lg[0] += hv[i] * w0.x; lg[1] += hv[i] * w0.y; lg[2] += hv[i] * w0.z; lg[3] += hv[i] * w0.w; lg[4] += hv[i] * w1.x; lg[5] += hv[i] * w1.y; lg[6] += hv[i] * w1.z; lg[7] += hv[i] * w1.w; } } } }
        { if (a.HQ) {
#pragma unroll
            for (int o = 32; o >= 1; o >>= 1) am = fmaxf(am, shx(am, o, lane));
            const float qs = 127.f / fmaxf(am, 1e-30f);
            if (lane == 0) a.hscale[r] = am * (1.f / 127.f);
#pragma unroll
            for (int j = 0; j < 4; ++j) *(unsigned*)(a.HQ + (size_t)r * D + j * 256 + lane * 4) = pk4_i8(hq[j * 4] * qs, hq[j * 4 + 1] * qs, hq[j * 4 + 2] * qs, hq[j * 4 + 3] * qs); } }
        if (ROUTE) {
#pragma unroll
            for (int e = 0; e < 8; ++e) lg[e] = wave_sum(lg[e], lane);
            if (lane == 0) {
                int e1 = 0; float v1 = lg[0];
#pragma unroll
                for (int e = 1; e < 8; ++e) if (lg[e] > v1) { v1 = lg[e]; e1 = e; }
                int e2 = -1; float v2 = -3e38f;
#pragma unroll
                for (int e = 0; e < 8; ++e) if (e != e1 && lg[e] > v2) { v2 = lg[e]; e2 = e; }
                const float p2 = expf(v2 - v1), ga = 1.f / (1.f + p2), gb = p2 / (1.f + p2);
                const int s1 = atomicAdd(a.plan + e1, 1); a.ltok[e1 * T + s1] = r; a.tslot[r * 2] = e1 * T + s1; a.tgate[r * 2] = ga;
                const int s2 = atomicAdd(a.plan + e2, 1); a.ltok[e2 * T + s2] = r; a.tslot[r * 2 + 1] = e2 * T + s2; a.tgate[r * 2 + 1] = gb;
            } }
    }
}
__device__ __forceinline__ void moe_plan_lds(const int* plan, LAS int* planL) {
    if (threadIdx.x == 0) { int start = 0;
        for (int e = 0; e < 8; ++e) { const int cnt = plan[e]; const int nt = (cnt + 255) >> 8; planL[e] = cnt; planL[8 + e] = start * 256; for (int t = 0; t < nt; ++t) planL[32 + start + t] = e; start += nt; }
        planL[16] = start; }
    __syncthreads();
}

#define CAS __attribute__((address_space(4)))
__device__ __forceinline__ const float* karg_in(int i) { asm volatile("" : "+s"(i)); return (const float*)((const CAS void* const CAS*)__builtin_amdgcn_kernarg_segment_ptr())[i]; }
constexpr int FFN_ITEMS = 3 * 1792, FFN_CHUNK = 32;
template <bool MOE> __device__ __forceinline__ void ffn_conv_chunk(int chunk, int jj, unsigned char* wsp, LAS unsigned char* lds, int wave, int lane) {
    { const int t_ = otid(); wave = __builtin_amdgcn_readfirstlane(t_ >> 6); lane = t_ & 63; }
    chunk = __builtin_amdgcn_readfirstlane(chunk); asm volatile("" : "+s"(wsp), "+s"(jj), "+s"(chunk));
    LAS float* scr = (LAS float*)(lds + wave * 16384);
    constexpr bool F8W = MOE && FFN8;
    if constexpr (FFNQ && (!MOE || MOEQ)) {
        constexpr int NEX = MOE ? NE : 1, NBIG = NEX * 224;
        if (chunk < NBIG) { const int e = chunk / 224, g = chunk % 224, mat = g / 112, cb = g % 112;
            const size_t eo = MOE ? ((size_t)jj * NE + e) * D * DFF : (size_t)jj * D * DFF;
            colgroup_q_block(karg_in((MOE ? 38 : 34) + mat) + eo, DFF, 32 * cb, (signed char*)(wsp + W::WF13) + (size_t)e * 2 * DFF * D, D, mat, 2, (float*)(wsp + (MOE ? W::WS13M : W::WS13)) + e * 2 * DFF, lds); return; }
        chunk -= NBIG;
#pragma unroll 1
        for (int i = 0; i < FFN_CHUNK / NWAVES; ++i) { const int g = chunk * FFN_CHUNK + i * NWAVES + wave; if (g >= NEX * 1792) break;
            const int e = g / 1792, it = g % 1792; const size_t eo = MOE ? ((size_t)jj * NE + e) * D * DFF : (size_t)jj * D * DFF;
            if (MOE ? FFN8 : FFN2_8) transpose_item8(karg_in(MOE ? 40 : 36) + eo, D, D / 32, (unsigned char*)(wsp + W::WF2) + (size_t)e * D * DFF, DFF, 0, 1, pg8::S8_W2, scr, it, lane);
            else transpose_item(karg_in(MOE ? 40 : 36) + eo, D, D / 32, (bf16_t*)(wsp + W::WF2) + (size_t)e * D * DFF, DFF, 0, 1, 0, nullptr, scr, it, lane); }
        return; }
#pragma unroll 1
    for (int i = 0; i < FFN_CHUNK / NWAVES; ++i) {
        const int g = chunk * FFN_CHUNK + i * NWAVES + wave; if (g >= (MOE ? NE : 1) * FFN_ITEMS) break;
        const int e = g / FFN_ITEMS, r = g % FFN_ITEMS, mat = r / 1792, it = r % 1792;
        const size_t eo = MOE ? ((size_t)jj * NE + e) * D * DFF : (size_t)jj * D * DFF;
        const float* src = karg_in((MOE ? 38 : 34) + mat) + eo;
        if (F8W) { unsigned char* W13_8 = (unsigned char*)(wsp + W::WF13) + (size_t)e * 2 * DFF * D; unsigned char* W2_8 = (unsigned char*)(wsp + W::WF2) + (size_t)e * D * DFF;
            if (mat < 2) transpose_item8(src, DFF, DFF / 32, W13_8, D, mat, 2, pg8::S8_W13, scr, it, lane); else transpose_item8(src, D, D / 32, W2_8, DFF, 0, 1, pg8::S8_W2, scr, it, lane); }
        else { bf16_t* W13 = (bf16_t*)(wsp + W::WF13) + (size_t)e * 2 * DFF * D; bf16_t* W2 = (bf16_t*)(wsp + W::WF2) + (size_t)e * D * DFF;
            if (mat < 2) transpose_item(src, DFF, DFF / 32, W13, D, mat, 2, 0, nullptr, scr, it, lane); else transpose_item(src, D, D / 32, W2, DFF, 0, 1, 0, nullptr, scr, it, lane); }
    }
}
struct FwdCtx { unsigned char* ws; float* out; int lo, hi; };
#define PHASE_BEGIN if (pc >= lo && pc < hi) { unsigned char* wsp = ws; asm volatile("" : "+s"(wsp)); int lp = l; asm volatile("" : "+s"(lp)); \
        int bid = blockIdx.x; asm volatile("" : "+s"(bid)); int GRD = gridDim.x; asm volatile("" : "+s"(GRD)); \
        const int tid = otid(); const int wave = tid >> 6, lane = tid & 63, gw = bid * NWAVES + wave; (void)lane; (void)gw; (void)lp; \
        float* MOD = (float*)(wsp + W::MOD); float* X = (float*)(wsp + W::X); bf16_t* Hb = (bf16_t*)(wsp + W::H); (void)MOD; (void)X; (void)Hb;
#define PHASE_END   if (pc + 1 < hi) xcd_barrier(bar); } ++pc;
#define L_PTRS const float* MODl = MOD + (size_t)lp * 9 * 6144; const int jj = lp >> 1; const float lam_init = 0.8f - 0.6f * __expf(-0.3f * (float)lp); (void)MODl; (void)jj; (void)lam_init; \
        bf16_t* WING = (bf16_t*)(wsp + W::WING); bf16_t* WBR = (bf16_t*)(wsp + W::WBR); bf16_t* WOUT = (bf16_t*)(wsp + W::WOUT); bf16_t* WEXP = (bf16_t*)(wsp + W::WEXP); bf16_t* WGLU = (bf16_t*)(wsp + W::WGLU); \
        bf16_t* WF13 = (bf16_t*)(wsp + W::WF13); bf16_t* WF2 = (bf16_t*)(wsp + W::WF2); \
        bf16_t* ZB = (bf16_t*)(wsp + W::Z); bf16_t* GB = (bf16_t*)(wsp + W::G); bf16_t* EB = (bf16_t*)(wsp + W::E); bf16_t* OB = (bf16_t*)(wsp + W::OB); bf16_t* MB = (bf16_t*)(wsp + W::MB); bf16_t* YB = (bf16_t*)(wsp + W::YB); \
        int* PLANG = (int*)(wsp + W::CTL + W::PLAN + (size_t)jj * 4096); int* LTOK = (int*)(wsp + W::LTOK); int* TSLOT = (int*)(wsp + W::TSLOT); float* TGATE = (float*)(wsp + W::TGATE); \
        unsigned* QC = (unsigned*)(wsp + W::CTL + W::QCTR + (size_t)lp * 1024); \
        (void)WING; (void)WBR; (void)WOUT; (void)WEXP; (void)WGLU; (void)WF13; (void)WF2; (void)ZB; (void)GB; (void)EB; (void)OB; (void)MB; (void)YB; (void)PLANG; (void)LTOK; (void)TSLOT; (void)TGATE; (void)QC;
#define MK_SA S5Args sa; { unsigned char* s5t = wsp + W::S5TAB + (size_t)lp * 288 * 1024; sa.ZB = ZB; sa.S5A = (const float4*)s5t; sa.S5B = (const bf16_t*)(s5t + 32 * 1024); sa.S5C = (const bf16_t*)(s5t + 160 * 1024); \
        sa.dskip = karg_in(19) + lp * 256; sa.S = (float2*)(wsp + W::S5S); sa.Y5 = (bf16_t*)(wsp + W::Y5B); sa.dbg = nullptr; }
#define MK_PA PrepArgs pa{ZB, EB, (bf16_t*)(wsp + W::QM), (bf16_t*)(wsp + W::KM), (bf16_t*)(wsp + W::QD), (bf16_t*)(wsp + W::KD), (bf16_t*)(wsp + W::VTN), (bf16_t*)(wsp + W::VTM), (bf16_t*)(wsp + W::VTD)};
#define MK_L2 LnArgs l2{}; l2.X = X; l2.mod_gate = MODl + 5 * D; l2.g = karg_in(32) + lp * D; l2.bta = karg_in(33) + lp * D; l2.out = lp == DEPTH - 1 ? OUTP : nullptr; \
        l2.H = (GQ || lp == DEPTH - 1) ? nullptr : Hb; l2.H8 = (!GQ && GATE8 && lp != DEPTH - 1) ? (unsigned char*)(wsp + W::H8M) : nullptr; l2.HQ = (GQ && lp != DEPTH - 1) ? (signed char*)Hb : nullptr; l2.hscale = (float*)(wsp + W::HSM); l2.mod_h = MODl + 9 * 6144; l2.hsh = 0; l2.hsc = D; l2.tslot = TSLOT; l2.tgate = TGATE; l2.nrows = TR;


template <int LAYER> __device__ __forceinline__ void layer_body(const FwdCtx& cx, LAS unsigned char* lds, const XcdBarrier& bar, int& pc) {
    unsigned char* ws = cx.ws; float* OUTP = cx.out; const int lo = cx.lo, hi = cx.hi; const int l = LAYER; constexpr bool moe = (LAYER & 1) != 0;
    constexpr bool LASTL = LAYER == DEPTH - 1; constexpr int NRT = LASTL ? TL / 256 : T / 256, TR = NRT * 256;
    const int NGW = gridDim.x * NWAVES; (void)NGW;
    LAS float* biasL = (LAS float*)(lds + LDS_UP); LAS int* planL = (LAS int*)(lds + LDS_UP + 8192); LAS int* qslot = (LAS int*)(lds + LDS_UP + 12032); (void)biasL; (void)planL; (void)qslot;
        PHASE_BEGIN L_PTRS
            { int cursor = 0;
#if GQ
              for (int it = bid; it < INC / 32 + 4 * D / 32; it += GRD) {
                  if (it < INC / 32) colgroup_q_block(karg_in(6) + (size_t)lp * D * INC, INC, 32 * it, (signed char*)WING, D, 0, 1, (float*)(wsp + W::WSIN), lds);
                  else colgroup_q_block(karg_in(27) + (size_t)lp * D * 4 * D, 4 * D, 32 * (it - INC / 32), (signed char*)(wsp + W::WG8), D, 0, 1, (float*)(wsp + W::WSIN) + ZC, lds); }
              if (bid == GRD - 1 && tid < ZC - INC) ((float*)(wsp + W::WSIN))[INC + tid] = 0.f;
#else
              conv_matrix(karg_in(6) + (size_t)lp * D * INC, D, INC, INC, WING, D, 0, 1, 0, nullptr, lds, cursor);
              if (GATE8) conv_matrix8(karg_in(27) + (size_t)lp * D * 4 * D, D, 4 * D, 4 * D, (unsigned char*)(wsp + W::WG8), D, 0, 1, pg8::S8_W13, lds, cursor);
              else conv_matrix(karg_in(27) + (size_t)lp * D * 4 * D, D, 4 * D, 4 * D, WING, D, ZC, 1, 0, nullptr, lds, cursor);
#endif
              for (int i = 0; i < 4; ++i) conv_matrix(karg_in(26) + ((size_t)lp * 4 + i) * 256 * D, 256, D, D, WBR, 256, i * D, 1, 0, nullptr, lds, cursor);
              conv_matrix(karg_in(29) + (size_t)lp * D * D, D, D, D, WOUT, D, 0, 1, 0, nullptr, lds, cursor);
              if (!GQ) zero_rect(WING, D, INC, ZC, 0, D);
              conv_matrix(karg_in(10) + (size_t)lp * 256 * 384, 256, 384, 384, WEXP, 384, 0, 1, 0, karg_in(8) + lp * 256, lds, cursor);
              conv_matrix(karg_in(11) + (size_t)lp * 128 * 512, 128, 512, 512, WEXP, 384, 384, 1, 256, karg_in(9) + lp * 128, lds, cursor);
              zero_rect(WEXP, 384, 0, 384, 256, 384); zero_rect(WEXP, 384, 384, 896, 0, 256); zero_rect(WEXP, 384, 896, 1024, 0, 384);
              conv_matrix(karg_in(20) + (size_t)lp * 256 * 512, 256, 256, 512, WGLU, 256, 0, 2, 0, nullptr, lds, cursor);
              conv_matrix(karg_in(20) + (size_t)lp * 256 * 512 + 256, 256, 256, 512, WGLU, 256, 1, 2, 0, nullptr, lds, cursor);
              __syncthreads(); }
        PHASE_END
        for (int rep = 0; rep < DUP_L1; ++rep) {
        PHASE_BEGIN L_PTRS
#if GQ
            { pg8::StaticOrder S; S.init(T / 256, ZC / 256, GRD, bid, Hb, D / 2, WING, D / 2);
              pg8::EpiStoreQ E; E.O = ZB; E.ldc = ZC; E.hs = (const float*)(wsp + W::HSM); E.ws = (const float*)(wsp + W::WSIN);
              pg8::gemm_phase<pg8::EpiStoreQ, pg8::StaticOrder, false, true>(lds, D / 2, D / 2, D / 2, S, E);
#ifdef DUP_Z
              asm volatile("" ::: "memory"); pg8::gemm_phase<pg8::EpiStoreQ, pg8::StaticOrder, false, true>(lds, D / 2, D / 2, D / 2, S, E);
#endif
            }
            { pg8::StaticOrder S; S.init(NRT, 4 * D / 256, GRD, bid, Hb, D / 2, (bf16_t*)(wsp + W::WG8), D / 2);
              pg8::EpiGateQ E; E.O = (unsigned char*)GB; E.ldc = 4 * D; E.bias = karg_in(28) + (size_t)lp * 4 * D; E.hs = (const float*)(wsp + W::HSM); E.ws = (const float*)(wsp + W::WSIN) + ZC;
              pg8::gemm_phase<pg8::EpiGateQ, pg8::StaticOrder, false, true>(lds, D / 2, D / 2, D / 2, S, E);
#ifdef DUP_GATE
              asm volatile("" ::: "memory"); pg8::gemm_phase<pg8::EpiGateQ, pg8::StaticOrder, false, true>(lds, D / 2, D / 2, D / 2, S, E);
#endif
            }
#elif GATE8
            { pg8::StaticOrder S; S.init(T / 256, ZC / 256, GRD, bid, Hb, D, WING, D);
              pg8::EpiStore E; E.O = ZB; E.ldc = ZC;
              pg8::gemm_phase<pg8::EpiStore, pg8::StaticOrder>(lds, D, D, D, S, E); }
            { pg8::StaticOrder S; S.init(NRT, 4 * D / 256, GRD, bid, (bf16_t*)(wsp + W::H8M), D / 2, (bf16_t*)(wsp + W::WG8), D / 2);
              pg8::EpiGate E; E.O = GB; E.ldc = 4 * D; E.bias = karg_in(28) + (size_t)lp * 4 * D; E.isc = 1.f / (pg8::S8_H * pg8::S8_W13); E.u8 = G8;
              pg8::gemm_phase<pg8::EpiGate, pg8::StaticOrder, true>(lds, D / 2, D / 2, D / 2, S, E); }
#else
            { pg8::StaticOrder S; S.init(T / 256, NWG / 256, GRD, bid, Hb, D, WING, D);
              pg8::EpiZG E; E.Zo = ZB; E.Go = GB; E.bias = karg_in(28) + (size_t)lp * 4 * D;
              pg8::gemm_phase<pg8::EpiZG, pg8::StaticOrder>(lds, D, D, D, S, E); }
#endif
        PHASE_END
        }
        for (int rep = 0; rep < DUP_L2; ++rep) {
        PHASE_BEGIN L_PTRS MK_SA
            { pg8::StaticOrder S; S.init(T / 256, 4, GRD, bid, ZB + O_MQ, ZC, WEXP, 384);
              pg8::EpiStore E; E.O = EB; E.ldc = D;
              pg8::gemm_phase<pg8::EpiStore, pg8::StaticOrder>(lds, 384, ZC, 384, S, E);
              LAS float* tile = (LAS float*)(lds + wave * 8448);
              for (int it = bid; it < NB * 2 * NCHK * 2; it += GRD) { const int gh = it & 1, j = (it >> 1) % NCHK, bd = (it >> 1) / NCHK; s5_pass1_item(sa, bd >> 1, bd & 1, j, gh * 8 + wave, tile, lane); }
              __syncthreads(); }
        PHASE_END
        }
        for (int rep = 0; rep < DUP_L3; ++rep) {
        PHASE_BEGIN L_PTRS MK_PA
            { const float* rope_tab = (const float*)(wsp + W::ROPE);
              for (int r = gw; r < T; r += 6 * NGW) prep_rows_fast<6>(pa, rope_tab, r, NGW, T, lane); }
            for (int ti = bid; ti < T / 64; ti += GRD) prep_vt_tile_fast(pa, ti, lds);
        PHASE_END
        }
        for (int rep = 0; rep < DUP_L4; ++rep) {
        PHASE_BEGIN L_PTRS
            { float lam; { const float* lv = (const float*)(wsp + W::LAMV) + lp * 128; float s1 = 0.f, s2 = 0.f; for (int i = 0; i < 32; ++i) { s1 += lv[i] * lv[32 + i]; s2 += lv[64 + i] * lv[96 + i]; } lam = __expf(s1) - __expf(s2) + lam_init; }
              na_load_bias(karg_in(7) + (size_t)lp * 4 * 15 * 31, biasL);
#define QPOP2(k, r2) ({ __syncthreads(); if (otid() == 0) *qslot = (int)atomicAdd(QC + 64 * (k) + 32 * rep + 16 * (r2), 1u); __syncthreads(); *qslot; })
#define SUBSCOPE unsigned char* w2 = wsp; asm volatile("" : "+s"(w2)); const int t2_ = otid(); const int wv = __builtin_amdgcn_readfirstlane(t2_ >> 6), ln = t2_ & 63; (void)wv; (void)ln;
              const int nconv = (FFNQ && (!moe || MOEQ)) ? (moe ? NE : 1) * (224 + 1792 / FFN_CHUNK) : ((moe ? NE : 1) * FFN_ITEMS + FFN_CHUNK - 1) / FFN_CHUNK; bool conv_done = false;
#define CONV_SOME(nmax) do { for (int c_ = 0; c_ < (nmax) && !conv_done; ++c_) { __syncthreads(); if (otid() == 0) *qslot = (int)atomicAdd(QC + 8 + 32 * rep, 1u); __syncthreads(); const int q_ = *qslot; \
                  if (q_ >= nconv) conv_done = true; else ffn_conv_chunk<moe>(q_, jj, wsp, lds, wave, lane); } } while (0)
              { SUBSCOPE AttnArgs aa{(bf16_t*)(w2 + W::QD), (bf16_t*)(w2 + W::KD), (bf16_t*)(w2 + W::VTD), (bf16_t*)(w2 + W::OB), nullptr, karg_in(25) + lp * 64, lam_init, 0};
                for (int r2 = 0; r2 < (DUP_SUB == 0 ? 2 : 1); ++r2) for (;;) { const int u = QPOP2(0, r2); if (u >= NB * 4 * (LASTL ? 16 : 17)) break; const int qb = u / 32, bh = u % 32; attn_unit<2>(aa, bh >> 2, bh & 3, qb, lds, lam); CONV_SOME(2); } }
              { SUBSCOPE AttnArgs aa{(bf16_t*)(w2 + W::QM), (bf16_t*)(w2 + W::KM), (bf16_t*)(w2 + W::VTM), (bf16_t*)(w2 + W::OB), nullptr, nullptr, lam_init, 0};
                for (int r2 = 0; r2 < (DUP_SUB == 1 ? 2 : 1); ++r2) for (;;) { const int u = QPOP2(1, r2); if (u >= NB * 4 * (LASTL ? 16 : 17)) break; const int qb = u / 32, bh = u % 32; attn_unit<1>(aa, bh >> 2, bh & 3, qb, lds, 0.f); CONV_SOME(2); } }
              { SUBSCOPE S5Args sa; { unsigned char* s5t = w2 + W::S5TAB + (size_t)lp * 288 * 1024; sa.ZB = (bf16_t*)(w2 + W::Z); sa.S5A = (const float4*)s5t; sa.S5B = (const bf16_t*)(s5t + 32 * 1024); sa.S5C = (const bf16_t*)(s5t + 160 * 1024);
                  sa.dskip = karg_in(19) + lp * 256; sa.S = (float2*)(w2 + W::S5S); sa.Y5 = (bf16_t*)(w2 + W::Y5B); sa.dbg = nullptr; }
                LAS float* tile = (LAS float*)(lds + wv * 8448);
                for (int r2 = 0; r2 < (DUP_SUB == 2 ? 2 : 1); ++r2) for (;;) { const int it = QPOP2(2, r2); if (it >= NB * (LASTL ? NCHK - 4 : NCHK) * 2) break; const int gh = it & 1, tc = LASTL ? 4 + (it >> 1) % (NCHK - 4) : (it >> 1) % NCHK, b = LASTL ? (it >> 1) / (NCHK - 4) : (it >> 1) / NCHK; s5_pass2_item(sa, b, tc, gh * 8 + wv, tile, ln); } }
              { SUBSCOPE NaArgs na{(bf16_t*)(w2 + W::Z), (bf16_t*)(w2 + W::VTN), (bf16_t*)(w2 + W::OB), nullptr};
                for (int r2 = 0; r2 < (DUP_SUB == 3 ? 2 : 1); ++r2) for (;;) { const int it = QPOP2(3, r2); if (it >= (LASTL ? 512 : 544)) break; na_wave(na, it, biasL, wv, ln); } }
#undef SUBSCOPE
              CONV_SOME(1 << 30);
#undef CONV_SOME
              __syncthreads(); }
        PHASE_END
        }
        PHASE_BEGIN L_PTRS
            { pg8::StaticOrder S; S.init(NRT, 2, GRD, bid, (bf16_t*)(wsp + W::Y5B), 256, WGLU, 256);
              pg8::EpiPair<true> E; E.O = OB; E.ldc = D; E.col_off = 512;
              pg8::gemm_phase<pg8::EpiPair<true>, pg8::StaticOrder>(lds, 256, 256, 256, S, E); }
        PHASE_END
        for (int rep = 0; rep < DUP_L6; ++rep) {
        PHASE_BEGIN L_PTRS
            { pg8::MergeOrder S; S.init(NRT, GRD, bid, OB, WBR);
              pg8::EpiMerge E; E.M = MB; E.G = GB; E.P = ZB;
              pg8::gemm_phase<pg8::EpiMerge, pg8::MergeOrder>(lds, 256, D, 256, S, E); }
        PHASE_END
        }
        PHASE_BEGIN L_PTRS
            { pg8::StaticOrder S; S.init(NRT, 4, GRD, bid, MB, D, WOUT, D);
              pg8::EpiStore E; E.O = YB; E.ldc = D;
              pg8::gemm_phase<pg8::EpiStore, pg8::StaticOrder>(lds, D, D, D, S, E); }
        PHASE_END
        PHASE_BEGIN L_PTRS
            { LnArgs la{}; la.xin = lp == 0 ? karg_in(0) : nullptr; la.cin = karg_in(2); la.X = X; la.Y = YB; la.mod_gate = MODl + 2 * D; la.g = karg_in(30) + lp * D; la.bta = karg_in(31) + lp * D; la.out = nullptr;
              la.H = ((FFN8 && moe) || (FFNQ && !moe)) ? nullptr : Hb; la.H8 = (FFN8 && moe && !MOEQ) ? (unsigned char*)Hb : nullptr; la.HQ = (FFNQ && (!moe || MOEQ)) ? (signed char*)Hb : nullptr; la.hscale = (float*)(wsp + (moe ? W::HSM : W::TSLOT)); la.mod_h = MODl; la.hsh = 3 * D; la.hsc = 4 * D; la.wr = karg_in(37) + (size_t)jj * D * 8; la.plan = PLANG; la.ltok = LTOK; la.tslot = TSLOT; la.tgate = TGATE; la.nrows = TR;
              if (moe) ln_rows<false, true>(la, planL); else ln_rows<false, false>(la, planL); }
        PHASE_END
        if (!moe) {
            for (int rep = 0; rep < DUP_FFN; ++rep) {
            PHASE_BEGIN L_PTRS
#if 0
                { pg8::StaticOrder S; S.init(T / 256, 2 * DFF / 256, GRD, bid, Hb, D / 2, WF13, D / 2);
                  pg8::EpiSwiglu8 E; E.O = (unsigned char*)(wsp + W::ACT); E.ldc = DFF; E.isc = 1.f / (pg8::S8_H * pg8::S8_W13); E.osc = pg8::S8_ACT;
                  pg8::gemm_phase<pg8::EpiSwiglu8, pg8::StaticOrder, true>(lds, D / 2, D / 2, D / 2, S, E); }
#elif FFNQ
                { pg8::StaticOrder S; S.init(T / 256, 2 * DFF / 256, GRD, bid, Hb, D / 2, WF13, D / 2);
                  pg8::EpiSwigluQ<FFN2_8 != 0> E; E.O = (bf16_t*)(wsp + W::ACT); E.ldc = DFF; E.hs = (const float*)(wsp + W::TSLOT); E.ws = (const float*)(wsp + W::WS13); E.osc = pg8::S8_ACT;
                  pg8::gemm_phase<pg8::EpiSwigluQ<FFN2_8 != 0>, pg8::StaticOrder, false, true>(lds, D / 2, D / 2, D / 2, S, E); }
#else
                { pg8::StaticOrder S; S.init(T / 256, 2 * DFF / 256, GRD, bid, Hb, D, WF13, D);
                  pg8::EpiPair<false> E; E.O = (bf16_t*)(wsp + W::ACT); E.ldc = DFF; E.col_off = 0;
                  pg8::gemm_phase<pg8::EpiPair<false>, pg8::StaticOrder>(lds, D, D, D, S, E); }
#endif
            PHASE_END
            PHASE_BEGIN L_PTRS
#if FFN2_8
                { pg8::StaticOrder S; S.init(T / 256, 4, GRD, bid, (bf16_t*)(wsp + W::ACT), DFF / 2, WF2, DFF / 2);
                  pg8::EpiStoreS E; E.O = (bf16_t*)(wsp + W::FB); E.ldc = D; E.scale = 1.f / (pg8::S8_ACT * pg8::S8_W2);
                  pg8::gemm_phase<pg8::EpiStoreS, pg8::StaticOrder, true>(lds, DFF / 2, DFF / 2, DFF / 2, S, E); }
#else
                { pg8::StaticOrder S; S.init(T / 256, 4, GRD, bid, (bf16_t*)(wsp + W::ACT), DFF, WF2, DFF);
                  pg8::EpiStore E; E.O = (bf16_t*)(wsp + W::FB); E.ldc = D;
                  pg8::gemm_phase<pg8::EpiStore, pg8::StaticOrder>(lds, DFF, DFF, DFF, S, E); }
#endif
            PHASE_END
            }
            PHASE_BEGIN L_PTRS MK_L2
                l2.Y = (bf16_t*)(wsp + W::FB); ln_rows<false, false>(l2, planL);
            PHASE_END
        } else {
            PHASE_BEGIN L_PTRS
                moe_plan_lds(PLANG, planL);
                { const int nrows = planL[16] * 256;
#if FFN8
                  for (int pr0 = gw; pr0 < nrows; pr0 += 4 * NGW) {
                      int tok[4]; u32x4 v0[4]; float hsv[4];
#pragma unroll
                      for (int q = 0; q < 4; ++q) { const int pr = pr0 + q * NGW; tok[q] = -1; if (pr < nrows) { const int e = planL[32 + (pr >> 8)], slot = pr - planL[8 + e]; if (slot < planL[e]) tok[q] = LTOK[e * T + slot]; } }
#pragma unroll
                      for (int q = 0; q < 4; ++q) { v0[q] = (u32x4){0u, 0u, 0u, 0u}; hsv[q] = 0.f; if (tok[q] >= 0) { v0[q] = ((const u32x4*)((const unsigned char*)Hb + (size_t)tok[q] * D))[lane]; if (MOEQ) hsv[q] = ((const float*)(wsp + W::HSM))[tok[q]]; } }
#pragma unroll
                      for (int q = 0; q < 4; ++q) { const int pr = pr0 + q * NGW; if (pr < nrows) { if (MOEQ && lane == 0) ((float*)(wsp + W::HGS))[pr] = hsv[q]; ((u32x4*)((unsigned char*)(wsp + W::HG) + (size_t)pr * D))[lane] = v0[q]; } } } }
#else
                  for (int pr = gw; pr < nrows; pr += NGW) { const int e = planL[32 + (pr >> 8)], slot = pr - planL[8 + e];
                      u32x4 v0 = (u32x4){0u, 0u, 0u, 0u}, v1 = v0;
                      if (slot < planL[e]) { const int tok = LTOK[e * T + slot]; const u32x4* src = (const u32x4*)(Hb + (size_t)tok * D); v0 = src[lane]; v1 = src[64 + lane]; }
                      u32x4* dst = (u32x4*)((bf16_t*)(wsp + W::HG) + (size_t)pr * D); dst[lane] = v0; dst[64 + lane] = v1; } }
#endif
            PHASE_END
            for (int rep = 0; rep < DUP_FFN; ++rep) {
            PHASE_BEGIN L_PTRS
                if (lo == pc) moe_plan_lds(PLANG, planL);
#if MOEQ
                { pg8::MoeOrderL S; S.init(planL, 2 * DFF / 256, GRD, bid, (bf16_t*)(wsp + W::HG), D / 2, WF13, D / 2, (size_t)2 * DFF * D / 2);
                  pg8::EpiSwigluQ<true> E; E.O = (bf16_t*)(wsp + W::ACT); E.ldc = DFF; E.hs = (const float*)(wsp + W::HGS); E.ws = (const float*)(wsp + W::WS13M); E.osc = pg8::S8_ACT;
                  pg8::gemm_phase<pg8::EpiSwigluQ<true>, pg8::MoeOrderL, false, true>(lds, D / 2, D / 2, D / 2, S, E); }
#elif FFN8
                { pg8::MoeOrderL S; S.init(planL, 2 * DFF / 256, GRD, bid, (bf16_t*)(wsp + W::HG), D / 2, WF13, D / 2, (size_t)2 * DFF * D / 2);
                  pg8::EpiSwiglu8 E; E.O = (unsigned char*)(wsp + W::ACT); E.ldc = DFF; E.isc = 1.f / (pg8::S8_H * pg8::S8_W13); E.osc = pg8::S8_ACT;
                  pg8::gemm_phase<pg8::EpiSwiglu8, pg8::MoeOrderL, true>(lds, D / 2, D / 2, D / 2, S, E); }
#else
                { pg8::MoeOrderL S; S.init(planL, 2 * DFF / 256, GRD, bid, (bf16_t*)(wsp + W::HG), D, WF13, D, (size_t)2 * DFF * D);
                  pg8::EpiPair<false> E; E.O = (bf16_t*)(wsp + W::ACT); E.ldc = DFF; E.col_off = 0;
                  pg8::gemm_phase<pg8::EpiPair<false>, pg8::MoeOrderL>(lds, D, D, D, S, E); }
#endif
            PHASE_END
            PHASE_BEGIN L_PTRS
                if (lo == pc) moe_plan_lds(PLANG, planL);
#if FFN8
                { pg8::MoeOrderL S; S.init(planL, 4, GRD, bid, (bf16_t*)(wsp + W::ACT), DFF / 2, WF2, DFF / 2, (size_t)D * DFF / 2);
                  pg8::EpiStoreS E; E.O = (bf16_t*)(wsp + W::HG); E.ldc = D; E.scale = 1.f / (pg8::S8_ACT * pg8::S8_W2);
                  pg8::gemm_phase<pg8::EpiStoreS, pg8::MoeOrderL, true>(lds, DFF / 2, DFF / 2, DFF / 2, S, E); }
#else
                { pg8::MoeOrderL S; S.init(planL, 4, GRD, bid, (bf16_t*)(wsp + W::ACT), DFF, WF2, DFF, (size_t)D * DFF);
                  pg8::EpiStore E; E.O = (bf16_t*)(wsp + W::HG); E.ldc = D;
                  pg8::gemm_phase<pg8::EpiStore, pg8::MoeOrderL>(lds, DFF, DFF, DFF, S, E); }
#endif
            PHASE_END
            }
            PHASE_BEGIN L_PTRS
                if (lo == pc) moe_plan_lds(PLANG, planL);
                MK_L2 l2.Y = (bf16_t*)(wsp + W::HG); ln_rows<true, false>(l2, planL);
            PHASE_END
        }
}
__global__ void __launch_bounds__(NTHR, 2) fwd(FwdArgs A) {
    extern __shared__ __attribute__((aligned(16))) unsigned char lds_raw[];
    LAS unsigned char* lds = (LAS unsigned char*)lds_raw;
    unsigned char* ws = A.ws;
    volatile LAS unsigned* bst = (volatile LAS unsigned*)(lds + LDS_UP + 12288);
    if (threadIdx.x < 4) bst[threadIdx.x] = 0u;
    __syncthreads();
    XcdBarrier bar = xcd_barrier_post((unsigned*)(ws + W::CTL), bst);
    const int lo = A.lo, hi = A.hi; int pc = 0; const int l = 0; (void)l;
    const int NGW = gridDim.x * NWAVES;
    PHASE_BEGIN
        { LAS float* condL = (LAS float*)lds;
          float* MODP = (float*)(wsp + W::MODP);
          for (int u = bid; u < 4 * 12 * 8; u += GRD) { const int ks = u & 7, cg = (u >> 3) % 12, l = u / 96;
              __syncthreads();
              for (int i = tid; i < 9 * 128; i += NTHR) { const int r = i >> 7, k = ks * 128 + (i & 127); const float v = r < 8 ? karg_in(1)[r * D + k] : karg_in(3)[k]; condL[i] = v * sigm(v); }
              __syncthreads();
              const int n = cg * 512 + tid; float acc[9];
#pragma unroll
              for (int r = 0; r < 9; ++r) acc[r] = 0.f;
              const float* w = karg_in(4) + ((size_t)l * D + ks * 128) * 6144 + n;
#pragma unroll 4
              for (int k = 0; k < 128; ++k) { const float wv = w[(size_t)k * 6144];
#pragma unroll
                  for (int r = 0; r < 9; ++r) acc[r] += condL[r * 128 + k] * wv; }
#pragma unroll
              for (int r = 0; r < 9; ++r) MODP[(((size_t)ks * 4 + l) * 9 + r) * 6144 + n] = acc[r]; }
          for (int i = bid * NTHR + tid; i < 4 * 2048; i += GRD * NTHR) { const int l = i >> 11, j = i & 2047; unsigned char* tb = wsp + W::S5TAB + (size_t)l * 288 * 1024;
              const int gi = j >> 6, p = j & 63;
              const float* lam_re = karg_in(12) + (size_t)l * 2048; const float* lam_im = karg_in(13) + (size_t)l * 2048; const float* log_dt = karg_in(14) + l * 32;
              const float* b_re = karg_in(15) + (size_t)l * 32768; const float* b_im = karg_in(16) + (size_t)l * 32768; const float* c_re = karg_in(17) + (size_t)l * 32768; const float* c_im = karg_in(18) + (size_t)l * 32768;
              float4* S5A = (float4*)tb; bf16_t* S5B = (bf16_t*)(tb + 32 * 1024); bf16_t* S5C = (bf16_t*)(tb + 160 * 1024);
              const double lre = lam_re[j], lim = lam_im[j], dt = exp((double)log_dt[gi]);
              const double x = lre * dt; double y = lim * dt; y -= 6.283185307179586476925 * rint(y / 6.283185307179586476925);
              float sy, cy; sincosf((float)y, &sy, &cy); const float sh = sinf((float)(0.5 * y));
              const double em1 = x * (1.0 + x * 0.5 * (1.0 + x * (1.0 / 3.0) * (1.0 + x * 0.25 * (1.0 + x * 0.2 * (1.0 + x * (1.0 / 6.0))))));
              const double nr = em1 * (double)cy - 2.0 * (double)sh * (double)sh, ni = (1.0 + em1) * (double)sy;
              const double ar = 1.0 + nr, ai = ni; double pr = ar, pi = ai;
#pragma unroll
              for (int k = 0; k < 6; ++k) { const double t = pr * pr - pi * pi; pi = 2.0 * pr * pi; pr = t; }
              S5A[j] = make_float4((float)ar, (float)ai, (float)pr, (float)pi);
              const double den = lre * lre + lim * lim; const float fr = (float)((nr * lre + ni * lim) / den), fi = (float)((ni * lre - nr * lim) / den);
              for (int c = 0; c < 16; ++c) { const float br = b_re[j * 16 + c], bi = b_im[j * 16 + c];
                  S5B[((size_t)gi * 128 + p) * 16 + c] = (bf16_t)f2bf(fr * br - fi * bi); S5B[((size_t)gi * 128 + 64 + p) * 16 + c] = (bf16_t)f2bf(fr * bi + fi * br);
                  S5C[((size_t)gi * 16 + c) * 128 + p] = (bf16_t)f2bf(c_re[(gi * 16 + c) * 64 + p]); S5C[((size_t)gi * 16 + c) * 128 + 64 + p] = (bf16_t)f2bf(-c_im[(gi * 16 + c) * 64 + p]); } }
          if (bid == 1 % GRD) { float* RT = (float*)(wsp + W::ROPE); const int pos = tid >> 3, i = tid & 7; const float inv = exp2f(-(float)i * 0.125f * 13.287712379549449f); float sn_, cs_; sincosf((float)pos * inv, &sn_, &cs_); RT[pos * 16 + i] = cs_; RT[pos * 16 + 8 + i] = sn_; }
          if (bid == 0) { float* LAMV = (float*)(wsp + W::LAMV); const int l = tid >> 7, wq = (tid >> 5) & 3, j = tid & 31; const float* s0 = karg_in(21); const float* s1 = karg_in(22); const float* s2 = karg_in(23); const float* s3 = karg_in(24); const float* src = wq == 0 ? s0 : (wq == 1 ? s1 : (wq == 2 ? s2 : s3)); LAMV[tid] = src[l * 32 + j]; }
          __syncthreads(); }
    PHASE_END
    PHASE_BEGIN
        { const float* MODP = (const float*)(wsp + W::MODP);
          for (int i = bid * NTHR + tid; i < 4 * 9 * 6144; i += GRD * NTHR) { const int n = i % 6144, l = i / (9 * 6144); float s = karg_in(5)[l * 6144 + n];
#pragma unroll
              for (int ks = 0; ks < 8; ++ks) s += MODP[(size_t)ks * 4 * 9 * 6144 + i];
              MOD[i] = s; } }
    PHASE_END
    PHASE_BEGIN
        for (int r = gw; r < T; r += NGW) { const float* xr = r < TL ? karg_in(0) + (size_t)r * D : karg_in(2) + (size_t)(r - TL) * D; const float* md = MOD + (size_t)modrow(r) * 6144;
#if GQ
            float hq[16]; float am = 0.f;
#pragma unroll
            for (int j = 0; j < 4; ++j) { const int c = j * 256 + lane * 4; const float4 x4 = *(const float4*)(xr + c), sc = *(const float4*)(md + D + c), sh = *(const float4*)(md + c);
                hq[j * 4] = x4.x * (1.f + sc.x) + sh.x; hq[j * 4 + 1] = x4.y * (1.f + sc.y) + sh.y; hq[j * 4 + 2] = x4.z * (1.f + sc.z) + sh.z; hq[j * 4 + 3] = x4.w * (1.f + sc.w) + sh.w;
                am = fmaxf(fmaxf(am, fmaxf(fabsf(hq[j * 4]), fabsf(hq[j * 4 + 1]))), fmaxf(fabsf(hq[j * 4 + 2]), fabsf(hq[j * 4 + 3]))); }
#pragma unroll
            for (int o = 32; o >= 1; o >>= 1) am = fmaxf(am, shx(am, o, lane));
            const float qs = 127.f / fmaxf(am, 1e-30f);
            if (lane == 0) ((float*)(wsp + W::HSM))[r] = am * (1.f / 127.f);
#pragma unroll
            for (int j = 0; j < 4; ++j) *(unsigned*)((signed char*)Hb + (size_t)r * D + j * 256 + lane * 4) = pk4_i8(hq[j * 4] * qs, hq[j * 4 + 1] * qs, hq[j * 4 + 2] * qs, hq[j * 4 + 3] * qs);
            continue;
#endif
#pragma unroll
            for (int j = 0; j < 4; ++j) { const int c = j * 256 + lane * 4; const float4 x4 = *(const float4*)(xr + c), sc = *(const float4*)(md + D + c), sh = *(const float4*)(md + c);
                const float h0 = x4.x * (1.f + sc.x) + sh.x, h1 = x4.y * (1.f + sc.y) + sh.y, h2 = x4.z * (1.f + sc.z) + sh.z, h3 = x4.w * (1.f + sc.w) + sh.w;
                u32x2 w; w.x = pk2(h0, h1); w.y = pk2(h2, h3); *(u32x2*)(Hb + (size_t)r * D + c) = w;
                if (GATE8) *(unsigned*)((unsigned char*)(wsp + W::H8M) + (size_t)r * D + c) = pg8::pk4_fp8(h0 * pg8::S8_H, h1 * pg8::S8_H, h2 * pg8::S8_H, h3 * pg8::S8_H); } }
    PHASE_END

    FwdCtx cx{ws, A.out, lo, hi};
    layer_body<0>(cx, lds, bar, pc); layer_body<1>(cx, lds, bar, pc); layer_body<2>(cx, lds, bar, pc); layer_body<3>(cx, lds, bar, pc);
}
#undef PHASE_BEGIN L_PTRS
#undef PHASE_END
#undef QPOP2
#undef L_PTRS
#undef MK_SA
#undef MK_PA
#undef MK_L2
constexpr int NPHASES = 3 + 4 * 9 + 2 * 3 + 2 * 4 + 4 * (DUP_L4 - 1) + 4 * (DUP_L1 - 1) + 4 * (DUP_L6 - 1) + 4 * (DUP_L3 - 1) + 4 * (DUP_L2 - 1) + 4 * 2 * (DUP_FFN - 1);

template <int MODE> static void sgemm(hipStream_t st, const SG& p, int Mgrid) {
    dim3 grid((p.N + 127) / 128, (Mgrid + 127) / 128);
    hipLaunchKernelGGL((k_sgemm<MODE>), grid, dim3(256), 0, st, p);
}

#ifndef FUSED
#define FUSED 1
#endif
#if FUSED
extern "C" void kernel_launch(void* const* d_in, const int* in_sizes, int n_in, void* d_out, int out_size, void* d_ws, size_t ws_size, hipStream_t stream) {
    if (n_in != 41 || ws_size < W::END || out_size != TL * D) { fprintf(stderr, "kernel_launch: bad args n_in %d ws %zu out %d\n", n_in, ws_size, out_size); return; }
    static int grid = 0;
    if (!grid) {
        int dev = 0, cus = 0, per_cu = 0;
        if (hipGetDevice(&dev) != hipSuccess || hipDeviceGetAttribute(&cus, hipDeviceAttributeMultiprocessorCount, dev) != hipSuccess) { fprintf(stderr, "kernel_launch: device query failed\n"); return; }
        if (hipFuncSetAttribute((const void*)fwd, hipFuncAttributeMaxDynamicSharedMemorySize, LDS_BYTES) != hipSuccess) { fprintf(stderr, "kernel_launch: hipFuncSetAttribute failed\n"); return; }
        if (hipOccupancyMaxActiveBlocksPerMultiprocessor(&per_cu, fwd, NTHR, LDS_BYTES) != hipSuccess || per_cu < 1) { fprintf(stderr, "kernel_launch: occupancy query says %d\n", per_cu); return; }
        grid = cus;
    }
    if (hipMemsetAsync((char*)d_ws + W::CTL, 0, W::CTL_ZERO, stream) != hipSuccess) { fprintf(stderr, "kernel_launch: memset failed\n"); return; }
    FwdArgs a{};
    for (int i = 0; i < 41; ++i) a.in[i] = (const float*)d_in[i];
    a.ws = (unsigned char*)d_ws; a.out = (float*)d_out;
#if FUSED == 1
    a.lo = 0; a.hi = NPHASES;
    hipLaunchKernelGGL(fwd, dim3(grid), dim3(NTHR), LDS_BYTES, stream, a);
#else
    for (int p = 0; p < NPHASES; ++p) { a.lo = p; a.hi = p + 1; hipLaunchKernelGGL(fwd, dim3(grid), dim3(NTHR), LDS_BYTES, stream, a); }
#endif
}
#else
extern "C" void kernel_launch(void* const* d_in, const int* in_sizes, int n_in, void* d_out, int out_size, void* d_ws, size_t ws_size, hipStream_t stream) {
    if (n_in != 41 || ws_size < WS_END) { fprintf(stderr, "kernel_launch: bad args n_in %d ws %zu\n", n_in, ws_size); return; }
    const float* const* in = (const float* const*)d_in;
    char* ws = (char*)d_ws;
    float* COND = (float*)(ws + WS_COND); float* MOD = (float*)(ws + WS_MOD); int* CNT = (int*)(ws + WS_CNT); int* LTOK = (int*)(ws + WS_LTOK); float* LGATE = (float*)(ws + WS_LGATE);
    float* X = (float*)(ws + WS_X); float* O = (float*)(ws + WS_O); float* MG = (float*)(ws + WS_MG); float* TG = (float*)(ws + WS_TG); float* E = (float*)(ws + WS_E);
    float* Y5 = (float*)(ws + WS_Y5); float* Z = (float*)(ws + WS_Z); float* ACT = Z;
    bf16_t* Hb = (bf16_t*)(ws + WS_H); bf16_t* W13 = (bf16_t*)(ws + WS_W13); bf16_t* W2T = (bf16_t*)(ws + WS_W2T); bf16_t* ACTb = (bf16_t*)(ws + WS_Z); bf16_t* Fb = (bf16_t*)(ws + WS_TG);
    int* PLAN = (int*)(ws + WS_CNT); int* TSLOT = (int*)(ws + WS_COND + 64 * 1024); float* TGATE = (float*)(ws + WS_COND + 512 * 1024);
    bf16_t* ACTE = (bf16_t*)(ws + 144 * MiB); bf16_t* HG = (bf16_t*)(ws + 636 * MiB); bf16_t* W13E = (bf16_t*)(ws + 778 * MiB); bf16_t* W2TE = (bf16_t*)(ws + 890 * MiB);
    bf16_t* ZB = (bf16_t*)(ws + 280 * MiB); bf16_t* MB = (bf16_t*)(ws + 280 * MiB); bf16_t* YB = (bf16_t*)(ws + 348 * MiB); bf16_t* OB = (bf16_t*)(ws + 144 * MiB); bf16_t* GB = (bf16_t*)(ws + WS_Z);
    bf16_t* WING = (bf16_t*)(ws + 1088 * MiB); bf16_t* WBR = (bf16_t*)(ws + 1101 * MiB); bf16_t* WOUT = (bf16_t*)(ws + 1103 * MiB);
    bf16_t* EB = (bf16_t*)(ws + 552 * MiB); bf16_t* QM = (bf16_t*)(ws + 620 * MiB); bf16_t* KM = (bf16_t*)(ws + 620 * MiB + (size_t)4 * T * 96 * 2);
    bf16_t* VTN = (bf16_t*)(ws + 484 * MiB); bf16_t* VTM = (bf16_t*)(ws + 501 * MiB); bf16_t* VTD = (bf16_t*)(ws + 518 * MiB); bf16_t* QD = (bf16_t*)(ws + 535 * MiB); bf16_t* KD = (bf16_t*)(ws + 1105 * MiB);
    bf16_t* WEXP = (bf16_t*)(ws + 6 * MiB); bf16_t* WGLU = (bf16_t*)(ws + 7 * MiB); float* LAMV = (float*)(ws + WS_COND + 40 * 1024);
    float4* S5A = (float4*)(ws + 7 * MiB + 256 * 1024); bf16_t* S5B = (bf16_t*)(ws + 7 * MiB + 512 * 1024); bf16_t* S5C = (bf16_t*)(ws + 7 * MiB + 768 * 1024);
    bf16_t* Y5B = (bf16_t*)(ws + 671 * MiB); float2* S5S = (float2*)(ws + 688 * MiB);
    static int grid = 0;
    if (!grid) {
        int dev = 0, cus = 0; hipGetDevice(&dev); hipDeviceGetAttribute(&cus, hipDeviceAttributeMultiprocessorCount, dev);
        hipFuncSetAttribute((const void*)k_conv_ffn, hipFuncAttributeMaxDynamicSharedMemorySize, LDS_BYTES);
        hipFuncSetAttribute((const void*)k_conv_mix, hipFuncAttributeMaxDynamicSharedMemorySize, LDS_BYTES);
        hipFuncSetAttribute((const void*)k_conv_exp, hipFuncAttributeMaxDynamicSharedMemorySize, LDS_BYTES);
        hipFuncSetAttribute((const void*)k_prep, hipFuncAttributeMaxDynamicSharedMemorySize, LDS_BYTES);
        hipFuncSetAttribute((const void*)k_na2, hipFuncAttributeMaxDynamicSharedMemorySize, LDS_BYTES);
        hipFuncSetAttribute((const void*)k_s5_pass1, hipFuncAttributeMaxDynamicSharedMemorySize, LDS_BYTES);
        hipFuncSetAttribute((const void*)k_s5_pass2, hipFuncAttributeMaxDynamicSharedMemorySize, LDS_BYTES);
        hipFuncSetAttribute((const void*)k_gemm<pg8::EpiPair<true>>, hipFuncAttributeMaxDynamicSharedMemorySize, LDS_BYTES);
        hipFuncSetAttribute((const void*)k_attn<1>, hipFuncAttributeMaxDynamicSharedMemorySize, LDS_BYTES);
        hipFuncSetAttribute((const void*)k_attn<2>, hipFuncAttributeMaxDynamicSharedMemorySize, LDS_BYTES);
        hipFuncSetAttribute((const void*)k_gemm_gate, hipFuncAttributeMaxDynamicSharedMemorySize, LDS_BYTES);
        hipFuncSetAttribute((const void*)k_gemm_merge, hipFuncAttributeMaxDynamicSharedMemorySize, LDS_BYTES);
        hipFuncSetAttribute((const void*)k_conv_moe, hipFuncAttributeMaxDynamicSharedMemorySize, LDS_BYTES);
        hipFuncSetAttribute((const void*)k_gemm_moe<pg8::EpiPair<false>>, hipFuncAttributeMaxDynamicSharedMemorySize, LDS_BYTES);
        hipFuncSetAttribute((const void*)k_gemm_moe<pg8::EpiStore>, hipFuncAttributeMaxDynamicSharedMemorySize, LDS_BYTES);
        hipFuncSetAttribute((const void*)k_gemm<pg8::EpiPair<false>>, hipFuncAttributeMaxDynamicSharedMemorySize, LDS_BYTES);
        hipFuncSetAttribute((const void*)k_gemm<pg8::EpiStore>, hipFuncAttributeMaxDynamicSharedMemorySize, LDS_BYTES);
        grid = cus > 0 ? cus : 256;
    }
    unsigned long long* CHKT = (unsigned long long*)(ws + WS_CNT + 65536);
    hipMemsetAsync(CHKT, 0, 2048, stream);
#define CHK(id, ptr, bytes) do { if (SELFCHECK) hipLaunchKernelGGL(k_chk, dim3(1024), dim3(256), 0, stream, (const unsigned*)(ptr), (size_t)(bytes) / 4, CHKT + run * 64 + (id)); } while (0)
#ifndef SELFCHECK
#define SELFCHECK 0
#endif
    for (int run = 0; run < (SELFCHECK ? 2 : 1); ++run) {
    hipLaunchKernelGGL(k_cond, dim3(36), dim3(256), 0, stream, in[1], in[3], COND);
    hipLaunchKernelGGL(k_lamv, dim3(1), dim3(512), 0, stream, in[21], in[22], in[23], in[24], LAMV);
    hipLaunchKernelGGL(k_mod, dim3(24, 4), dim3(256), 0, stream, COND, in[4], in[5], MOD);
    hipLaunchKernelGGL(k_copy_in, dim3((unsigned)((size_t)T * D / 4 / 256)), dim3(256), 0, stream, in[0], in[2], X);
    for (int l = 0; l < DEPTH; ++l) {
        const float* MODl = MOD + (size_t)l * 9 * 6144;
        const float lam_init = 0.8f - 0.6f * expf(-0.3f * (float)l);
        SG p{};
        ConvMix cx{in[6] + (size_t)l * D * INC, in[27] + (size_t)l * D * 4 * D, in[26] + (size_t)l * 4 * 256 * D, in[29] + (size_t)l * D * D, WING, WBR, WOUT};
        hipLaunchKernelGGL(k_conv_mix, dim3(grid), dim3(NTHR), LDS_BYTES, stream, cx);
        { ConvExp ce{in[10] + (size_t)l * 256 * 384, in[11] + (size_t)l * 128 * 512, in[8] + l * 256, in[9] + l * 128, in[20] + (size_t)l * 256 * 512, WEXP, WGLU};
          hipLaunchKernelGGL(k_conv_exp, dim3(grid), dim3(NTHR), LDS_BYTES, stream, ce); }
        { S5Prep sp{in[12] + (size_t)l * 2048, in[13] + (size_t)l * 2048, in[14] + l * 32, in[15] + (size_t)l * 32768, in[16] + (size_t)l * 32768, in[17] + (size_t)l * 32768, in[18] + (size_t)l * 32768, S5A, S5B, S5C};
          hipLaunchKernelGGL(k_s5prep, dim3(8), dim3(256), 0, stream, sp); }
        CHK(l * 16 + 2, S5A, (size_t)32768); CHK(l * 16 + 3, S5B, (size_t)131072); CHK(l * 16 + 4, S5C, (size_t)131072);
        if (l == 0) hipLaunchKernelGGL(k_modh, dim3(T * D / 4 / 256), dim3(256), 0, stream, X, MODl, 0, D, Hb);
        { GemmArgs ga{Hb, WING, ZB, T / 256, ZC / 256, D, D, D, ZC, 0, 0};
          hipLaunchKernelGGL(k_gemm<pg8::EpiStore>, dim3(grid), dim3(NTHR), LDS_BYTES, stream, ga); }
        CHK(l * 16 + 0, Hb, (size_t)T * D * 2); CHK(l * 16 + 1, ZB, (size_t)T * ZC * 2);
        { GemmArgs ga{ZB + O_MQ, WEXP, EB, T / 256, 4, 384, ZC, 384, D, 0, 0};
          hipLaunchKernelGGL(k_gemm<pg8::EpiStore>, dim3(grid), dim3(NTHR), LDS_BYTES, stream, ga); }
        { PrepArgs pa{ZB, EB, QM, KM, QD, KD, VTN, VTM, VTD};
          hipLaunchKernelGGL(k_prep, dim3(grid), dim3(NTHR), LDS_BYTES, stream, pa); }
        CHK(l * 16 + 5, EB, (size_t)T * D * 2); CHK(l * 16 + 5, QM, (size_t)8 * T * 96 * 2); CHK(l * 16 + 5, VTN, (size_t)51 * MiB); CHK(l * 16 + 5, QD, (size_t)17 * MiB); CHK(l * 16 + 5, KD, (size_t)17 * MiB);
        { S5Args sa{ZB, S5A, S5B, S5C, in[19] + l * 256, S5S, Y5B, SELFCHECK ? CHKT + run * 64 + l * 16 + 5 : (unsigned long long*)nullptr};
          CHK(l * 16 + 5, ZB, (size_t)T * ZC * 2); CHK(l * 16 + 5, S5A, (size_t)32768); CHK(l * 16 + 5, S5B, (size_t)131072);
          hipLaunchKernelGGL(k_s5_pass1, dim3(grid), dim3(NTHR), LDS_BYTES, stream, sa);
          CHK(l * 16 + 6, S5S, (size_t)NB * 2 * NCHK * 16 * 64 * 8);
          hipLaunchKernelGGL(k_s5_pass2, dim3(grid), dim3(NTHR), LDS_BYTES, stream, sa); }
        CHK(l * 16 + 7, Y5B, (size_t)17 * MiB);
        { NaArgs na{ZB, VTN, OB, in[7] + (size_t)l * 4 * 15 * 31};
          hipLaunchKernelGGL(k_na2, dim3(grid), dim3(NTHR), LDS_BYTES, stream, na); }
        { AttnArgs aa{QM, KM, VTM, OB, nullptr, nullptr, lam_init, 0};
          hipLaunchKernelGGL(k_attn<1>, dim3(grid), dim3(NTHR), LDS_BYTES, stream, aa); }
        { AttnArgs aa{QD, KD, VTD, OB, LAMV + l * 128, in[25] + l * 64, lam_init, 0};
          hipLaunchKernelGGL(k_attn<2>, dim3(grid), dim3(NTHR), LDS_BYTES, stream, aa); }
        { GemmArgs ga{Y5B, WGLU, OB, T / 256, 2, 256, 256, 256, D, 512, 0};
          hipLaunchKernelGGL(k_gemm<pg8::EpiPair<true>>, dim3(grid), dim3(NTHR), LDS_BYTES, stream, ga); }
        CHK(l * 16 + 9, OB, (size_t)T * D * 2);
        { Gemm2Args ga{Hb, WING + (size_t)ZC * D, GB, in[28] + (size_t)l * 4 * D, nullptr, T / 256, 4 * D / 256, D, D, D, 4 * D};
          hipLaunchKernelGGL(k_gemm_gate, dim3(grid), dim3(NTHR), LDS_BYTES, stream, ga); }
        CHK(l * 16 + 10, GB, (size_t)T * 4 * D * 2);
        { Gemm2Args ga{OB, WBR, MB, nullptr, GB, T / 256, 4, 256, D, 256, D};
          hipLaunchKernelGGL(k_gemm_merge, dim3(grid), dim3(NTHR), LDS_BYTES, stream, ga); }
        CHK(l * 16 + 11, MB, (size_t)T * D * 2);
        { GemmArgs ga{MB, WOUT, YB, T / 256, D / 256, D, D, D, D, 0, 0};
          hipLaunchKernelGGL(k_gemm<pg8::EpiStore>, dim3(grid), dim3(NTHR), LDS_BYTES, stream, ga); }
        CHK(l * 16 + 12, YB, (size_t)T * D * 2);
        hipLaunchKernelGGL(k_lnh<true>, dim3(T / 4), dim3(256), 0, stream, X, (const void*)YB, MODl, 2 * D, in[30] + l * D, in[31] + l * D, (float*)nullptr, Hb, MODl, 3 * D, 4 * D);
        CHK(l * 16 + 13, X, (size_t)T * D * 4);
        const int j = l / 2;
        if ((l & 1) == 0) {
            ConvFfn cf{in[34] + (size_t)j * D * DFF, in[35] + (size_t)j * D * DFF, in[36] + (size_t)j * DFF * D, W13, W2T};
            hipLaunchKernelGGL(k_conv_ffn, dim3(grid), dim3(NTHR), LDS_BYTES, stream, cf);
            GemmArgs g1{Hb, W13, ACTb, T / 256, 2 * DFF / 256, D, D, D, DFF, 0, 0};
            hipLaunchKernelGGL(k_gemm<pg8::EpiPair<false>>, dim3(grid), dim3(NTHR), LDS_BYTES, stream, g1);
            GemmArgs g2{ACTb, W2T, Fb, T / 256, D / 256, DFF, DFF, DFF, D, 0, 0};
            hipLaunchKernelGGL(k_gemm<pg8::EpiStore>, dim3(grid), dim3(NTHR), LDS_BYTES, stream, g2);
        } else {
            hipMemsetAsync(PLAN, 0, 4096, stream);
            ConvMoe cm{in[38] + (size_t)j * NE * D * DFF, in[39] + (size_t)j * NE * D * DFF, in[40] + (size_t)j * NE * DFF * D, W13E, W2TE};
            hipLaunchKernelGGL(k_conv_moe, dim3(grid), dim3(NTHR), LDS_BYTES, stream, cm);
            hipLaunchKernelGGL(k_route2, dim3(T / 4), dim3(256), 0, stream, X, MODl, in[37] + (size_t)j * D * 8, PLAN, LTOK, TSLOT, TGATE);
            hipLaunchKernelGGL(k_moe_plan, dim3(1), dim3(64), 0, stream, PLAN);
            hipLaunchKernelGGL(k_gather, dim3(MAXTILES * 256 / 4), dim3(256), 0, stream, Hb, HG, PLAN, LTOK);
            MoeGemmArgs m1{HG, W13E, ACTE, PLAN, 2 * DFF / 256, D, D, D, DFF, 0, (size_t)2 * DFF * D};
            hipLaunchKernelGGL(k_gemm_moe<pg8::EpiPair<false>>, dim3(grid), dim3(NTHR), LDS_BYTES, stream, m1);
            MoeGemmArgs m2{ACTE, W2TE, HG, PLAN, D / 256, DFF, DFF, DFF, D, 0, (size_t)D * DFF};
            hipLaunchKernelGGL(k_gemm_moe<pg8::EpiStore>, dim3(grid), dim3(NTHR), LDS_BYTES, stream, m2);
        }
        if ((l & 1) == 0) hipLaunchKernelGGL(k_lnh<true>, dim3(T / 4), dim3(256), 0, stream, X, (const void*)Fb, MODl, 5 * D, in[32] + l * D, in[33] + l * D, l == DEPTH - 1 ? (float*)d_out : (float*)nullptr, l == DEPTH - 1 ? (bf16_t*)nullptr : Hb, MODl + 9 * 6144, 0, D);
        else hipLaunchKernelGGL(k_ln_moe, dim3(T / 4), dim3(256), 0, stream, X, HG, PLAN, TSLOT, TGATE, MODl, 5 * D, in[32] + l * D, in[33] + l * D, l == DEPTH - 1 ? (float*)d_out : (float*)nullptr, l == DEPTH - 1 ? (bf16_t*)nullptr : Hb, MODl + 9 * 6144);
        CHK(l * 16 + 14, X, (size_t)T * D * 4);
    }
    }
    if (SELFCHECK) hipLaunchKernelGGL(k_chk_final, dim3(1024), dim3(256), 0, stream, CHKT, 64, (float*)d_out, (size_t)TL * D);
}
#endif
```
